# Optimizing an MI355X kernel written in HIP

```python
import jax, jax.numpy as jnp
from jax import lax
import numpy as np

D_MODEL = 2048
BATCH = 1
SEQ = 16384
DEPTH = 2

GRID_W = 64
CTX_LEN = 256
N_HEADS = 16
N_KV_HEADS = 4
HEAD_DIM = 128
GQA_GROUP = N_HEADS // N_KV_HEADS
Q_BLOCK = 128
ROPE_THETA = 10000.0
ROPE_FREQS = HEAD_DIM // 4
ATTN_SCALE = HEAD_DIM ** -0.5
FOURIER_DIM = D_MODEL // 2
N_FOURIER_GROUPS = 4
FOURIER_GROUP = FOURIER_DIM // N_FOURIER_GROUPS
D_FF = 5632
N_EXPERTS = 8
TOP_K = 2
D_FF_EXPERT = D_FF // TOP_K
N_DENSE = (DEPTH + 1) // 2
N_MOE = DEPTH // 2
EPS = 1e-6
Q_W = N_HEADS * HEAD_DIM
KV_W = N_KV_HEADS * HEAD_DIM
IN_COLS = Q_W + 2 * KV_W + FOURIER_DIM + 2 * D_MODEL
SPLITS = (Q_W, Q_W + KV_W, Q_W + 2 * KV_W, Q_W + 2 * KV_W + FOURIER_DIM)

kernel_name = "hybrid_gqa_fnet_moe_diffusion_block"


def rms_norm(t, g):
    tf = t.astype(jnp.float32)
    y = tf * lax.rsqrt(jnp.mean(tf * tf, axis=-1, keepdims=True) + EPS)
    return (y * g.astype(jnp.float32)).astype(t.dtype)


def modulate(h, shift, scale):
    return h * (1.0 + scale) + shift


def ada_modulation(cond, w, b):
    m = jax.nn.silu(cond) @ w + b
    return jnp.split(m[:, None, :], 6, axis=-1)


def axial_rope_tables(rows):
    row = jnp.repeat(jnp.arange(rows, dtype=jnp.float32), GRID_W)
    col = jnp.tile(jnp.arange(GRID_W, dtype=jnp.float32), rows)
    inv = ROPE_THETA ** (-jnp.arange(ROPE_FREQS, dtype=jnp.float32) / ROPE_FREQS)
    ar = row[:, None] * inv
    ac = col[:, None] * inv
    ang = jnp.concatenate([ar, ar, ac, ac], axis=-1)
    return jnp.cos(ang), jnp.sin(ang)


def apply_rope(t, cos, sin):
    tf = t.astype(jnp.float32)
    seg = tf.reshape(*t.shape[:-1], 2, 2, ROPE_FREQS)
    rot = jnp.stack([-seg[..., 1, :], seg[..., 0, :]], axis=-2).reshape(t.shape)
    return (tf * cos[:, None, :] + rot * sin[:, None, :]).astype(t.dtype)


def _heads(t, n):
    return t.reshape(*t.shape[:-1], n, HEAD_DIM)


def project(h, w_in, b_gate, q_g, k_g):
    p = h @ w_in
    q, k, v, f, g = jnp.split(p, SPLITS, axis=-1)
    q = rms_norm(_heads(q, N_HEADS), q_g)
    k = rms_norm(_heads(k, N_KV_HEADS), k_g)
    v = _heads(v, N_KV_HEADS)
    return q, k, v, f, g + b_gate


def gqa(q, k, v):
    B, Q = q.shape[:2]
    qg = q.reshape(B, Q, N_KV_HEADS, GQA_GROUP, HEAD_DIM)
    s = jnp.einsum('bqhgd,bkhd->bhgqk', qg, k, preferred_element_type=jnp.float32) * ATTN_SCALE
    p = jax.nn.softmax(s, axis=-1).astype(v.dtype)
    o = jnp.einsum('bhgqk,bkhd->bqhgd', p, v)
    return o.reshape(B, Q, N_HEADS * HEAD_DIM)


def latent_attention(q, k_all, v_all):
    B, S = q.shape[:2]
    nb = S // Q_BLOCK
    qb = jnp.moveaxis(q.reshape(B, nb, Q_BLOCK, N_HEADS, HEAD_DIM), 1, 0)
    o = lax.map(lambda qi: gqa(qi, k_all, v_all), qb)
    return jnp.moveaxis(o, 0, 1).reshape(B, S, N_HEADS * HEAD_DIM)


def fourier_mix(u):
    B, N = u.shape[:2]
    ug = u.astype(jnp.float32).reshape(B, N, N_FOURIER_GROUPS, FOURIER_GROUP)
    f = jnp.fft.fftn(ug, axes=(1, 3), norm='ortho').real
    return f.reshape(B, N, FOURIER_DIM).astype(u.dtype)


def merge(attn, four, gate_logits, w_attn_proj, w_four_proj, w_out):
    gates = jax.nn.sigmoid(gate_logits.astype(jnp.float32)).astype(attn.dtype)
    g_attn, g_four = jnp.split(gates, 2, axis=-1)
    y = g_attn * (attn @ w_attn_proj) + g_four * (four @ w_four_proj)
    return y @ w_out


def swiglu(h, wg, wu, wd):
    return (jax.nn.silu(h @ wg) * (h @ wu)) @ wd


def moe_swiglu(h, router_w, wg, wu, wd):
    logits = jnp.einsum('bsd,de->bse', h, router_w, preferred_element_type=jnp.float32)
    top_v, top_i = lax.top_k(logits, TOP_K)
    w = jax.nn.softmax(top_v, axis=-1)
    combine = jnp.sum(jax.nn.one_hot(top_i, N_EXPERTS, dtype=jnp.float32) * w[..., None], axis=-2)
    out = jnp.zeros_like(h)
    for e in range(N_EXPERTS):
        out = out + combine[..., e:e + 1].astype(h.dtype) * swiglu(h, wg[e], wu[e], wd[e])
    return out


def channel_mixer(l, h, ffn_w_gate, ffn_w_up, ffn_w_down, router_w, moe_w_gate, moe_w_up, moe_w_down):
    i = l // 2
    if l % 2 == 0:
        return swiglu(h, ffn_w_gate[i], ffn_w_up[i], ffn_w_down[i])
    return moe_swiglu(h, router_w[i], moe_w_gate[i], moe_w_up[i], moe_w_down[i])


def setup_inputs(seed: int = 0) -> dict:
    key = jax.random.key(seed)
    ks = jax.random.split(key, 24)
    f32 = jnp.float32

    def nrm(k, shape, fan_in):
        return jax.random.normal(k, shape, f32) * (fan_in ** -0.5)

    def gain(k, shape):
        return 1.0 + 0.02 * jax.random.normal(k, shape, f32)

    def small(k, shape):
        return 0.02 * jax.random.normal(k, shape, f32)

    D = D_MODEL
    return {
        'x': jax.random.normal(ks[0], (BATCH, SEQ, D), f32),
        'c': jax.random.normal(ks[1], (BATCH, D), f32),
        'ctx': jax.random.normal(ks[2], (BATCH, CTX_LEN, D), f32),
        'c_ctx': jax.random.normal(ks[3], (D,), f32),
        'ada_w': nrm(ks[4], (DEPTH, D, 6 * D), D),
        'ada_b': small(ks[5], (DEPTH, 6 * D)),
        'norm_attn_g': gain(ks[6], (DEPTH, D)),
        'norm_ffn_g': gain(ks[7], (DEPTH, D)),
        'w_in': nrm(ks[8], (DEPTH, D, IN_COLS), D),
        'b_gate': small(ks[9], (DEPTH, 2 * D)),
        'q_norm_g': gain(ks[10], (DEPTH, HEAD_DIM)),
        'k_norm_g': gain(ks[11], (DEPTH, HEAD_DIM)),
        'w_attn_proj': nrm(ks[12], (DEPTH, Q_W, D), Q_W),
        'w_four_proj': nrm(ks[13], (DEPTH, FOURIER_DIM, D), FOURIER_DIM),
        'w_out': nrm(ks[14], (DEPTH, D, D), D),
        'ffn_w_gate': nrm(ks[15], (N_DENSE, D, D_FF), D),
        'ffn_w_up': nrm(ks[16], (N_DENSE, D, D_FF), D),
        'ffn_w_down': nrm(ks[17], (N_DENSE, D_FF, D), D_FF),
        'router_w': nrm(ks[18], (N_MOE, D, N_EXPERTS), D),
        'moe_w_gate': nrm(ks[19], (N_MOE, N_EXPERTS, D, D_FF_EXPERT), D),
        'moe_w_up': nrm(ks[20], (N_MOE, N_EXPERTS, D, D_FF_EXPERT), D),
        'moe_w_down': nrm(ks[21], (N_MOE, N_EXPERTS, D_FF_EXPERT, D), D_FF_EXPERT),
        'final_norm_g': gain(ks[22], (D,)),
    }


def reference(x, c, ctx, c_ctx, ada_w, ada_b, norm_attn_g, norm_ffn_g, w_in, b_gate, q_norm_g, k_norm_g,
              w_attn_proj, w_four_proj, w_out, ffn_w_gate, ffn_w_up, ffn_w_down, router_w, moe_w_gate,
              moe_w_up, moe_w_down, final_norm_g):
    S = x.shape[1]
    ROWS = S // GRID_W
    cos, sin = axial_rope_tables(ROWS)
    xc = ctx
    for l in range(DEPTH):
        last = l == DEPTH - 1
        sh1, sc1, ga1, sh2, sc2, ga2 = ada_modulation(c, ada_w[l], ada_b[l])
        mod_c = ada_modulation(c_ctx[None, :], ada_w[l], ada_b[l])

        hc = modulate(rms_norm(xc, norm_attn_g[l]), mod_c[0], mod_c[1])
        if last:
            kc, vc = jnp.split(hc @ w_in[l][:, Q_W:Q_W + 2 * KV_W], 2, axis=-1)
            kc = rms_norm(_heads(kc, N_KV_HEADS), k_norm_g[l])
            vc = _heads(vc, N_KV_HEADS)
        else:
            qc, kc, vc, fc, gc = project(hc, w_in[l], b_gate[l], q_norm_g[l], k_norm_g[l])
            yc = merge(gqa(qc, kc, vc), fourier_mix(fc), gc, w_attn_proj[l], w_four_proj[l], w_out[l])
            xc_next = xc + mod_c[2] * yc
            hc2 = modulate(rms_norm(xc_next, norm_ffn_g[l]), mod_c[3], mod_c[4])
            xc_next = xc_next + mod_c[5] * channel_mixer(l, hc2, ffn_w_gate, ffn_w_up, ffn_w_down,
                                                         router_w, moe_w_gate, moe_w_up, moe_w_down)

        h = modulate(rms_norm(x, norm_attn_g[l]), sh1, sc1)
        q, k, v, f, g = project(h, w_in[l], b_gate[l], q_norm_g[l], k_norm_g[l])
        q = apply_rope(q, cos, sin)
        k = apply_rope(k, cos, sin)
        k_all = jnp.concatenate([kc, k], axis=1)
        v_all = jnp.concatenate([vc, v], axis=1)
        y = merge(latent_attention(q, k_all, v_all), fourier_mix(f), g, w_attn_proj[l], w_four_proj[l], w_out[l])
        x = x + ga1 * y
        h2 = modulate(rms_norm(x, norm_ffn_g[l]), sh2, sc2)
        x = x + ga2 * channel_mixer(l, h2, ffn_w_gate, ffn_w_up, ffn_w_down,
                                    router_w, moe_w_gate, moe_w_up, moe_w_down)
        if not last:
            xc = xc_next
    return rms_norm(x, final_norm_g)
```

```cpp
#include <hip/hip_runtime.h>
#include <hip/hip_bf16.h>
#include <cstdio>
#include <cstdint>

#define GAS __attribute__((address_space(1)))
#define LAS __attribute__((address_space(3)))
typedef unsigned short bf16_t;
typedef short bf16x8 __attribute__((ext_vector_type(8)));
typedef short s16x4 __attribute__((ext_vector_type(4)));
typedef float f32x4 __attribute__((ext_vector_type(4)));
typedef float f32x2 __attribute__((ext_vector_type(2)));
typedef float f32x16 __attribute__((ext_vector_type(16)));
typedef unsigned u32x4 __attribute__((ext_vector_type(4)));
typedef unsigned u32x2 __attribute__((ext_vector_type(2)));
typedef int i32x4 __attribute__((ext_vector_type(4)));
typedef int i32x2 __attribute__((ext_vector_type(2)));
typedef GAS unsigned gu32;
#define RLX_AGENT __ATOMIC_RELAXED, __HIP_MEMORY_SCOPE_AGENT
#define LDS_WAIT() asm volatile("s_waitcnt lgkmcnt(0)" ::: "memory")
#define VM_WAIT() asm volatile("s_waitcnt vmcnt(0)" ::: "memory")

#ifndef MK_SPLIT
#define MK_SPLIT 0
#endif

constexpr int DM = 2048, SEQ = 16384, CTXL = 256, MR = SEQ + CTXL, NH = 16, NKV = 4, HD = 128;
constexpr int QW = 2048, KVW = 512, FD = 1024, GW2 = 4096, INC = 8192, DFF = 5632, NE = 8, DFE = 2816;
constexpr int PAIR_ROWS = 34816;
constexpr float EPS = 1e-6f;
constexpr int NWAVES = 8;

constexpr size_t MiB = 1u << 20;
constexpr size_t WS_CTL = 0, CTL_ZERO_BYTES = 1 * MiB;
constexpr size_t WS_WIN = 1 * MiB;
constexpr size_t WS_WAP = 65 * MiB;
constexpr size_t WS_WFP = 81 * MiB;
constexpr size_t WS_WOUT = 89 * MiB;
constexpr size_t WS_WGU = 105 * MiB;
constexpr size_t WS_WD = 149 * MiB;
constexpr size_t WS_MGU = 171 * MiB;
constexpr size_t WS_MD = 347 * MiB;
constexpr size_t WS_TAB = 435 * MiB;
constexpr size_t WS_PART = 436 * MiB;
constexpr size_t WS_MOD = 439 * MiB;
constexpr size_t WS_H = 440 * MiB;
constexpr size_t WS_Q = 505 * MiB;
constexpr size_t WS_K = 570 * MiB;
constexpr size_t WS_V = 587 * MiB;
constexpr size_t WS_F = 604 * MiB;
constexpr size_t WS_G = 637 * MiB;
constexpr size_t WS_ZA = 767 * MiB;
constexpr size_t WS_YB = 831 * MiB;
constexpr size_t WS_FOUR = 895 * MiB;
constexpr size_t WS_ZC = 928 * MiB;
constexpr size_t WS_XC = 929 * MiB;
constexpr size_t WS_ROUTE = 931 * MiB;
constexpr size_t WS_U = 505 * MiB;
constexpr size_t WS_HG = 505 * MiB;
constexpr size_t WS_UG = 641 * MiB;
constexpr size_t WS_END = 932 * MiB;
static_assert(WS_UG + (size_t)PAIR_ROWS * DFE * 2 <= WS_ROUTE, "ws map");
static_assert(WS_U + (size_t)MR * DFF * 2 <= WS_ZA, "ws map");
constexpr size_t TAB_DC = 0;
constexpr size_t TAB_DN = 256 * 1024;
constexpr size_t TAB_D256 = 384 * 1024;
constexpr size_t TAB_ROPE = 640 * 1024;
constexpr int CW_TMO = 0, CW_CODE = 1, CW_DBG = 2, CW_CNT = 1024  , CW_BAR = 4096;

constexpr int RING_BYTES = 131072, LDSCTL_OFF = RING_BYTES, MISC_OFF = LDSCTL_OFF + 320;
constexpr int LDS_BYTES = 147456;

__device__ __forceinline__ unsigned f2bf(float f) { unsigned u = __builtin_bit_cast(unsigned, f); return (u + 0x7fffu + ((u >> 16) & 1u)) >> 16; }
__device__ __forceinline__ unsigned pk2(float lo, float hi) { return f2bf(lo) | (f2bf(hi) << 16); }
__device__ __forceinline__ float bflo(unsigned w) { return __builtin_bit_cast(float, w << 16); }
__device__ __forceinline__ float bfhi(unsigned w) { return __builtin_bit_cast(float, w & 0xffff0000u); }
__device__ __forceinline__ unsigned cvt_pk_bf16(float lo, float hi) { unsigned r; asm volatile("v_cvt_pk_bf16_f32 %0, %1, %2" : "=v"(r) : "v"(lo), "v"(hi)); return r; }
__device__ __forceinline__ float wave_sum(float v) {
#pragma unroll
    for (int o = 1; o < 64; o <<= 1) v += __shfl_xor(v, o);
    return v;
}
__device__ __forceinline__ float sigmoidf_(float x) { return __builtin_amdgcn_rcpf(1.0f + __builtin_amdgcn_exp2f(-1.4426950408889634f * x)); }

#define XB_TMO      128
#define XB_XCNT(j)  (256  + 64 * (j))
#define XB_XSUB(j)  (1280 + 64 * (j))
#define XB_XGEN(j)  (2304 + 64 * (j))
#define XB_TOP      3328
#define XB_TOPGEN   3392
#define XCD_BAR_WORDS 3456
#define XB_SPIN_CAP (1u << 18)
__device__ __forceinline__ unsigned xb_ld(unsigned* p)              { return __hip_atomic_load(p, __ATOMIC_RELAXED, __HIP_MEMORY_SCOPE_AGENT); }
__device__ __forceinline__ unsigned xb_add(unsigned* p, unsigned v) { return __hip_atomic_fetch_add(p, v, __ATOMIC_RELAXED, __HIP_MEMORY_SCOPE_AGENT); }
__device__ __forceinline__ unsigned xb_xcc_id() { return (unsigned)__builtin_amdgcn_s_getreg((3 << 11) | 20) & 0xFu; }
#define XB_SPIN(cond, bar) do { unsigned _sp = 0; while (cond) { __builtin_amdgcn_s_sleep(1); \
    if ((++_sp & 255u) == 0u) { if (xb_ld(&(bar)[XB_TMO])) break; if (_sp > XB_SPIN_CAP) { atomicAdd(&(bar)[XB_TMO], 1u); break; } } } } while (0)
struct XcdBarrier { unsigned* bar; unsigned x; volatile LAS unsigned* st; };
__device__ __forceinline__ XcdBarrier xcd_barrier_post(unsigned* bar, volatile LAS unsigned* st) {
    XcdBarrier b; b.bar = bar; b.x = xb_xcc_id(); b.st = st;
    if (threadIdx.x == 0) (void)xb_add(&bar[XB_XCNT(b.x)], 1u);
    return b;
}
__device__ __forceinline__ void xcd_barrier_complete(unsigned* bar, unsigned x, unsigned& nloc, unsigned& nx) {
    const unsigned G = gridDim.x * gridDim.y * gridDim.z;
    unsigned sum, cnt, mine, sp = 0u;
    for (;;) {
        sum = 0u; cnt = 0u; mine = 0u;
#pragma unroll
        for (unsigned j = 0; j < 16; ++j) { const unsigned c = xb_ld(&bar[XB_XCNT(j)]); sum += c; cnt += (c > 0u) ? 1u : 0u; mine = (j == x) ? c : mine; }
        if (sum == G) break;
        __builtin_amdgcn_s_sleep(1);
        if ((++sp & 255u) == 0u) { if (xb_ld(&bar[XB_TMO])) break; if (sp > XB_SPIN_CAP) { atomicAdd(&bar[XB_TMO], 1u); break; } }
    }
    nloc = mine > 0u ? mine : 1u; nx = cnt > 0u ? cnt : 1u;
}
__device__ __forceinline__ void xcd_barrier(const XcdBarrier& b) {
    asm volatile("s_waitcnt vmcnt(0)" ::: "memory");
    __syncthreads();
    if (threadIdx.x == 0) {
        unsigned* bar = b.bar;
        __builtin_amdgcn_s_waitcnt(0);
        unsigned nloc = b.st[0], nx = b.st[1];
        if (nloc == 0u) { xcd_barrier_complete(bar, b.x, nloc, nx); b.st[0] = nloc; b.st[1] = nx; }
        const unsigned old = xb_add(&bar[XB_XSUB(b.x)], 1u);
        const unsigned gen = old / nloc;
        if (old + 1u == (gen + 1u) * nloc) {
            __builtin_amdgcn_fence(__ATOMIC_RELEASE, "agent");
            asm volatile("s_waitcnt vmcnt(0)" ::: "memory");
            const unsigned og = xb_add(&bar[XB_TOP], 1u);
            const unsigned tg = og / nx;
            if (og + 1u == (tg + 1u) * nx) xb_add(&bar[XB_TOPGEN], 1u);
            else XB_SPIN(xb_ld(&bar[XB_TOPGEN]) == tg, bar);
            __builtin_amdgcn_fence(__ATOMIC_ACQUIRE, "agent");
            xb_add(&bar[XB_XGEN(b.x)], 1u);
            asm volatile("s_waitcnt vmcnt(0)" ::: "memory");
        } else {
            XB_SPIN(xb_ld(&bar[XB_XGEN(b.x)]) == gen, bar);
            __builtin_amdgcn_fence(__ATOMIC_ACQUIRE, "agent");
            asm volatile("s_waitcnt vmcnt(0)" ::: "memory");
        }
    }
    __syncthreads();
}

namespace pg8 {
constexpr int BM = 256, BK = 64, HALF = 128, HTB = HALF * BK * 2, STAGE_BYTES = 8 * HTB, NXCD = 8, WGM = 8;
__host__ __device__ __forceinline__ int lds_byte(int r, int c) { const int st = (r >> 4) * 2 + (c >> 5), rr = r & 15, cc = c & 31, ob = rr * 64 + cc * 2; return st * 1024 + (ob ^ (((ob >> 9) & 1) << 5)); }
__host__ __device__ __forceinline__ void stage_rc(int b, int& R, int& C) { const int st = b / 1024, sb = b % 1024, swz = sb ^ (((sb >> 9) & 1) << 5); R = (st >> 1) * 16 + swz / 64; C = (st & 1) * 32 + (swz % 64) / 2; }
__host__ __device__ __forceinline__ int perm32(int rho) { const int n = rho >> 4, i = rho & 15; return 8 * (i >> 2) + 4 * n + (i & 3); }

struct Unit { int pm, pn, aux; long aoff, boff; };
struct Gemm { const bf16_t* A; const bf16_t* Bt; int lda, ldb, K, rmulB; long hstepA, hstepB; };
__device__ __forceinline__ Gemm mk_gemm(const bf16_t* A, int lda, const bf16_t* Bt, int ldb, int K) { Gemm g; g.A = A; g.Bt = Bt; g.lda = lda; g.ldb = ldb; g.K = K; g.rmulB = 1; g.hstepA = (long)HALF * lda * 2; g.hstepB = (long)HALF * ldb * 2; return g; }

template <class Epi, class Sched>
__device__ __forceinline__ void gemm_phase(LAS unsigned char* lds, const Gemm g, const Sched& S, const Epi& E) {
    int tid_ = threadIdx.x; asm volatile("" : "+v"(tid_));
    const int tid = tid_, wid = __builtin_amdgcn_readfirstlane(tid >> 6), lane = tid & 63, wr = wid >> 2, wc = wid & 3, fr = lane & 15, fq = lane >> 4;
    const int K = g.K, nt = K / BK;
    unsigned voffA[2], voffB[2];
#pragma unroll
    for (int i = 0; i < 2; ++i) { int R, C; stage_rc(tid * 16 + i * 8192, R, C); const int Rb = (R & ~31) + perm32(R & 31);
        voffA[i] = (unsigned)(R * g.lda + C) * 2u; voffB[i] = (unsigned)(Rb * g.rmulB * g.ldb + C) * 2u; }
    const size_t kstep = (size_t)(BK * 2);
    const long hstepA = g.hstepA, hstepB = g.hstepB;
    const unsigned ldsw = (unsigned)wid * 1024u;
    const int aoff = lds_byte(wr * 64 + fr, fq * 8), boff = lds_byte(wc * 32 + fr, fq * 8);
#define PG8_SA(b, h) (((b) * 2 + (h)) * HTB)
#define PG8_SB(b, h) ((4 + (b) * 2 + (h)) * HTB)
#define PG8_STAGE(bufoff, gbase, voff) do { _Pragma("unroll") for (int _i = 0; _i < 2; ++_i) \
        __builtin_amdgcn_global_load_lds((const unsigned*)((const char*)(gbase) + (voff)[_i]), (LAS unsigned*)(lds + (bufoff) + ldsw + _i * 8192), 16, 0, 0); } while (0)
#define PG8_LDA(dst, b, h) do { _Pragma("unroll") for (int m = 0; m < 4; ++m) _Pragma("unroll") for (int k = 0; k < 2; ++k) dst[m][k] = *(const LAS bf16x8*)(lds + PG8_SA(b, h) + aoff + m * 2048 + k * 1024); } while (0)
#define PG8_LDB(dst, b, h) do { _Pragma("unroll") for (int n = 0; n < 2; ++n) _Pragma("unroll") for (int k = 0; k < 2; ++k) dst[n][k] = *(const LAS bf16x8*)(lds + PG8_SB(b, h) + boff + n * 2048 + k * 1024); } while (0)
#define PG8_MMA(ai, bj, At, Bt) do { __builtin_amdgcn_s_setprio(1); _Pragma("unroll") for (int m = 0; m < 4; ++m) _Pragma("unroll") for (int n = 0; n < 2; ++n) _Pragma("unroll") for (int k = 0; k < 2; ++k) \
        acc[ai][bj][m][n] = __builtin_amdgcn_mfma_f32_16x16x32_bf16(Bt[n][k], At[m][k], acc[ai][bj][m][n], 0, 0, 0); __builtin_amdgcn_s_setprio(0); } while (0)
#define PG8_WAIT_V(n) asm volatile("s_waitcnt vmcnt(" #n ")" ::: "memory")
#define PG8_WAIT_L(n) asm volatile("s_waitcnt lgkmcnt(" #n ")" ::: "memory")
#define PG8_BAR __builtin_amdgcn_s_barrier()
#define PG8_SCHED __builtin_amdgcn_sched_barrier(0)
    Unit cur, nxt; int ui = 0;
    if (!S.next(0, cur)) return;
    f32x4 acc[2][2][4][2];
#pragma unroll
    for (int a = 0; a < 2; ++a)
#pragma unroll
        for (int b = 0; b < 2; ++b)
#pragma unroll
            for (int m = 0; m < 4; ++m)
#pragma unroll
                for (int n = 0; n < 2; ++n) acc[a][b][m][n] = (f32x4){0.f, 0.f, 0.f, 0.f};
    bf16x8 At[4][2], B0[2][2], B1[2][2];
    const char* cA = (const char*)g.A + cur.aoff; const char* cB = (const char*)g.Bt + cur.boff;
    PG8_STAGE(PG8_SB(0, 0), cB, voffB); PG8_STAGE(PG8_SB(0, 1), cB + hstepB, voffB); PG8_STAGE(PG8_SA(0, 0), cA, voffA); PG8_STAGE(PG8_SA(0, 1), cA + hstepA, voffA);
    if (wr == 1) PG8_BAR;
    PG8_WAIT_V(2); PG8_BAR;
    PG8_STAGE(PG8_SB(1, 0), cB + kstep, voffB); PG8_STAGE(PG8_SA(1, 0), cA + kstep, voffA); PG8_STAGE(PG8_SB(1, 1), cB + hstepB + kstep, voffB);
    PG8_WAIT_V(6); PG8_BAR;
    for (;;) {
        const bool has_next = S.next(ui + 1, nxt);
        const char* nA = has_next ? (const char*)g.A + nxt.aoff : cA; const char* nB = has_next ? (const char*)g.Bt + nxt.boff : cB;
        for (int t = 0; t < nt; t += 2) {
            const bool last = (t == nt - 2);
            const char* a1 = cA + (size_t)(t + 1) * kstep;
            const char* a2 = last ? nA : cA + (size_t)(t + 2) * kstep; const char* b2 = last ? nB : cB + (size_t)(t + 2) * kstep;
            const char* a3 = a2 + kstep; const char* b3 = b2 + kstep;
            PG8_LDB(B0, 0, 0); PG8_LDB(B1, 0, 1); PG8_SCHED; PG8_LDA(At, 0, 0); PG8_STAGE(PG8_SA(1, 1), a1 + hstepA, voffA);
            PG8_WAIT_V(8); PG8_WAIT_L(0); PG8_BAR; PG8_MMA(0, 0, At, B0); PG8_MMA(0, 1, At, B1); PG8_BAR; PG8_SCHED;
            PG8_LDA(At, 0, 1); PG8_STAGE(PG8_SB(0, 0), b2, voffB); PG8_STAGE(PG8_SB(0, 1), b2 + hstepB, voffB); PG8_STAGE(PG8_SA(0, 0), a2, voffA);
            PG8_WAIT_V(8); PG8_WAIT_L(0); PG8_BAR; PG8_MMA(1, 0, At, B0); PG8_MMA(1, 1, At, B1); PG8_BAR; PG8_SCHED;
            PG8_LDB(B0, 1, 0); PG8_LDB(B1, 1, 1); PG8_SCHED; PG8_LDA(At, 1, 0); PG8_STAGE(PG8_SA(0, 1), a2 + hstepA, voffA);
            PG8_WAIT_V(8); PG8_WAIT_L(0); PG8_BAR; PG8_MMA(0, 0, At, B0); PG8_MMA(0, 1, At, B1); PG8_BAR; PG8_SCHED;
            PG8_LDA(At, 1, 1); PG8_STAGE(PG8_SB(1, 0), b3, voffB); PG8_STAGE(PG8_SB(1, 1), b3 + hstepB, voffB); PG8_STAGE(PG8_SA(1, 0), a3, voffA);
            PG8_WAIT_V(8); PG8_WAIT_L(0); PG8_BAR; PG8_MMA(1, 0, At, B0); PG8_MMA(1, 1, At, B1); PG8_BAR; PG8_SCHED;
        }
        if (wr == 0) PG8_BAR;
        E(acc, cur, wr, wc, fr, fq);
        if (!has_next) break;
#pragma unroll
        for (int a = 0; a < 2; ++a)
#pragma unroll
            for (int b = 0; b < 2; ++b)
#pragma unroll
                for (int m = 0; m < 4; ++m)
#pragma unroll
                    for (int n = 0; n < 2; ++n) acc[a][b][m][n] = (f32x4){0.f, 0.f, 0.f, 0.f};
        cur = nxt; cA = nA; cB = nB; ++ui;
        if (wr == 1) PG8_BAR;
    }
    PG8_WAIT_V(0);
    PG8_BAR;
#undef PG8_SA
#undef PG8_SB
#undef PG8_STAGE
#undef PG8_LDA
#undef PG8_LDB
#undef PG8_MMA
#undef PG8_WAIT_V
#undef PG8_WAIT_L
#undef PG8_BAR
#undef PG8_SCHED
}

struct TileOrder {
    int nM, nN, nwg, G, c, xpm, xlo, xn; long tA, tB;
    __device__ __forceinline__ void init(int nM_, int nN_, int G_, int c_, long tA_, long tB_) { nM = nM_; nN = nN_; nwg = nM * nN; G = G_; c = c_; tA = tA_; tB = tB_; xpm = 0; xlo = 0; xn = 0; }
    __device__ __forceinline__ bool next(int i, Unit& u) const {
        const long L = (long)i * G + c;
        if (L < nwg) {
            int wgid = (int)L; { const int q = nwg / NXCD, r = nwg % NXCD, xcd = wgid % NXCD, off = wgid / NXCD; wgid = (xcd < r ? xcd * (q + 1) : r * (q + 1) + (xcd - r) * q) + off; }
            const int nig = WGM * nN, gid = wgid / nig, fm = gid * WGM, gsz = (nM - fm) < WGM ? (nM - fm) : WGM;
            u.pm = fm + ((wgid % nig) % gsz); u.pn = (wgid % nig) / gsz;
        } else if (L < nwg + xn) { u.pm = xpm; u.pn = xlo + (int)(L - nwg); }
        else return false;
        u.aux = 0; u.aoff = u.pm * tA; u.boff = u.pn * tB; return true;
    }
};
struct F1Order { int G, c;
    __device__ __forceinline__ bool next(int i, Unit& u) const { const int L = i * G + c; if (L >= 512) return false;
        u.pn = L & 63; u.pm = (L >> 6) & 1; u.aux = L >> 7; u.aoff = (long)u.pm * 256 * 256 * 2; u.boff = (long)u.aux * 512 + (long)(2 * u.pn) * FD * 2; return true; } };
struct F1cOrder { int G, c;
    __device__ __forceinline__ bool next(int i, Unit& u) const { const int L = i * G + c; if (L >= 8) return false;
        u.pn = 0; u.pm = L & 1; u.aux = L >> 1; u.aoff = (long)u.pm * 256 * 256 * 2; u.boff = ((long)SEQ * FD + u.aux * 256) * 2; return true; } };
struct LinOrder { int G, c, n; long tB;
    __device__ __forceinline__ bool next(int i, Unit& u) const { const int L = i * G + c; if (L >= n) return false;
        u.pn = L; u.pm = 0; u.aux = 0; u.aoff = 0; u.boff = (long)L * tB; return true; } };
struct MoeOrder { int G, c, nN; int cum[9]; long tA, tB, eB;
    __device__ __forceinline__ bool next(int i, Unit& u) const { const int L = i * G + c; const int T = cum[8]; if (L >= T * nN) return false;
        const int ti = L % T, pn = L / T; int e = 0;
#pragma unroll
        for (int k = 1; k < 8; ++k) e += (ti >= cum[k]) ? 1 : 0;
        u.pm = ti; u.pn = pn; u.aux = e; u.aoff = (long)ti * tA; u.boff = (long)e * eB + (long)pn * tB; return true; } };

#define EPI_ARGS const f32x4 (&acc)[2][2][4][2], const Unit& u, int wr, int wc, int fr, int fq
__device__ __forceinline__ u32x4 pack8(f32x4 v0, f32x4 v1) { u32x4 w; w.x = cvt_pk_bf16(v0[0], v0[1]); w.y = cvt_pk_bf16(v0[2], v0[3]); w.z = cvt_pk_bf16(v1[0], v1[1]); w.w = cvt_pk_bf16(v1[2], v1[3]); return w; }
__device__ __forceinline__ void unpack8(u32x4 w, f32x4& v0, f32x4& v1) { v0 = (f32x4){bflo(w.x), bfhi(w.x), bflo(w.y), bfhi(w.y)}; v1 = (f32x4){bflo(w.z), bfhi(w.z), bflo(w.w), bfhi(w.w)}; }

struct EpiInProj {
    bf16_t *Q, *Kb, *Vb, *Fb, *Gb; const float* bgate;
    __device__ __forceinline__ void operator()(EPI_ARGS) const {
        const int pn = u.pn; bf16_t* base; int ldc, c0; bool sig = false;
        if (pn < 8) { base = Q; ldc = QW; c0 = pn * 256; }
        else if (pn < 10) { base = Kb; ldc = KVW; c0 = (pn - 8) * 256; }
        else if (pn < 12) { base = Vb; ldc = KVW; c0 = (pn - 10) * 256; }
        else if (pn < 16) { base = Fb; ldc = FD; c0 = (pn - 12) * 256; }
        else { base = Gb; ldc = GW2; c0 = (pn - 16) * 256; sig = true; }
        const int row0 = u.pm * BM + wr * 64 + fr, col0 = c0 + wc * 32 + 8 * fq;
        f32x4 bv[2][2];
#pragma unroll
        for (int bj = 0; bj < 2; ++bj)
#pragma unroll
            for (int n = 0; n < 2; ++n) bv[bj][n] = sig ? *(const f32x4*)(bgate + col0 + bj * HALF + 4 * n) : (f32x4){0.f, 0.f, 0.f, 0.f};
#pragma unroll
        for (int ai = 0; ai < 2; ++ai)
#pragma unroll
            for (int m = 0; m < 4; ++m) { bf16_t* rowp = base + (size_t)(row0 + ai * HALF + m * 16) * ldc + col0;
#pragma unroll
                for (int bj = 0; bj < 2; ++bj) { f32x4 v0 = acc[ai][bj][m][0] + bv[bj][0], v1 = acc[ai][bj][m][1] + bv[bj][1];
                    if (sig) {
#pragma unroll
                        for (int j = 0; j < 4; ++j) { v0[j] = sigmoidf_(v0[j]); v1[j] = sigmoidf_(v1[j]); } }
                    *(u32x4*)(rowp + bj * HALF) = pack8(v0, v1); } }
    }
};
struct EpiF1 {
    bf16_t* ZA;
    __device__ __forceinline__ void operator()(EPI_ARGS) const {
        const int g = u.aux, reim = u.pm;
#pragma unroll
        for (int ai = 0; ai < 2; ++ai)
#pragma unroll
            for (int m = 0; m < 4; ++m) { const int mm = ai * HALF + wr * 64 + m * 16 + fr;
#pragma unroll
                for (int bj = 0; bj < 2; ++bj) { const int a = 2 * u.pn + bj, b = wc * 32 + 8 * fq;
                    *(u32x4*)(ZA + ((size_t)((g * 256 + mm) * 128 + a) * 256 + reim * 128 + b)) = pack8(acc[ai][bj][m][0], acc[ai][bj][m][1]); } }
    }
};
struct EpiF1c {
    bf16_t* ZC;
    __device__ __forceinline__ void operator()(EPI_ARGS) const {
        const int g = u.aux, reim = u.pm;
#pragma unroll
        for (int ai = 0; ai < 2; ++ai)
#pragma unroll
            for (int m = 0; m < 4; ++m) { const int mm = ai * HALF + wr * 64 + m * 16 + fr;
#pragma unroll
                for (int bj = 0; bj < 2; ++bj) { const int n = bj * HALF + wc * 32 + 8 * fq;
                    *(u32x4*)(ZC + ((size_t)(g * 256 + mm) * 512 + reim * 256 + n)) = pack8(acc[ai][bj][m][0], acc[ai][bj][m][1]); } }
    }
};
struct EpiF2 {
    bf16_t* YB;
    __device__ __forceinline__ void operator()(EPI_ARGS) const {
#pragma unroll
        for (int m = 0; m < 4; ++m) { int ka = wr * 64 + m * 16 + fr; asm volatile("" : "+v"(ka));
#pragma unroll
            for (int bj = 0; bj < 2; ++bj) { const int gm = 2 * u.pn + bj, g = gm >> 8, mm = gm & 255, a0 = wc * 32 + 8 * fq;
                f32x4 re[2], im[2];
#pragma unroll
                for (int n = 0; n < 2; ++n)
#pragma unroll
                    for (int j = 0; j < 4; ++j) { const int a = a0 + 4 * n + j; const float t = (float)(a * ka) * (1.0f / 16384.0f);
                        const float c = __builtin_amdgcn_cosf(t), s = __builtin_amdgcn_sinf(t);
                        const float yr = acc[0][bj][m][n][j], yi = acc[1][bj][m][n][j];
                        re[n][j] = yr * c + yi * s; im[n][j] = yi * c - yr * s; }
                bf16_t* p = YB + ((size_t)((g * 128 + ka) * 256 + mm) * 256 + a0);
                *(u32x4*)p = pack8(re[0], re[1]); *(u32x4*)(p + 128) = pack8(im[0], im[1]); asm volatile("" ::: "memory"); } }
    }
};
struct EpiF3 {
    bf16_t* FOUR;
    __device__ __forceinline__ void operator()(EPI_ARGS) const {
        const int g = u.pn >> 7, ka = u.pn & 127;
#pragma unroll
        for (int m = 0; m < 4; ++m) { const int kb = wr * 64 + m * 16 + fr;
#pragma unroll
            for (int bj = 0; bj < 2; ++bj) { const int mm = bj * HALF + wc * 32 + 8 * fq;
                *(u32x4*)(FOUR + ((size_t)(128 * kb + ka) * FD + g * 256 + mm)) = pack8(acc[0][bj][m][0], acc[0][bj][m][1]); } }
    }
};
struct EpiF3c {
    bf16_t* FOUR;
    __device__ __forceinline__ void operator()(EPI_ARGS) const {
#pragma unroll
        for (int ai = 0; ai < 2; ++ai)
#pragma unroll
            for (int m = 0; m < 4; ++m) { const int k = ai * HALF + wr * 64 + m * 16 + fr;
#pragma unroll
                for (int bj = 0; bj < 2; ++bj) { const int mm = bj * HALF + wc * 32 + 8 * fq;
                    *(u32x4*)(FOUR + ((size_t)(SEQ + k) * FD + u.pn * 256 + mm)) = pack8(acc[ai][bj][m][0], acc[ai][bj][m][1]); } }
    }
};
template <int SECOND> struct EpiMerge {
    bf16_t* Y; const bf16_t* Gb;
    __device__ __forceinline__ void operator()(EPI_ARGS) const {
        const int row0 = u.pm * BM + wr * 64 + fr, col0 = u.pn * BM + wc * 32 + 8 * fq;
#pragma unroll
        for (int ai = 0; ai < 2; ++ai)
#pragma unroll
            for (int m = 0; m < 4; ++m) { const size_t row = (size_t)(row0 + ai * HALF + m * 16);
#pragma unroll
                for (int bj = 0; bj < 2; ++bj) { const int col = col0 + bj * HALF;
                    f32x4 g0, g1; unpack8(*(const u32x4*)(Gb + row * GW2 + SECOND * DM + col), g0, g1);
                    f32x4 v0 = acc[ai][bj][m][0] * g0, v1 = acc[ai][bj][m][1] * g1;
                    bf16_t* yp = Y + row * DM + col;
                    if (SECOND) { f32x4 y0, y1; unpack8(*(const u32x4*)yp, y0, y1); v0 += y0; v1 += y1; }
                    *(u32x4*)yp = pack8(v0, v1); } }
    }
};
struct EpiRes {
    const float* baseL; float* outL; const float* gateL; const float* baseC; float* outC; const float* gateC;
    __device__ __forceinline__ void operator()(EPI_ARGS) const {
        const bool isc = u.pm >= SEQ / BM; const float* base = isc ? baseC : baseL; float* out = isc ? outC : outL; const float* gate = isc ? gateC : gateL;
        const int row0 = (isc ? 0 : u.pm * BM) + wr * 64 + fr, col0 = u.pn * BM + wc * 32 + 8 * fq;
        f32x4 gv[2][2];
#pragma unroll
        for (int bj = 0; bj < 2; ++bj)
#pragma unroll
            for (int n = 0; n < 2; ++n) gv[bj][n] = *(const f32x4*)(gate + col0 + bj * HALF + 4 * n);
#pragma unroll
        for (int ai = 0; ai < 2; ++ai)
#pragma unroll
            for (int m = 0; m < 4; ++m) { const size_t off = (size_t)(row0 + ai * HALF + m * 16) * DM + col0;
#pragma unroll
                for (int bj = 0; bj < 2; ++bj)
#pragma unroll
                    for (int n = 0; n < 2; ++n) { const f32x4 b = *(const f32x4*)(base + off + bj * HALF + 4 * n);
                        *(f32x4*)(out + off + bj * HALF + 4 * n) = b + gv[bj][n] * acc[ai][bj][m][n]; }
                asm volatile("" ::: "memory"); }
    }
};
struct EpiSwiglu {
    bf16_t* U; int ldu;
    __device__ __forceinline__ void operator()(EPI_ARGS) const {
        const int row0 = u.pm * BM + wr * 64 + fr, col0 = u.pn * HALF + wc * 32 + 8 * fq;
#pragma unroll
        for (int ai = 0; ai < 2; ++ai)
#pragma unroll
            for (int m = 0; m < 4; ++m) { f32x4 o[2];
#pragma unroll
                for (int n = 0; n < 2; ++n)
#pragma unroll
                    for (int j = 0; j < 4; ++j) { const float gt = acc[ai][0][m][n][j], up = acc[ai][1][m][n][j]; o[n][j] = gt * sigmoidf_(gt) * up; }
                *(u32x4*)(U + (size_t)(row0 + ai * HALF + m * 16) * ldu + col0) = pack8(o[0], o[1]); }
    }
};
struct EpiPlain {
    bf16_t* O; int ldc;
    __device__ __forceinline__ void operator()(EPI_ARGS) const {
        const int row0 = u.pm * BM + wr * 64 + fr, col0 = u.pn * BM + wc * 32 + 8 * fq;
#pragma unroll
        for (int ai = 0; ai < 2; ++ai)
#pragma unroll
            for (int m = 0; m < 4; ++m) { bf16_t* rowp = O + (size_t)(row0 + ai * HALF + m * 16) * ldc + col0;
#pragma unroll
                for (int bj = 0; bj < 2; ++bj) *(u32x4*)(rowp + bj * HALF) = pack8(acc[ai][bj][m][0], acc[ai][bj][m][1]); }
    }
};
}

namespace at {
using bf16 = __hip_bfloat16;
constexpr int D = 128, NW = 8, QBLK = 32, KVBLK = 64;
constexpr float SCALE = 0.088388347648318440f;
constexpr float THR = 8.f;
constexpr int LDQ = QW, LDK = KVW, LDO = QW;
constexpr size_t SHM_V = KVBLK * D * 2, SHM_K = KVBLK * D * 2, SHM_ATTN = 2 * SHM_V + 2 * SHM_K + NW * 64 * 4;
#define KSWZ(row, colB) ((row) * 256 + ((colB) ^ (((row) & 7) << 4)))
#define SBAR() __builtin_amdgcn_sched_barrier(0)
__device__ __forceinline__ int crow(int r, int hi) { return (r & 3) + 8 * (r >> 2) + 4 * hi; }
__device__ __forceinline__ unsigned cvtpk(float lo, float hi) { unsigned r; asm volatile("v_cvt_pk_bf16_f32 %0, %1, %2" : "=v"(r) : "v"(lo), "v"(hi)); return r; }
__device__ __forceinline__ void partialSM(f32x16& p0, f32x16& p1, float& m_reg, float& mn, float& alpha) {
  constexpr float C = SCALE * 1.4426950408889634f;
  float pmax = p0[0]; for (int r = 1; r < 16; ++r) pmax = fmaxf(pmax, p0[r]); for (int r = 0; r < 16; ++r) pmax = fmaxf(pmax, p1[r]);
  { auto rr = __builtin_amdgcn_permlane32_swap(__float_as_uint(pmax), __float_as_uint(pmax), false, false);
    pmax = fmaxf(__uint_as_float(rr[0]), __uint_as_float(rr[1])); }
  if (__builtin_expect(__all(pmax - m_reg <= THR / SCALE), 1)) { mn = m_reg; alpha = 1.f; }
  else { mn = fmaxf(m_reg, pmax); alpha = __builtin_amdgcn_exp2f((m_reg - mn) * C); m_reg = mn; }
  float mnC = -mn * C;
  for (int r = 0; r < 16; ++r) p0[r] = fmaf(p0[r], C, mnC); for (int r = 0; r < 16; ++r) p1[r] = fmaf(p1[r], C, mnC);
  for (int r = 0; r < 16; ++r) p0[r] = __builtin_amdgcn_exp2f(p0[r]);
}
__device__ __forceinline__ void finishSM(f32x16& p0, f32x16& p1, float alpha, float& l_reg, bf16x8& pa0, bf16x8& pa1, bf16x8& pa2, bf16x8& pa3) {
  for (int r = 0; r < 16; ++r) p1[r] = __builtin_amdgcn_exp2f(p1[r]);
  float ps = 0; for (int r = 0; r < 16; ++r) ps += p0[r]; for (int r = 0; r < 16; ++r) ps += p1[r];
  { auto rr = __builtin_amdgcn_permlane32_swap(__float_as_uint(ps), __float_as_uint(ps), false, false);
    ps = __uint_as_float(rr[0]) + __uint_as_float(rr[1]); }
  l_reg = l_reg * alpha + ps;
#define PK4(P, BASE, OUT) do { unsigned a0 = cvtpk(P[BASE + 0], P[BASE + 1]), a1 = cvtpk(P[BASE + 2], P[BASE + 3]);   \
    unsigned b0 = cvtpk(P[BASE + 4], P[BASE + 5]), b1 = cvtpk(P[BASE + 6], P[BASE + 7]);                              \
    auto r0 = __builtin_amdgcn_permlane32_swap(a0, b0, false, false); auto r1 = __builtin_amdgcn_permlane32_swap(a1, b1, false, false); \
    u32x4 w = {r0[0], r1[0], r0[1], r1[1]}; OUT = *reinterpret_cast<bf16x8*>(&w); } while (0)
  PK4(p0, 0, pa0); PK4(p0, 8, pa1); PK4(p1, 0, pa2); PK4(p1, 8, pa3);
#undef PK4
}
__device__ __forceinline__ void qkt(f32x16& p0, f32x16& p1, const bf16* Ks, const bf16x8* qr, int r32, int hi) {
  p0 = f32x16{}; p1 = f32x16{};
  for (int d0 = 0; d0 < 8; ++d0) { int cb = (d0 * 16 + hi * 8) * 2;
    bf16x8 b0 = *reinterpret_cast<const bf16x8*>((const char*)Ks + KSWZ(r32, cb));
    bf16x8 b1 = *reinterpret_cast<const bf16x8*>((const char*)Ks + KSWZ(32 + r32, cb));
    p0 = __builtin_amdgcn_mfma_f32_32x32x16_bf16(b0, qr[d0], p0, 0, 0, 0);
    p1 = __builtin_amdgcn_mfma_f32_32x32x16_bf16(b1, qr[d0], p1, 0, 0, 0); }
}
__device__ __forceinline__ int v_st(int k, int c) { const int kk = (k & ~0xC) | ((k & 4) << 1) | ((k & 8) >> 1); return ((kk >> 3) * 4 + (c >> 5)) * 512 + ((kk & 7) * 32 + (c & 31)) * 2; }
__device__ __forceinline__ int v_rd_base(int lane) { return ((lane & 3) << 3) | (((lane >> 2) & 3) << 6) | (((lane >> 4) & 1) << 5) | (((lane >> 5) & 1) << 8); }
constexpr int v_rd_off(int d0, int ks, int half) { return d0 * 512 + ks * 4096 + half * 2048; }
template <int OFF> __device__ __forceinline__ s16x4 tr_read(int vb) {
  s16x4 r; asm volatile("ds_read_b64_tr_b16 %0, %1 offset:%2" : "=&v"(r) : "v"(vb), "i"(OFF) : "memory"); return r;
}
template <int D0> __device__ __forceinline__ void pv_one(f32x16& od, int vb, bf16x8 pa0, bf16x8 pa1, bf16x8 pa2, bf16x8 pa3) {
  const s16x4 l0 = tr_read<v_rd_off(D0, 0, 0)>(vb), h0 = tr_read<v_rd_off(D0, 0, 1)>(vb), l1 = tr_read<v_rd_off(D0, 1, 0)>(vb), h1 = tr_read<v_rd_off(D0, 1, 1)>(vb);
  const s16x4 l2 = tr_read<v_rd_off(D0, 2, 0)>(vb), h2 = tr_read<v_rd_off(D0, 2, 1)>(vb), l3 = tr_read<v_rd_off(D0, 3, 0)>(vb), h3 = tr_read<v_rd_off(D0, 3, 1)>(vb);
  asm volatile("s_waitcnt lgkmcnt(0)" ::: "memory"); SBAR();
#define PK(L, H) (bf16x8){L[0], L[1], L[2], L[3], H[0], H[1], H[2], H[3]}
  od = __builtin_amdgcn_mfma_f32_32x32x16_bf16(pa0, PK(l0, h0), od, 0, 0, 0);
  od = __builtin_amdgcn_mfma_f32_32x32x16_bf16(pa1, PK(l1, h1), od, 0, 0, 0);
  od = __builtin_amdgcn_mfma_f32_32x32x16_bf16(pa2, PK(l2, h2), od, 0, 0, 0);
  od = __builtin_amdgcn_mfma_f32_32x32x16_bf16(pa3, PK(l3, h3), od, 0, 0, 0);
#undef PK
}
__device__ __forceinline__ void pv_d0(f32x16* o, int vb, bf16x8 pa0, bf16x8 pa1, bf16x8 pa2, bf16x8 pa3) {
  pv_one<0>(o[0], vb, pa0, pa1, pa2, pa3); pv_one<1>(o[1], vb, pa0, pa1, pa2, pa3); pv_one<2>(o[2], vb, pa0, pa1, pa2, pa3); pv_one<3>(o[3], vb, pa0, pa1, pa2, pa3);
}
__device__ __forceinline__ void attn_dense_body(const bf16* Qb, const bf16* __restrict__ Kh, const bf16* __restrict__ Vh, bf16* Ob, int seq, char* lds) {
  int tid_ = threadIdx.x; asm volatile("" : "+v"(tid_));
  const int tid = tid_, wid = tid >> 6, lane = tid & 63, r32 = lane & 31, hi = lane >> 5;
  bf16* V_lds = (bf16*)lds; bf16* K_lds = (bf16*)(lds + 2 * SHM_V);
  float* ws = (float*)(lds + 2 * SHM_V + 2 * SHM_K) + wid * 64; float* li_l = ws; float* al_l = ws + 32;
  float m_reg = -1e30f, l_reg = 0; f32x16 o[4] = {}; bf16x8 qr[8];
  const bf16* Qw = Qb + (long)(wid * QBLK + r32) * LDQ + hi * 8;
#pragma unroll
  for (int d0 = 0; d0 < 8; ++d0) qr[d0] = *reinterpret_cast<const bf16x8*>(Qw + d0 * 16);
  const int sr = tid >> 4, sc = (tid & 15) * 8, vst0 = v_st(sr, sc), vst1 = v_st(32 + sr, sc);
  const int vb0 = (int)(uintptr_t)V_lds + v_rd_base(lane);
  struct { bf16x8 vs0, vs1, ks0, ks1; } sr_[2];
#define SLOAD(i, k0) do { sr_[i].vs0 = *(const bf16x8*)(&Vh[(long)((k0) + sr) * LDK + sc]); sr_[i].vs1 = *(const bf16x8*)(&Vh[(long)((k0) + 32 + sr) * LDK + sc]); \
    sr_[i].ks0 = *(const bf16x8*)(&Kh[(long)((k0) + sr) * LDK + sc]); sr_[i].ks1 = *(const bf16x8*)(&Kh[(long)((k0) + 32 + sr) * LDK + sc]); } while (0)
#define SWRITE(b, i) do { *(bf16x8*)((char*)V_lds + (b) * SHM_V + vst0) = sr_[i].vs0;          \
    *(bf16x8*)((char*)V_lds + (b) * SHM_V + vst1) = sr_[i].vs1; int kc = sc * 2;               \
    *(bf16x8*)((char*)K_lds + (b) * SHM_K + KSWZ(sr, kc)) = sr_[i].ks0;                       \
    *(bf16x8*)((char*)K_lds + (b) * SHM_K + KSWZ(32 + sr, kc)) = sr_[i].ks1; } while (0)
#define SWAIT() asm volatile("s_waitcnt vmcnt(4)" ::: "memory")
#define RESC(a) do { if (__any((a) < 1.f)) { if (hi == 0) al_l[r32] = (a); asm volatile("s_waitcnt lgkmcnt(0)" ::: "memory"); \
    for (int d = 0; d < 4; ++d) for (int r = 0; r < 16; ++r) o[d][r] *= al_l[crow(r, hi)]; } } while (0)
  f32x16 pA0, pA1, pB0, pB1; float mnA, mnB, alA, alB; bf16x8 pa0, pa1, pa2, pa3; const int NT = seq / KVBLK;
  constexpr int SE = 0, SO = 1;
  SLOAD(SE, 0); asm volatile("s_waitcnt vmcnt(0)" ::: "memory"); SWRITE(0, SE); __syncthreads();
  qkt(pA0, pA1, K_lds, qr, r32, hi); partialSM(pA0, pA1, m_reg, mnA, alA);
  SLOAD(SO, KVBLK); if (2 < NT) SLOAD(SE, 2 * KVBLK);
  SWAIT(); SWRITE(1, SO); __syncthreads();
  for (int j = 1; j + 1 < NT; j += 2) {
    SBAR(); qkt(pB0, pB1, (bf16*)((char*)K_lds + SHM_K), qr, r32, hi);
    finishSM(pA0, pA1, alA, l_reg, pa0, pa1, pa2, pa3); SBAR();
    SLOAD(SO, (j + 2) * KVBLK); SBAR();
    pv_d0(o, vb0, pa0, pa1, pa2, pa3); partialSM(pB0, pB1, m_reg, mnB, alB);
    __syncthreads(); SWAIT(); SWRITE(0, SE);
    RESC(alB); __syncthreads();
    SBAR(); qkt(pA0, pA1, K_lds, qr, r32, hi);
    finishSM(pB0, pB1, alB, l_reg, pa0, pa1, pa2, pa3); SBAR();
    if (j + 3 < NT) SLOAD(SE, (j + 3) * KVBLK); SBAR();
    pv_d0(o, vb0 + (int)SHM_V, pa0, pa1, pa2, pa3); partialSM(pA0, pA1, m_reg, mnA, alA);
    __syncthreads(); SWAIT(); SWRITE(1, SO);
    RESC(alA); __syncthreads();
  }
  SBAR(); qkt(pB0, pB1, (bf16*)((char*)K_lds + SHM_K), qr, r32, hi);
  finishSM(pA0, pA1, alA, l_reg, pa0, pa1, pa2, pa3); SBAR();
  pv_d0(o, vb0, pa0, pa1, pa2, pa3); partialSM(pB0, pB1, m_reg, mnB, alB);
  __syncthreads(); RESC(alB);
  finishSM(pB0, pB1, alB, l_reg, pa0, pa1, pa2, pa3); SBAR();
  pv_d0(o, vb0 + (int)SHM_V, pa0, pa1, pa2, pa3);
  if (hi == 0) li_l[r32] = l_reg; asm volatile("s_waitcnt lgkmcnt(0)" ::: "memory");
  float rli[16];
#pragma unroll
  for (int r = 0; r < 16; ++r) rli[r] = __builtin_amdgcn_rcpf(li_l[crow(r, hi)]);
  unsigned short* Ow = (unsigned short*)Ob + (long)(wid * QBLK) * LDO;
#pragma unroll
  for (int r = 0; r < 16; ++r) { int orow = crow(r, hi);
    for (int d0 = 0; d0 < 4; ++d0) Ow[(long)orow * LDO + d0 * 32 + r32] = (unsigned short)f2bf(o[d0][r] * rli[r]); }
  __syncthreads();
#undef SLOAD
#undef SWRITE
#undef SWAIT
#undef RESC
}
}

struct Args { const float* in[23]; float* out; unsigned char* ws; int ph_lo, ph_hi; };

struct Frame {
    LAS unsigned char* lds; unsigned char* ldsg;
    gu32* ctl; unsigned char* ws;
    int tid, lane, wave, vcu, G, gw, NGW;
};
__device__ __forceinline__ Frame opaque(const Frame& F0) { Frame F = F0; int t = F0.tid; asm volatile("" : "+v"(t)); F.tid = t; F.lane = t & 63; return F; }

__device__ __forceinline__ void p0_transpose_item(const float* W, int N, bf16_t* WT, int ldt, int drow0, int k0, int n0, LAS float* scr, int lane) {
#pragma unroll 8
    for (int i = 0; i < 32; ++i) { const int kk = 2 * i + (lane >> 5); scr[kk * 33 + (lane & 31)] = W[(size_t)(k0 + kk) * N + n0 + (lane & 31)]; }
    LDS_WAIT(); asm volatile("" ::: "memory");
    const int c = lane & 7;
#pragma unroll
    for (int j = 0; j < 4; ++j) { const int n = (lane >> 3) + 8 * j; const LAS float* s = scr + (8 * c) * 33 + n;
        u32x4 o; o.x = pk2(s[0 * 33], s[1 * 33]); o.y = pk2(s[2 * 33], s[3 * 33]); o.z = pk2(s[4 * 33], s[5 * 33]); o.w = pk2(s[6 * 33], s[7 * 33]);
        *(GAS u32x4*)(WT + (size_t)(drow0 + n) * ldt + k0 + 8 * c) = o; }
    LDS_WAIT(); asm volatile("" ::: "memory");
}
__device__ __forceinline__ void p0_convert(Frame& F, const float* W, int K, int N, bf16_t* WT, int mode) {
    LAS float* scr = (LAS float*)(F.lds + F.wave * 16384);
    const int nblk = N / 32, nitems = (K / 64) * nblk;
    for (int it = F.gw; it < nitems; it += F.NGW) { const int kb = it / nblk, nb = it % nblk, n0 = nb * 32;
        const int drow0 = mode == 0 ? n0 : ((n0 >> 7) * 256 + (n0 & 127) + (mode == 2 ? 128 : 0));
        p0_transpose_item(W, N, WT, K, drow0, kb * 64, n0, scr, F.lane); }
}
__device__ __forceinline__ float siluf_(float x) { return x / (1.0f + __expf(-x)); }

__device__ __forceinline__ void p0_prologue(const Frame& F0, const Args& A) {
    Frame F = opaque(F0);
    unsigned char* ws = F.ws;
    if (F.gw < 1536) {
        const int task = F.gw, l = task / 768, rem = task % 768, chunk = rem / 16, slab = rem % 16;
        const float* w = A.in[4] + (size_t)l * DM * 12288 + chunk * 256 + F.lane * 4;
        const float* cv = A.in[1]; const float* xv = A.in[3];
        f32x4 a0 = {0.f, 0.f, 0.f, 0.f}, a1 = {0.f, 0.f, 0.f, 0.f};
#pragma unroll 8
        for (int k = slab * 128; k < slab * 128 + 128; ++k) { const f32x4 wv = *(const f32x4*)(w + (size_t)k * 12288); const float s0 = siluf_(cv[k]), s1 = siluf_(xv[k]); a0 += wv * s0; a1 += wv * s1; }
        float* part = (float*)(ws + WS_PART);
        *(f32x4*)(part + ((size_t)((slab * 2 + l) * 2 + 0) * 12288 + chunk * 256 + F.lane * 4)) = a0;
        *(f32x4*)(part + ((size_t)((slab * 2 + l) * 2 + 1) * 12288 + chunk * 256 + F.lane * 4)) = a1;
    }
    const int gtid = F.gw * 64 + F.lane, gstride = F.NGW * 64;
    { bf16_t* DC = (bf16_t*)(ws + WS_TAB + TAB_DC);
      for (int idx = gtid; idx < 512 * 256; idx += gstride) { const int r = idx >> 8, c = idx & 255, reim = r >> 8, m = r & 255, ph = (m * c) & 255; float s, co; sincospif((float)ph * (2.0f / 256.0f), &s, &co);
          DC[idx] = (bf16_t)f2bf((reim ? -s : co) * 0.0625f); }
      bf16_t* DN = (bf16_t*)(ws + WS_TAB + TAB_DN);
      for (int idx = gtid; idx < 256 * 256; idx += gstride) { const int r = idx >> 8, cc = idx & 255, ro = r >> 7, k = r & 127, ci = cc >> 7, b = cc & 127, ph = (k * b) & 127; float s, co; sincospif((float)ph * (2.0f / 128.0f), &s, &co);
          const float v = (ro == ci) ? co : (ro == 0 ? s : -s); DN[idx] = (bf16_t)f2bf(v * 0.08838834764831845f); }
      bf16_t* D2 = (bf16_t*)(ws + WS_TAB + TAB_D256);
      for (int idx = gtid; idx < 256 * 512; idx += gstride) { const int k = idx >> 9, cc = idx & 511, ci = cc >> 8, n = cc & 255, ph = (k * n) & 255; float s, co; sincospif((float)ph * (2.0f / 256.0f), &s, &co);
          D2[idx] = (bf16_t)f2bf((ci ? s : co) * 0.0625f); }
      float* rope = (float*)(ws + WS_TAB + TAB_ROPE);
      for (int idx = gtid; idx < 320 * 32; idx += gstride) { const int p = idx >> 5, j = idx & 31; const float inv = powf(10000.0f, -(float)j / 32.0f);
          const float pos = (float)(p < 256 ? p : p - 256); const float ang = pos * inv; float s, co; sincosf(ang, &s, &co);
          if (p < 256) { rope[p * 32 + j] = co; rope[8192 + p * 32 + j] = s; } else { rope[16384 + (p - 256) * 32 + j] = co; rope[16384 + 2048 + (p - 256) * 32 + j] = s; } }
    }
    for (int l = 0; l < 2; ++l) {
        p0_convert(F, A.in[8] + (size_t)l * DM * INC, DM, INC, (bf16_t*)(ws + WS_WIN) + (size_t)l * INC * DM, 0);
        p0_convert(F, A.in[12] + (size_t)l * QW * DM, QW, DM, (bf16_t*)(ws + WS_WAP) + (size_t)l * DM * QW, 0);
        p0_convert(F, A.in[13] + (size_t)l * FD * DM, FD, DM, (bf16_t*)(ws + WS_WFP) + (size_t)l * DM * FD, 0);
        p0_convert(F, A.in[14] + (size_t)l * DM * DM, DM, DM, (bf16_t*)(ws + WS_WOUT) + (size_t)l * DM * DM, 0);
    }
    p0_convert(F, A.in[15], DM, DFF, (bf16_t*)(ws + WS_WGU), 1);
    p0_convert(F, A.in[16], DM, DFF, (bf16_t*)(ws + WS_WGU), 2);
    p0_convert(F, A.in[17], DFF, DM, (bf16_t*)(ws + WS_WD), 0);
    for (int e = 0; e < NE; ++e) {
        p0_convert(F, A.in[19] + (size_t)e * DM * DFE, DM, DFE, (bf16_t*)(ws + WS_MGU) + (size_t)e * 2 * DFE * DM, 1);
        p0_convert(F, A.in[20] + (size_t)e * DM * DFE, DM, DFE, (bf16_t*)(ws + WS_MGU) + (size_t)e * 2 * DFE * DM, 2);
        p0_convert(F, A.in[21] + (size_t)e * DFE * DM, DFE, DM, (bf16_t*)(ws + WS_MD) + (size_t)e * DM * DFE, 0);
    }
}
__device__ __forceinline__ void p0b_mod(const Frame& F0, const Args& A) {
    Frame F = opaque(F0);
    const float* part = (const float*)(F.ws + WS_PART); float* mod = (float*)(F.ws + WS_MOD);
    for (int idx = F.gw * 64 + F.lane; idx < 2 * 2 * 12288; idx += F.NGW * 64) { const int l = idx / 24576, cond = (idx / 12288) & 1, col = idx % 12288;
        float s = A.in[5][l * 12288 + col];
#pragma unroll
        for (int slab = 0; slab < 16; ++slab) s += part[(size_t)((slab * 2 + l) * 2 + cond) * 12288 + col];
        mod[idx] = s; }
}

template <bool ROUTER>
__device__ __forceinline__ void norm_phase(const Frame& F0, const float* xl, const float* xc, int nrows, const float* gamma, const float* modL, const float* modC, int ksh, bf16_t* H,
                                           const float* router_w, i32x4* route, f32x2* rwt) {
    Frame F = opaque(F0);
    LAS float* PA = (LAS float*)F.lds;
    LAS float* PB = PA + 2 * DM;
    LAS float* RW = PB + 2 * DM;
    for (int i = F.tid; i < DM; i += 512) { const float g = gamma[i];
        PA[i] = g * (1.0f + modL[(ksh + 1) * DM + i]); PB[i] = modL[ksh * DM + i];
        PA[DM + i] = g * (1.0f + modC[(ksh + 1) * DM + i]); PB[DM + i] = modC[ksh * DM + i]; }
    if (ROUTER) for (int i = F.tid; i < DM * NE; i += 512) RW[i] = router_w[i];
    __syncthreads();
    for (int row = F.gw; row < nrows; row += F.NGW) {
        const bool isc = row >= SEQ; const float* src = isc ? xc + (size_t)(row - SEQ) * DM : xl + (size_t)row * DM;
        const LAS float* pa = PA + (isc ? DM : 0); const LAS float* pb = PB + (isc ? DM : 0);
        f32x4 v[8]; float ss = 0.f;
#pragma unroll
        for (int j = 0; j < 8; ++j) { v[j] = *(const f32x4*)(src + 4 * F.lane + 256 * j); ss += (v[j].x * v[j].x + v[j].y * v[j].y) + (v[j].z * v[j].z + v[j].w * v[j].w); }
        const float rstd = 1.0f / sqrtf(wave_sum(ss) * (1.0f / DM) + EPS);
        float lg[NE];
        if (ROUTER) {
#pragma unroll
            for (int e = 0; e < NE; ++e) lg[e] = 0.f; }
        bf16_t* orow = H + (size_t)row * DM;
#pragma unroll
        for (int j = 0; j < 8; ++j) { const int c0 = 4 * F.lane + 256 * j; const f32x4 a = *(const LAS f32x4*)(pa + c0), b = *(const LAS f32x4*)(pb + c0);
            const f32x4 h = v[j] * rstd * a + b;
            u32x2 o; o.x = pk2(h.x, h.y); o.y = pk2(h.z, h.w); *(u32x2*)(orow + c0) = o;
            if (ROUTER) {
#pragma unroll
                for (int q = 0; q < 4; ++q) { const f32x4 w0 = *(const LAS f32x4*)(RW + (c0 + q) * 8), w1 = *(const LAS f32x4*)(RW + (c0 + q) * 8 + 4);
                    lg[0] += h[q] * w0.x; lg[1] += h[q] * w0.y; lg[2] += h[q] * w0.z; lg[3] += h[q] * w0.w; lg[4] += h[q] * w1.x; lg[5] += h[q] * w1.y; lg[6] += h[q] * w1.z; lg[7] += h[q] * w1.w; asm volatile("" ::: "memory"); } } }
        if (ROUTER) {
#pragma unroll
            for (int e = 0; e < NE; ++e) lg[e] = wave_sum(lg[e]);
            int i1 = 0; float v1 = lg[0];
#pragma unroll
            for (int e = 1; e < NE; ++e) if (lg[e] > v1) { v1 = lg[e]; i1 = e; }
            int i2 = -1; float v2 = -3.0e38f;
#pragma unroll
            for (int e = 0; e < NE; ++e) if (e != i1 && lg[e] > v2) { v2 = lg[e]; i2 = e; }
            const float w1 = 1.0f / (1.0f + __expf(v2 - v1)), w2 = 1.0f - w1;
            if (F.lane == 0) { const int s1 = (int)__hip_atomic_fetch_add(F.ctl + CW_CNT + 64 * i1, 1u, RLX_AGENT), s2 = (int)__hip_atomic_fetch_add(F.ctl + CW_CNT + 64 * i2, 1u, RLX_AGENT);
                route[row] = (i32x4){i1, s1, i2, s2}; rwt[row] = (f32x2){w1, w2}; }
        }
    }
    __syncthreads();
}

__device__ __forceinline__ void qknorm_rope_phase(const Frame& F0, bf16_t* Q, bf16_t* Kb, const float* qg, const float* kg, int nrows, bool ctx_q) {
    Frame F = opaque(F0);
    const float* rope = (const float*)(F.ws + WS_TAB + TAB_ROPE);
    const int L = F.lane, axis = L >> 5, half = (L & 31) >> 4, j0 = 2 * (L & 15);
    const f32x2 gq = *(const f32x2*)(qg + 2 * L), gk = *(const f32x2*)(kg + 2 * L);
    for (int row = F.gw; row < nrows; row += F.NGW) {
        const bool isc = row >= SEQ;
        f32x2 cs = {1.f, 1.f}, sn = {0.f, 0.f};
        if (!isc) { const int p = axis ? (row & 63) : (row >> 6); const float* cb = rope + (axis ? 16384 : 0) + p * 32 + j0; const float* sb = cb + (axis ? 2048 : 8192);
            cs = *(const f32x2*)cb; sn = *(const f32x2*)sb; if (half == 0) { sn.x = -sn.x; sn.y = -sn.y; } }
        const int nq = (isc && !ctx_q) ? 0 : NH;
        unsigned* qrow = (unsigned*)(Q + (size_t)row * QW) + L; unsigned* krow = (unsigned*)(Kb + (size_t)row * KVW) + L;
#pragma unroll 4
        for (int h = 0; h < NH + NKV; ++h) { if (h < NH && h >= nq) continue;
            unsigned* p = h < NH ? qrow + h * 64 : krow + (h - NH) * 64; const f32x2 g = h < NH ? gq : gk;
            const unsigned w = *p; float x0 = bflo(w), x1 = bfhi(w);
            const float rs = 1.0f / sqrtf(wave_sum(x0 * x0 + x1 * x1) * (1.0f / HD) + EPS);
            x0 = x0 * rs * g.x; x1 = x1 * rs * g.y;
            const float y0 = __shfl_xor(x0, 16), y1 = __shfl_xor(x1, 16);
            *p = pk2(x0 * cs.x + y0 * sn.x, x1 * cs.y + y1 * sn.y); }
    }
}

__device__ __forceinline__ void moe_cum(Frame& F, int (&cum)[9], int (&rbase)[8]) {
    int t = 0;
#pragma unroll
    for (int e = 0; e < NE; ++e) { const unsigned c = __builtin_amdgcn_readfirstlane(__hip_atomic_load(F.ctl + CW_CNT + 64 * e, RLX_AGENT)); cum[e] = t; rbase[e] = t * 256; t += (int)((c + 255u) >> 8); }
    cum[8] = t;
}
__device__ __forceinline__ void moe_gather_phase(const Frame& F0, const bf16_t* H, bf16_t* HG, const i32x4* route, i32x2* pairpos) {
    Frame F = opaque(F0);
    int cum[9], rbase[8]; moe_cum(F, cum, rbase);
    LAS int* RB = (LAS int*)F.lds;
    if (F.tid == 0) {
#pragma unroll
        for (int e = 0; e < NE; ++e) RB[e] = rbase[e]; }
    __syncthreads();
    for (int t = F.gw; t < SEQ; t += F.NGW) { const i32x4 r = route[t]; const int p1 = RB[r.x] + r.y, p2 = RB[r.z] + r.w;
        const u32x4* s = (const u32x4*)(H + (size_t)t * DM) + F.lane; u32x4* d1 = (u32x4*)(HG + (size_t)p1 * DM) + F.lane; u32x4* d2 = (u32x4*)(HG + (size_t)p2 * DM) + F.lane;
#pragma unroll
        for (int j = 0; j < 4; ++j) { const u32x4 v = s[64 * j]; d1[64 * j] = v; d2[64 * j] = v; }
        if (F.lane == 0) pairpos[t] = (i32x2){p1, p2}; }
    __syncthreads();
}

__device__ __forceinline__ void final_phase(const Frame& F0, float* out, const bf16_t* OP, const i32x2* pairpos, const f32x2* rwt, const float* ga2, const float* fg, bool poison) {
    Frame F = opaque(F0);
    for (int row = F.gw; row < SEQ; row += F.NGW) { const i32x2 pp = pairpos[row]; const f32x2 w = rwt[row];
        float* xr = out + (size_t)row * DM; const bf16_t* o1 = OP + (size_t)pp.x * DM; const bf16_t* o2 = OP + (size_t)pp.y * DM;
        f32x4 v[8]; float ss = 0.f;
#pragma unroll
        for (int j = 0; j < 8; ++j) { const int c0 = 4 * F.lane + 256 * j; const f32x4 x = *(const f32x4*)(xr + c0), g = *(const f32x4*)(ga2 + c0);
            const u32x2 a = *(const u32x2*)(o1 + c0), b = *(const u32x2*)(o2 + c0);
            const f32x4 m = (f32x4){bflo(a.x), bfhi(a.x), bflo(a.y), bfhi(a.y)} * w.x + (f32x4){bflo(b.x), bfhi(b.x), bflo(b.y), bfhi(b.y)} * w.y;
            v[j] = x + g * m; ss += (v[j].x * v[j].x + v[j].y * v[j].y) + (v[j].z * v[j].z + v[j].w * v[j].w); }
        const float rstd = 1.0f / sqrtf(wave_sum(ss) * (1.0f / DM) + EPS);
#pragma unroll
        for (int j = 0; j < 8; ++j) { const int c0 = 4 * F.lane + 256 * j; f32x4 o = v[j] * rstd * *(const f32x4*)(fg + c0);
            if (poison) { const float q = __builtin_nanf(""); o = (f32x4){q, q, q, q}; }
            *(f32x4*)(xr + c0) = o; } }
}

constexpr int PH_P0 = 0, PH_P0B = 1, PH_L0 = 2, PH_PER_LAYER = 12, PH_END = PH_L0 + 2 * PH_PER_LAYER;

__global__ void __launch_bounds__(NWAVES * 64, 2) mk_fwd(Args args) {
    extern __shared__ __attribute__((aligned(16))) unsigned char lds[];
    Frame F;
    F.lds = (LAS unsigned char*)lds; F.ldsg = lds;
    volatile LAS unsigned* MISC = (volatile LAS unsigned*)(F.lds + MISC_OFF);
    F.tid = threadIdx.x; F.lane = F.tid & 63; F.wave = __builtin_amdgcn_readfirstlane(F.tid >> 6);
    F.G = gridDim.x; { const int bx = blockIdx.x; F.vcu = (F.G % 8 == 0) ? (bx % 8) * (F.G / 8) + bx / 8 : bx; }
    F.gw = F.vcu * NWAVES + F.wave; F.NGW = F.G * NWAVES;
    F.ws = args.ws; F.ctl = (gu32*)(args.ws + WS_CTL);
    for (int u = F.tid; u < (LDS_BYTES - LDSCTL_OFF) / 4; u += NWAVES * 64) ((LAS unsigned*)(F.lds + LDSCTL_OFF))[u] = 0u;
    __syncthreads();
    const int lo = args.ph_lo, hi = args.ph_hi;
    XcdBarrier bar; bar.bar = (unsigned*)(F.ctl + CW_BAR); bar.x = 0; bar.st = nullptr;
    if (!MK_SPLIT) bar = xcd_barrier_post((unsigned*)(F.ctl + CW_BAR), MISC + 8);
#ifndef PH_MASK
#define PH_MASK 0xFFFFFFFFu
#endif
#define PHT(k) ((k) < PH_L0 ? (k) : 2 + ((k) - PH_L0) % PH_PER_LAYER)
#define IN(k) (((PH_MASK >> PHT(k)) & 1u) && lo <= (k) && (k) < hi)
#define SEAM(k) do { if (!MK_SPLIT) xcd_barrier(bar); } while (0)
    unsigned char* ws = args.ws;
    bf16_t* Hb = (bf16_t*)(ws + WS_H); bf16_t* Qb = (bf16_t*)(ws + WS_Q); bf16_t* Kb = (bf16_t*)(ws + WS_K); bf16_t* Vb = (bf16_t*)(ws + WS_V);
    bf16_t* Fb = (bf16_t*)(ws + WS_F); bf16_t* Gb = (bf16_t*)(ws + WS_G); bf16_t* ZA = (bf16_t*)(ws + WS_ZA); bf16_t* YB = (bf16_t*)(ws + WS_YB);
    bf16_t* FOUR = (bf16_t*)(ws + WS_FOUR); bf16_t* ZC = (bf16_t*)(ws + WS_ZC); float* XC = (float*)(ws + WS_XC);
    bf16_t* Ub = (bf16_t*)(ws + WS_U); bf16_t* HG = (bf16_t*)(ws + WS_HG); bf16_t* UG = (bf16_t*)(ws + WS_UG);
    i32x4* route = (i32x4*)(ws + WS_ROUTE); f32x2* rwt = (f32x2*)(ws + WS_ROUTE + 256 * 1024); i32x2* pairpos = (i32x2*)(ws + WS_ROUTE + 512 * 1024);
    const bf16_t* DC = (const bf16_t*)(ws + WS_TAB + TAB_DC); const bf16_t* DN = (const bf16_t*)(ws + WS_TAB + TAB_DN); const bf16_t* D256 = (const bf16_t*)(ws + WS_TAB + TAB_D256);
    const float* MOD = (const float*)(ws + WS_MOD);
    const int bx = (int)blockIdx.x;

    if (IN(PH_P0)) { p0_prologue(F, args); __syncthreads(); SEAM(0); }
    if (IN(PH_P0B)) { p0b_mod(F, args); SEAM(1); }

#pragma unroll 1
    for (int l = 0; l < 2; ++l) {
        const int pb = PH_L0 + l * PH_PER_LAYER; const bool last = (l == 1);
        const float* modL = MOD + (size_t)(l * 2 + 0) * 12288; const float* modC = MOD + (size_t)(l * 2 + 1) * 12288;
        const float* xlat = (l == 0) ? args.in[0] : args.out; const float* xctx = (l == 0) ? args.in[2] : XC;
        if (IN(pb + 0)) { norm_phase<false>(F, xlat, xctx, MR, args.in[6] + l * DM, modL, modC, 0, Hb, nullptr, nullptr, nullptr); SEAM(pb); }
        if (IN(pb + 1)) {
            pg8::Gemm g = pg8::mk_gemm(Hb, DM, (const bf16_t*)(ws + WS_WIN) + (size_t)l * INC * DM, DM, DM);
            pg8::TileOrder S; S.init(last ? 64 : 65, 32, F.G, bx, (long)256 * DM * 2, (long)256 * DM * 2);
            if (last) { S.xpm = 64; S.xlo = 8; S.xn = 4; }
            pg8::EpiInProj E{Qb, Kb, Vb, Fb, Gb, args.in[9] + l * GW2};
            pg8::gemm_phase(F.lds, g, S, E);
            SEAM(pb + 1);
        }
        if (IN(pb + 2)) {
#ifndef NO_QKN
            qknorm_rope_phase(F, Qb, Kb, args.in[10] + l * HD, args.in[11] + l * HD, MR, !last);
#endif
#ifndef NO_F1
            { pg8::Gemm g = pg8::mk_gemm(DC, 256, Fb, FD, 256); g.rmulB = 128; g.hstepB = (long)FD * 2;
              pg8::F1Order S{F.G, bx}; pg8::EpiF1 E{ZA}; pg8::gemm_phase(F.lds, g, S, E); }
#endif
#ifndef NO_F1C
            if (!last) { pg8::Gemm g = pg8::mk_gemm(DC, 256, Fb, FD, 256);
              pg8::F1cOrder S{F.G, bx}; pg8::EpiF1c E{ZC}; pg8::gemm_phase(F.lds, g, S, E); }
#endif
            SEAM(pb + 2);
        }
        if (IN(pb + 3)) {
            pg8::Gemm g = pg8::mk_gemm(DN, 256, ZA, 256, 256);
            pg8::LinOrder S{F.G, bx, 512, (long)256 * 256 * 2}; pg8::EpiF2 E{YB}; pg8::gemm_phase(F.lds, g, S, E);
            SEAM(pb + 3);
        }
        if (IN(pb + 4)) {
#ifndef NO_F3
            { pg8::Gemm g = pg8::mk_gemm(DN, 256, YB, 256, 256);
              pg8::LinOrder S{F.G, bx, 512, (long)256 * 256 * 2}; pg8::EpiF3 E{FOUR}; pg8::gemm_phase(F.lds, g, S, E); }
#endif
#ifndef NO_F3C
            if (!last) { pg8::Gemm g = pg8::mk_gemm(D256, 512, ZC, 512, 512);
              pg8::LinOrder S{F.G, bx, 4, (long)256 * 512 * 2}; pg8::EpiF3c E{FOUR}; pg8::gemm_phase(F.lds, g, S, E); }
#endif
            __syncthreads();
#ifndef NO_ATTN
            const int nctx = last ? 0 : NH;
            for (int i = 0;; ++i) {
                int qh, qb, isc;
                if (F.G == 256) { const int xcd = F.vcu >> 5, c = F.vcu & 31;
                    if (i < 4) { qh = (xcd >> 1) * 4 + (xcd & 1) * 2 + (i >> 1); qb = (i & 1) * 32 + c; isc = 0; }
                    else if (i == 4 && F.vcu < nctx) { qh = F.vcu; qb = 0; isc = 1; }
                    else break; }
                else { const int Lu = i * F.G + bx; if (Lu < 1024) { qh = Lu >> 6; qb = Lu & 63; isc = 0; } else if (Lu < 1024 + nctx) { qh = Lu - 1024; qb = 0; isc = 1; } else break; }
                const size_t row0 = isc ? (size_t)SEQ : (size_t)qb * 256;
                const at::bf16* Qp = (const at::bf16*)(Qb + row0 * QW + qh * HD);
                const size_t kro = isc ? (size_t)SEQ * KVW : 0;
                const at::bf16* Kp = (const at::bf16*)(Kb + kro + (qh >> 2) * HD); const at::bf16* Vp = (const at::bf16*)(Vb + kro + (qh >> 2) * HD);
                at::attn_dense_body(Qp, Kp, Vp, (at::bf16*)(Qb + row0 * QW + qh * HD), isc ? CTXL : MR, (char*)lds);
            }
#endif
            SEAM(pb + 4);
        }
        if (IN(pb + 5)) {
            const int nM = last ? 64 : 65;
            { pg8::Gemm g = pg8::mk_gemm(Qb, QW, (const bf16_t*)(ws + WS_WAP) + (size_t)l * DM * QW, QW, QW);
              pg8::TileOrder S; S.init(nM, 8, F.G, bx, (long)256 * QW * 2, (long)256 * QW * 2); pg8::EpiMerge<0> E{Hb, Gb}; pg8::gemm_phase(F.lds, g, S, E); }
            { pg8::Gemm g = pg8::mk_gemm(FOUR, FD, (const bf16_t*)(ws + WS_WFP) + (size_t)l * DM * FD, FD, FD);
              pg8::TileOrder S; S.init(nM, 8, F.G, bx, (long)256 * FD * 2, (long)256 * FD * 2); pg8::EpiMerge<1> E{Hb, Gb}; pg8::gemm_phase(F.lds, g, S, E); }
            SEAM(pb + 5);
        }
        if (IN(pb + 6)) {
            pg8::Gemm g = pg8::mk_gemm(Hb, DM, (const bf16_t*)(ws + WS_WOUT) + (size_t)l * DM * DM, DM, DM);
            pg8::TileOrder S; S.init(last ? 64 : 65, 8, F.G, bx, (long)256 * DM * 2, (long)256 * DM * 2);
            pg8::EpiRes E{xlat, args.out, modL + 2 * DM, xctx, XC, modC + 2 * DM};
            pg8::gemm_phase(F.lds, g, S, E);
            SEAM(pb + 6);
        }
        if (IN(pb + 7)) {
            if (!last) norm_phase<false>(F, args.out, XC, MR, args.in[7] + l * DM, modL, modC, 3, Hb, nullptr, nullptr, nullptr);
            else norm_phase<true>(F, args.out, XC, SEQ, args.in[7] + l * DM, modL, modC, 3, Hb, args.in[18], route, rwt);
            SEAM(pb + 7);
        }
        if (!last) {
            if (IN(pb + 8)) {
                pg8::Gemm g = pg8::mk_gemm(Hb, DM, (const bf16_t*)(ws + WS_WGU), DM, DM);
                pg8::TileOrder S; S.init(65, 44, F.G, bx, (long)256 * DM * 2, (long)256 * DM * 2);
                pg8::EpiSwiglu E{Ub, DFF}; pg8::gemm_phase(F.lds, g, S, E);
                SEAM(pb + 8);
            }
            if (IN(pb + 9)) {
                pg8::Gemm g = pg8::mk_gemm(Ub, DFF, (const bf16_t*)(ws + WS_WD), DFF, DFF);
                pg8::TileOrder S; S.init(65, 8, F.G, bx, (long)256 * DFF * 2, (long)256 * DFF * 2);
                pg8::EpiRes E{args.out, args.out, modL + 5 * DM, XC, XC, modC + 5 * DM};
                pg8::gemm_phase(F.lds, g, S, E);
                SEAM(pb + 9);
            }
        } else {
            if (IN(pb + 8)) { moe_gather_phase(F, Hb, HG, route, pairpos); SEAM(pb + 8); }
            if (IN(pb + 9)) {
                int rbase[8]; pg8::MoeOrder S; S.G = F.G; S.c = bx; S.nN = 22; moe_cum(F, S.cum, rbase); S.tA = (long)256 * DM * 2; S.tB = (long)256 * DM * 2; S.eB = (long)2 * DFE * DM * 2;
                pg8::Gemm g = pg8::mk_gemm(HG, DM, (const bf16_t*)(ws + WS_MGU), DM, DM);
                pg8::EpiSwiglu E{UG, DFE}; pg8::gemm_phase(F.lds, g, S, E);
                SEAM(pb + 9);
            }
            if (IN(pb + 10)) {
                int rbase[8]; pg8::MoeOrder S; S.G = F.G; S.c = bx; S.nN = 8; moe_cum(F, S.cum, rbase); S.tA = (long)256 * DFE * 2; S.tB = (long)256 * DFE * 2; S.eB = (long)DM * DFE * 2;
                pg8::Gemm g = pg8::mk_gemm(UG, DFE, (const bf16_t*)(ws + WS_MD), DFE, DFE);
                pg8::EpiPlain E{HG, DM}; pg8::gemm_phase(F.lds, g, S, E);
                SEAM(pb + 10);
            }
            if (IN(pb + 11)) {
                bool poison = false;
                if (!MK_SPLIT) poison = __hip_atomic_load((gu32*)((unsigned*)(F.ctl + CW_BAR) + XB_TMO), RLX_AGENT) != 0u;
                final_phase(F, args.out, HG, pairpos, rwt, modL + 5 * DM, args.in[22], poison);
            }
        }
    }
#undef IN
#undef SEAM
}

extern "C" void kernel_launch(void* const* d_in, const int* in_sizes, int n_in, void* d_out, int out_size, void* d_ws, size_t ws_size, hipStream_t stream) {
    static int grid = 0;
    if (grid == 0) {
        if (n_in != 23 || out_size != SEQ * DM || ws_size < WS_END) { fprintf(stderr, "kernel_launch: unexpected shapes (n_in %d out %d ws %zu)\n", n_in, out_size, ws_size); grid = -1; return; }
        int dev = 0, cus = 0, per_cu = 0;
        if (hipGetDevice(&dev) != hipSuccess || hipDeviceGetAttribute(&cus, hipDeviceAttributeMultiprocessorCount, dev) != hipSuccess) { grid = -1; return; }
        if (hipFuncSetAttribute((const void*)mk_fwd, hipFuncAttributeMaxDynamicSharedMemorySize, LDS_BYTES) != hipSuccess) { grid = -1; return; }
        if (hipOccupancyMaxActiveBlocksPerMultiprocessor(&per_cu, (const void*)mk_fwd, NWAVES * 64, LDS_BYTES) != hipSuccess || per_cu < 1) fprintf(stderr, "kernel_launch: occupancy query says %d\n", per_cu);
        (void)hipGetLastError();
        grid = cus;
    }
    if (grid < 0) return;
    (void)hipMemsetAsync((char*)d_ws + WS_CTL, 0, CTL_ZERO_BYTES, stream);
    Args a{};
    for (int i = 0; i < 23; ++i) a.in[i] = (const float*)d_in[i];
    a.out = (float*)d_out; a.ws = (unsigned char*)d_ws;
#if MK_SPLIT
    for (int p = 0; p < PH_END; ++p) { a.ph_lo = p; a.ph_hi = p + 1; hipLaunchKernelGGL(mk_fwd, dim3(grid), dim3(NWAVES * 64), LDS_BYTES, stream, a); }
#else
    a.ph_lo = 0; a.ph_hi = PH_END;
    hipLaunchKernelGGL(mk_fwd, dim3(grid), dim3(NWAVES * 64), LDS_BYTES, stream, a);
#endif
}
```

```cpp
#include <hip/hip_runtime.h>
#include <hip/hip_bf16.h>
#include <cstdio>
#include <cstdint>

#define GAS __attribute__((address_space(1)))
#define LAS __attribute__((address_space(3)))
typedef unsigned short bf16_t;
typedef short bf16x8 __attribute__((ext_vector_type(8)));
typedef short s16x4 __attribute__((ext_vector_type(4)));
typedef float f32x4 __attribute__((ext_vector_type(4)));
typedef float f32x2 __attribute__((ext_vector_type(2)));
typedef float f32x16 __attribute__((ext_vector_type(16)));
typedef unsigned u32x4 __attribute__((ext_vector_type(4)));
typedef unsigned u32x2 __attribute__((ext_vector_type(2)));
typedef int i32x4 __attribute__((ext_vector_type(4)));
typedef int i32x2 __attribute__((ext_vector_type(2)));
typedef GAS unsigned gu32;
#define RLX_AGENT __ATOMIC_RELAXED, __HIP_MEMORY_SCOPE_AGENT
#define LDS_WAIT() asm volatile("s_waitcnt lgkmcnt(0)" ::: "memory")
#define VM_WAIT() asm volatile("s_waitcnt vmcnt(0)" ::: "memory")

#ifndef MK_SPLIT
#define MK_SPLIT 0
#endif

constexpr int DM = 2048, SEQ = 16384, CTXL = 256, MR = SEQ + CTXL, NH = 16, NKV = 4, HD = 128;
constexpr int QW = 2048, KVW = 512, FD = 1024, GW2 = 4096, INC = 8192, DFF = 5632, NE = 8, DFE = 2816;
constexpr int PAIR_ROWS = 34816;
constexpr float EPS = 1e-6f;
constexpr int NWAVES = 8;

constexpr size_t MiB = 1u << 20;
constexpr size_t WS_CTL = 0, CTL_ZERO_BYTES = 1 * MiB;
constexpr size_t WS_WIN = 1 * MiB;
constexpr size_t WS_WAP = 65 * MiB;
constexpr size_t WS_WFP = 81 * MiB;
constexpr size_t WS_WOUT = 89 * MiB;
constexpr size_t WS_WGU = 105 * MiB;
constexpr size_t WS_WD = 149 * MiB;
constexpr size_t WS_MGU = 171 * MiB;
constexpr size_t WS_MD = 347 * MiB;
constexpr size_t WS_TAB = 435 * MiB;
constexpr size_t WS_PART = 436 * MiB;
constexpr size_t WS_MOD = 439 * MiB;
constexpr size_t WS_H = 440 * MiB;
constexpr size_t WS_Q = 505 * MiB;
constexpr size_t WS_K = 570 * MiB;
constexpr size_t WS_V = 587 * MiB;
constexpr size_t WS_F = 604 * MiB;
constexpr size_t WS_G = 637 * MiB;
constexpr size_t WS_ZA = 767 * MiB;
constexpr size_t WS_YB = 831 * MiB;
constexpr size_t WS_FOUR = 895 * MiB;
constexpr size_t WS_ZC = 928 * MiB;
constexpr size_t WS_XC = 929 * MiB;
constexpr size_t WS_ROUTE = 931 * MiB;
constexpr size_t WS_U = 505 * MiB;
constexpr size_t WS_HG = 505 * MiB;
constexpr size_t WS_UG = 641 * MiB;
constexpr size_t WS_PARTC = 932 * MiB;
constexpr size_t WS_VT = 956 * MiB;
constexpr size_t WS_XB = 974 * MiB;
constexpr size_t WS_END = 1038 * MiB;
static_assert(WS_UG + (size_t)PAIR_ROWS * DFE * 2 <= WS_ROUTE, "ws map");
static_assert(WS_U + (size_t)MR * DFF * 2 <= WS_ZA, "ws map");
constexpr size_t TAB_DC = 0;
constexpr size_t TAB_DN = 256 * 1024;
constexpr size_t TAB_D256 = 384 * 1024;
constexpr size_t TAB_ROPE = 640 * 1024;
constexpr int CW_TMO = 0, CW_CODE = 1, CW_DBG = 2, CW_CNT = 1024  , CW_BAR = 4096;

constexpr int RING_BYTES = 131072, LDSCTL_OFF = RING_BYTES, MISC_OFF = LDSCTL_OFF + 320;
constexpr int LDS_BYTES = 147456;

__device__ __forceinline__ int tid_of(int wave) { int l; asm volatile("v_mbcnt_lo_u32_b32 %0, -1, 0\n\tv_mbcnt_hi_u32_b32 %0, -1, %0" : "=v"(l)); return wave * 64 + l; }
__device__ __forceinline__ unsigned f2bf(float f) { unsigned u = __builtin_bit_cast(unsigned, f); return (u + 0x7fffu + ((u >> 16) & 1u)) >> 16; }
__device__ __forceinline__ unsigned pk2(float lo, float hi) { return f2bf(lo) | (f2bf(hi) << 16); }
__device__ __forceinline__ float bflo(unsigned w) { return __builtin_bit_cast(float, w << 16); }
__device__ __forceinline__ float bfhi(unsigned w) { return __builtin_bit_cast(float, w & 0xffff0000u); }
__device__ __forceinline__ unsigned cvt_pk_bf16(float lo, float hi) { unsigned r; asm volatile("v_cvt_pk_bf16_f32 %0, %1, %2" : "=v"(r) : "v"(lo), "v"(hi)); return r; }
template <int CTRL> __device__ __forceinline__ float dppf(float v) { return __builtin_bit_cast(float, __builtin_amdgcn_update_dpp(0, __builtin_bit_cast(int, v), CTRL, 0xF, 0xF, true)); }
__device__ __forceinline__ float xor16f(float v) { return __builtin_bit_cast(float, __builtin_amdgcn_ds_swizzle(__builtin_bit_cast(int, v), 0x401F)); }
__device__ __forceinline__ float wave_sum(float v) {
    v += dppf<0xB1>(v); v += dppf<0x4E>(v); v += dppf<0x141>(v); v += dppf<0x140>(v);
    v += xor16f(v);
    { auto rr = __builtin_amdgcn_permlane32_swap(__float_as_uint(v), __float_as_uint(v), false, false); v = __uint_as_float(rr[0]) + __uint_as_float(rr[1]); }
    return v;
}
__device__ __forceinline__ float wave_max(float v) {
    v = fmaxf(v, dppf<0xB1>(v)); v = fmaxf(v, dppf<0x4E>(v)); v = fmaxf(v, dppf<0x141>(v)); v = fmaxf(v, dppf<0x140>(v));
    v = fmaxf(v, xor16f(v));
    { auto rr = __builtin_amdgcn_permlane32_swap(__float_as_uint(v), __float_as_uint(v), false, false); v = fmaxf(__uint_as_float(rr[0]), __uint_as_float(rr[1])); }
    return v;
}
__device__ __forceinline__ float sigmoidf_(float x) { return __builtin_amdgcn_rcpf(1.0f + __builtin_amdgcn_exp2f(-1.4426950408889634f * x)); }

#define XB_TMO      128
#define XB_XCNT(j)  (256  + 64 * (j))
#define XB_XSUB(j)  (1280 + 64 * (j))
#define XB_XGEN(j)  (2304 + 64 * (j))
#define XB_TOP      3328
#define XB_TOPGEN   3392
#define XCD_BAR_WORDS 3456
#define XB_SPIN_CAP (1u << 18)
__device__ __forceinline__ unsigned xb_ld(unsigned* p)              { return __hip_atomic_load(p, __ATOMIC_RELAXED, __HIP_MEMORY_SCOPE_AGENT); }
__device__ __forceinline__ unsigned xb_add(unsigned* p, unsigned v) { return __hip_atomic_fetch_add(p, v, __ATOMIC_RELAXED, __HIP_MEMORY_SCOPE_AGENT); }
__device__ __forceinline__ unsigned xb_xcc_id() { return (unsigned)__builtin_amdgcn_s_getreg((3 << 11) | 20) & 0xFu; }
#define XB_SPIN(cond, bar) do { unsigned _sp = 0; while (cond) { __builtin_amdgcn_s_sleep(1); \
    if ((++_sp & 255u) == 0u) { if (xb_ld(&(bar)[XB_TMO])) break; if (_sp > XB_SPIN_CAP) { atomicAdd(&(bar)[XB_TMO], 1u); break; } } } } while (0)
struct XcdBarrier { unsigned* bar; unsigned x; volatile LAS unsigned* st; int wave; };
__device__ __forceinline__ XcdBarrier xcd_barrier_post(unsigned* bar, volatile LAS unsigned* st) {
    XcdBarrier b; b.bar = bar; b.x = xb_xcc_id(); b.st = st; b.wave = 0;
    if (threadIdx.x == 0) (void)xb_add(&bar[XB_XCNT(b.x)], 1u);
    return b;
}
__device__ __forceinline__ void xcd_barrier_complete(unsigned* bar, unsigned x, unsigned& nloc, unsigned& nx) {
    const unsigned G = gridDim.x * gridDim.y * gridDim.z;
    unsigned sum, cnt, mine, sp = 0u;
    for (;;) {
        sum = 0u; cnt = 0u; mine = 0u;
#pragma unroll
        for (unsigned j = 0; j < 16; ++j) { const unsigned c = xb_ld(&bar[XB_XCNT(j)]); sum += c; cnt += (c > 0u) ? 1u : 0u; mine = (j == x) ? c : mine; }
        if (sum == G) break;
        __builtin_amdgcn_s_sleep(1);
        if ((++sp & 255u) == 0u) { if (xb_ld(&bar[XB_TMO])) break; if (sp > XB_SPIN_CAP) { atomicAdd(&bar[XB_TMO], 1u); break; } }
    }
    nloc = mine > 0u ? mine : 1u; nx = cnt > 0u ? cnt : 1u;
}
__device__ __forceinline__ void xcd_barrier(const XcdBarrier& b) {
    asm volatile("s_waitcnt vmcnt(0)" ::: "memory");
    __syncthreads();
    if (tid_of(b.wave) == 0) {
        unsigned* bar = b.bar;
        __builtin_amdgcn_s_waitcnt(0);
        unsigned nloc = b.st[0], nx = b.st[1];
        if (nloc == 0u) { xcd_barrier_complete(bar, b.x, nloc, nx); b.st[0] = nloc; b.st[1] = nx; }
        const unsigned old = xb_add(&bar[XB_XSUB(b.x)], 1u);
        const unsigned gen = old / nloc;
        if (old + 1u == (gen + 1u) * nloc) {
            __builtin_amdgcn_fence(__ATOMIC_RELEASE, "agent");
            asm volatile("s_waitcnt vmcnt(0)" ::: "memory");
            const unsigned og = xb_add(&bar[XB_TOP], 1u);
            const unsigned tg = og / nx;
            if (og + 1u == (tg + 1u) * nx) xb_add(&bar[XB_TOPGEN], 1u);
            else XB_SPIN(xb_ld(&bar[XB_TOPGEN]) == tg, bar);
            __builtin_amdgcn_fence(__ATOMIC_ACQUIRE, "agent");
            xb_add(&bar[XB_XGEN(b.x)], 1u);
            asm volatile("s_waitcnt vmcnt(0)" ::: "memory");
        } else {
            XB_SPIN(xb_ld(&bar[XB_XGEN(b.x)]) == gen, bar);
            __builtin_amdgcn_fence(__ATOMIC_ACQUIRE, "agent");
            asm volatile("s_waitcnt vmcnt(0)" ::: "memory");
        }
    }
    __syncthreads();
}

namespace pg8 {
constexpr int BM = 256, BK = 64, HALF = 128, HTB = HALF * BK * 2, STAGE_BYTES = 8 * HTB, NXCD = 8, WGM = 8;
__host__ __device__ __forceinline__ int lds_byte(int r, int c) { const int st = (r >> 4) * 2 + (c >> 5), rr = r & 15, cc = c & 31, ob = rr * 64 + cc * 2; return st * 1024 + (ob ^ (((ob >> 9) & 1) << 5)); }
__host__ __device__ __forceinline__ void stage_rc(int b, int& R, int& C) { const int st = b / 1024, sb = b % 1024, swz = sb ^ (((sb >> 9) & 1) << 5); R = (st >> 1) * 16 + swz / 64; C = (st & 1) * 32 + (swz % 64) / 2; }
__host__ __device__ __forceinline__ int perm32(int rho) { const int n = rho >> 4, i = rho & 15; return 8 * (i >> 2) + 4 * n + (i & 3); }

struct Unit { int pm, pn, aux; long aoff, boff; };
struct Gemm { const bf16_t* A; const bf16_t* Bt; int lda, ldb, K, rmulB; long hstepA, hstepB; };
__device__ __forceinline__ Gemm mk_gemm(const bf16_t* A, int lda, const bf16_t* Bt, int ldb, int K) { Gemm g; g.A = A; g.Bt = Bt; g.lda = lda; g.ldb = ldb; g.K = K; g.rmulB = 1; g.hstepA = (long)HALF * lda * 2; g.hstepB = (long)HALF * ldb * 2; return g; }

template <class Epi, class Sched>
__device__ __forceinline__ void gemm_phase(LAS unsigned char* lds, const Gemm g, const Sched& S, const Epi& E, int wave_) {
    const int tid = tid_of(wave_),
              wid = __builtin_amdgcn_readfirstlane(tid >> 6), lane = tid & 63, wr = wid >> 2, wc = wid & 3, fr = lane & 15, fq = lane >> 4;
    const int K = g.K, nt = K / BK;
    unsigned voffA[2], voffB[2];
#pragma unroll
    for (int i = 0; i < 2; ++i) { int R, C; stage_rc(tid * 16 + i * 8192, R, C); const int Rb = (R & ~31) + perm32(R & 31);
        voffA[i] = (unsigned)(R * g.lda + C) * 2u; voffB[i] = (unsigned)(Rb * g.rmulB * g.ldb + C) * 2u; }
    const size_t kstep = (size_t)(BK * 2);
    const long hstepA = g.hstepA, hstepB = g.hstepB;
    const unsigned ldsw = (unsigned)wid * 1024u;
    const int aoff = lds_byte(wr * 64 + fr, fq * 8), boff = lds_byte(wc * 32 + fr, fq * 8);
#define PG8_SA(b, h) (((b) * 2 + (h)) * HTB)
#define PG8_SB(b, h) ((4 + (b) * 2 + (h)) * HTB)
#define PG8_STAGE(bufoff, gbase, voff) do { _Pragma("unroll") for (int _i = 0; _i < 2; ++_i) \
        __builtin_amdgcn_global_load_lds((const unsigned*)((const char*)(gbase) + (voff)[_i]), (LAS unsigned*)(lds + (bufoff) + ldsw + _i * 8192), 16, 0, 0); } while (0)
#define PG8_LDA(dst, b, h) do { _Pragma("unroll") for (int m = 0; m < 4; ++m) _Pragma("unroll") for (int k = 0; k < 2; ++k) dst[m][k] = *(const LAS bf16x8*)(lds + PG8_SA(b, h) + aoff + m * 2048 + k * 1024); } while (0)
#define PG8_LDB(dst, b, h) do { _Pragma("unroll") for (int n = 0; n < 2; ++n) _Pragma("unroll") for (int k = 0; k < 2; ++k) dst[n][k] = *(const LAS bf16x8*)(lds + PG8_SB(b, h) + boff + n * 2048 + k * 1024); } while (0)
#define PG8_MMA(ai, bj, At, Bt) do { __builtin_amdgcn_s_setprio(1); _Pragma("unroll") for (int m = 0; m < 4; ++m) _Pragma("unroll") for (int n = 0; n < 2; ++n) _Pragma("unroll") for (int k = 0; k < 2; ++k) \
        acc[ai][bj][m][n] = __builtin_amdgcn_mfma_f32_16x16x32_bf16(Bt[n][k], At[m][k], acc[ai][bj][m][n], 0, 0, 0); __builtin_amdgcn_s_setprio(0); } while (0)
#define PG8_WAIT_V(n) asm volatile("s_waitcnt vmcnt(" #n ")" ::: "memory")
#define PG8_WAIT_L(n) asm volatile("s_waitcnt lgkmcnt(" #n ")" ::: "memory")
#define PG8_BAR __builtin_amdgcn_s_barrier()
#define PG8_SCHED __builtin_amdgcn_sched_barrier(0)
    Unit cur, nxt; int ui = 0;
    if (!S.next(0, cur)) return;
    f32x4 acc[2][2][4][2];
#pragma unroll
    for (int a = 0; a < 2; ++a)
#pragma unroll
        for (int b = 0; b < 2; ++b)
#pragma unroll
            for (int m = 0; m < 4; ++m)
#pragma unroll
                for (int n = 0; n < 2; ++n) acc[a][b][m][n] = (f32x4){0.f, 0.f, 0.f, 0.f};
    bf16x8 At[4][2], B0[2][2], B1[2][2];
    const char* cA = (const char*)g.A + cur.aoff; const char* cB = (const char*)g.Bt + cur.boff;
    PG8_STAGE(PG8_SB(0, 0), cB, voffB); PG8_STAGE(PG8_SB(0, 1), cB + hstepB, voffB); PG8_STAGE(PG8_SA(0, 0), cA, voffA); PG8_STAGE(PG8_SA(0, 1), cA + hstepA, voffA);
    if (wr == 1) PG8_BAR;
    PG8_WAIT_V(2); PG8_BAR;
    PG8_STAGE(PG8_SB(1, 0), cB + kstep, voffB); PG8_STAGE(PG8_SA(1, 0), cA + kstep, voffA); PG8_STAGE(PG8_SB(1, 1), cB + hstepB + kstep, voffB);
    PG8_WAIT_V(6); PG8_BAR;
    for (;;) {
        const bool has_next = S.next(ui + 1, nxt);
        const char* nA = has_next ? (const char*)g.A + nxt.aoff : cA; const char* nB = has_next ? (const char*)g.Bt + nxt.boff : cB;
        for (int t = 0; t < nt; t += 2) {
            const bool last = (t == nt - 2);
            const char* a1 = cA + (size_t)(t + 1) * kstep;
            const char* a2 = last ? nA : cA + (size_t)(t + 2) * kstep; const char* b2 = last ? nB : cB + (size_t)(t + 2) * kstep;
            const char* a3 = a2 + kstep; const char* b3 = b2 + kstep;
            PG8_LDB(B0, 0, 0); PG8_LDB(B1, 0, 1); PG8_SCHED; PG8_LDA(At, 0, 0); PG8_STAGE(PG8_SA(1, 1), a1 + hstepA, voffA);
            PG8_WAIT_V(8); PG8_WAIT_L(0); PG8_BAR; PG8_MMA(0, 0, At, B0); PG8_MMA(0, 1, At, B1); PG8_BAR; PG8_SCHED;
            PG8_LDA(At, 0, 1); PG8_STAGE(PG8_SB(0, 0), b2, voffB); PG8_STAGE(PG8_SB(0, 1), b2 + hstepB, voffB); PG8_STAGE(PG8_SA(0, 0), a2, voffA);
            PG8_WAIT_V(8); PG8_WAIT_L(0); PG8_BAR; PG8_MMA(1, 0, At, B0); PG8_MMA(1, 1, At, B1); PG8_BAR; PG8_SCHED;
            PG8_LDB(B0, 1, 0); PG8_LDB(B1, 1, 1); PG8_SCHED; PG8_LDA(At, 1, 0); PG8_STAGE(PG8_SA(0, 1), a2 + hstepA, voffA);
            PG8_WAIT_V(8); PG8_WAIT_L(0); PG8_BAR; PG8_MMA(0, 0, At, B0); PG8_MMA(0, 1, At, B1); PG8_BAR; PG8_SCHED;
            PG8_LDA(At, 1, 1); PG8_STAGE(PG8_SB(1, 0), b3, voffB); PG8_STAGE(PG8_SB(1, 1), b3 + hstepB, voffB); PG8_STAGE(PG8_SA(1, 0), a3, voffA);
            PG8_WAIT_V(8); PG8_WAIT_L(0); PG8_BAR; PG8_MMA(1, 0, At, B0); PG8_MMA(1, 1, At, B1); PG8_BAR; PG8_SCHED;
        }
        if (wr == 0) PG8_BAR;
        E(acc, cur, wr, wc, fr, fq);
        if (!has_next) break;
#pragma unroll
        for (int a = 0; a < 2; ++a)
#pragma unroll
            for (int b = 0; b < 2; ++b)
#pragma unroll
                for (int m = 0; m < 4; ++m)
#pragma unroll
                    for (int n = 0; n < 2; ++n) acc[a][b][m][n] = (f32x4){0.f, 0.f, 0.f, 0.f};
        cur = nxt; cA = nA; cB = nB; ++ui;
        if (wr == 1) PG8_BAR;
    }
    PG8_WAIT_V(0);
    PG8_BAR;
#undef PG8_SA
#undef PG8_SB
#undef PG8_STAGE
#undef PG8_LDA
#undef PG8_LDB
#undef PG8_MMA
#undef PG8_WAIT_V
#undef PG8_WAIT_L
#undef PG8_BAR
#undef PG8_SCHED
}

struct TileOrder {
    int nM, nN, nwg, G, c, xpm, xlo, xn, sn, sdiv; long tA, tB, sA0, sB0;
    __device__ __forceinline__ void init(int nM_, int nN_, int G_, int c_, long tA_, long tB_) { nM = nM_; nN = nN_; nwg = nM * nN; G = G_; c = c_; tA = tA_; tB = tB_; xpm = 0; xlo = 0; xn = 0; sn = 0; sdiv = 1; sA0 = 0; sB0 = 0; }
    __device__ __forceinline__ bool next(int i, Unit& u) const {
        const long L = (long)i * G + c;
        if (L < nwg) {
            int wgid = (int)L; { const int q = nwg / NXCD, r = nwg % NXCD, xcd = wgid % NXCD, off = wgid / NXCD; wgid = (xcd < r ? xcd * (q + 1) : r * (q + 1) + (xcd - r) * q) + off; }
            const int nig = WGM * nN, gid = wgid / nig, fm = gid * WGM, gsz = (nM - fm) < WGM ? (nM - fm) : WGM;
            u.pm = fm + ((wgid % nig) % gsz); u.pn = (wgid % nig) / gsz;
        } else if (L < nwg + xn) { u.pm = xpm; u.pn = xlo + (int)(L - nwg); }
        else if (L < nwg + xn + sn) { const int k = (int)(L - nwg - xn); u.pm = k / sdiv; u.pn = 1000 + k % sdiv; u.aux = 0; u.aoff = sA0 + (long)u.pm * tB; u.boff = sB0 + (long)(k % sdiv) * tA; return true; }
        else return false;
        u.aux = 0; u.aoff = u.pm * tA; u.boff = u.pn * tB; return true;
    }
};
struct F1Order { int G, c;
    __device__ __forceinline__ bool next(int i, Unit& u) const { const int L = i * G + c; if (L >= 512) return false;
        u.pn = L & 63; u.pm = (L >> 6) & 1; u.aux = L >> 7; u.aoff = (long)u.pm * 256 * 256 * 2; u.boff = (long)u.aux * 512 + (long)(2 * u.pn) * FD * 2; return true; } };
struct F1cOrder { int G, c;
    __device__ __forceinline__ bool next(int i, Unit& u) const { const int L = i * G + c; if (L >= 8) return false;
        u.pn = 0; u.pm = L & 1; u.aux = L >> 1; u.aoff = (long)u.pm * 256 * 256 * 2; u.boff = ((long)SEQ * FD + u.aux * 256) * 2; return true; } };
struct LinOrder { int G, c, n; long tB;
    __device__ __forceinline__ bool next(int i, Unit& u) const { const int L = i * G + c; if (L >= n) return false;
        u.pn = L; u.pm = 0; u.aux = 0; u.aoff = 0; u.boff = (long)L * tB; return true; } };
struct SplitKOrder { int G, c, nN, S, pmv; long abase, tB, ksb;
    __device__ __forceinline__ bool next(int i, Unit& u) const { const int L = i * G + c; if (L >= nN * S) return false;
        u.pn = L % nN; u.aux = L / nN; u.pm = pmv; u.aoff = abase + (long)u.aux * ksb; u.boff = (long)u.pn * tB + (long)u.aux * ksb; return true; } };
struct MoeOrder { int G, c, nN; int cum[9]; long tA, tB, eB;
    __device__ __forceinline__ bool next(int i, Unit& u) const { const int L = i * G + c; const int T = cum[8]; if (L >= T * nN) return false;
        const int nwg = T * nN; int wgid = L; { const int q = nwg / NXCD, r = nwg % NXCD, xcd = wgid % NXCD, off = wgid / NXCD; wgid = (xcd < r ? xcd * (q + 1) : r * (q + 1) + (xcd - r) * q) + off; }
        const int nig = WGM * nN, gid = wgid / nig, fm = gid * WGM, gsz = (T - fm) < WGM ? (T - fm) : WGM;
        const int ti = fm + ((wgid % nig) % gsz), pn = (wgid % nig) / gsz; int e = 0;
#pragma unroll
        for (int k = 1; k < 8; ++k) e += (ti >= cum[k]) ? 1 : 0;
        u.pm = ti; u.pn = pn; u.aux = e; u.aoff = (long)ti * tA; u.boff = (long)e * eB + (long)pn * tB; return true; } };

#define EPI_ARGS const f32x4 (&acc)[2][2][4][2], const Unit& u, int wr, int wc, int fr, int fq
__device__ __forceinline__ u32x4 pack8(f32x4 v0, f32x4 v1) { u32x4 w; w.x = cvt_pk_bf16(v0[0], v0[1]); w.y = cvt_pk_bf16(v0[2], v0[3]); w.z = cvt_pk_bf16(v1[0], v1[1]); w.w = cvt_pk_bf16(v1[2], v1[3]); return w; }
__device__ __forceinline__ void unpack8(u32x4 w, f32x4& v0, f32x4& v1) { v0 = (f32x4){bflo(w.x), bfhi(w.x), bflo(w.y), bfhi(w.y)}; v1 = (f32x4){bflo(w.z), bfhi(w.z), bflo(w.w), bfhi(w.w)}; }

struct EpiInProj {
    bf16_t *Q, *Kb, *Vb, *Fb, *Gb; const float* bgate; bf16_t* Vt;
    __device__ __forceinline__ void operator()(EPI_ARGS) const {
        if (u.pn >= 1000) {
            const int row0 = u.pm * BM + wr * 64 + fr, col0 = (u.pn - 1000) * BM + wc * 32 + 8 * fq;
#pragma unroll
            for (int ai = 0; ai < 2; ++ai)
#pragma unroll
                for (int m = 0; m < 4; ++m) { bf16_t* rowp = Vt + (size_t)(row0 + ai * HALF + m * 16) * MR + col0;
#pragma unroll
                    for (int bj = 0; bj < 2; ++bj) *(u32x4*)(rowp + bj * HALF) = pack8(acc[ai][bj][m][0], acc[ai][bj][m][1]); }
            return; }
        const int pn = u.pn; bf16_t* base; int ldc, c0; bool sig = false;
        if (pn < 8) { base = Q; ldc = QW; c0 = pn * 256; }
        else if (pn < 10) { base = Kb; ldc = KVW; c0 = (pn - 8) * 256; }
        else if (pn < 12) { base = Vb; ldc = KVW; c0 = (pn - 10) * 256; }
        else if (pn < 16) { base = Fb; ldc = FD; c0 = (pn - 12) * 256; }
        else { base = Gb; ldc = GW2; c0 = (pn - 16) * 256; sig = true; }
        const int row0 = u.pm * BM + wr * 64 + fr, col0 = c0 + wc * 32 + 8 * fq;
        f32x4 bv[2][2];
#pragma unroll
        for (int bj = 0; bj < 2; ++bj)
#pragma unroll
            for (int n = 0; n < 2; ++n) bv[bj][n] = sig ? *(const f32x4*)(bgate + col0 + bj * HALF + 4 * n) : (f32x4){0.f, 0.f, 0.f, 0.f};
#pragma unroll
        for (int ai = 0; ai < 2; ++ai)
#pragma unroll
            for (int m = 0; m < 4; ++m) { bf16_t* rowp = base + (size_t)(row0 + ai * HALF + m * 16) * ldc + col0;
#pragma unroll
                for (int bj = 0; bj < 2; ++bj) { f32x4 v0 = acc[ai][bj][m][0] + bv[bj][0], v1 = acc[ai][bj][m][1] + bv[bj][1];
                    if (sig) {
#pragma unroll
                        for (int j = 0; j < 4; ++j) { v0[j] = sigmoidf_(v0[j]); v1[j] = sigmoidf_(v1[j]); } }
                    *(u32x4*)(rowp + bj * HALF) = pack8(v0, v1); } }
    }
};
struct EpiF1 {
    bf16_t* ZA;
    __device__ __forceinline__ void operator()(EPI_ARGS) const {
        const int g = u.aux, reim = u.pm;
#pragma unroll
        for (int ai = 0; ai < 2; ++ai)
#pragma unroll
            for (int m = 0; m < 4; ++m) { const int mm = ai * HALF + wr * 64 + m * 16 + fr;
#pragma unroll
                for (int bj = 0; bj < 2; ++bj) { const int a = 2 * u.pn + bj, b = wc * 32 + 8 * fq;
                    *(u32x4*)(ZA + ((size_t)((g * 256 + mm) * 128 + a) * 256 + reim * 128 + b)) = pack8(acc[ai][bj][m][0], acc[ai][bj][m][1]); } }
    }
};
struct EpiF1c {
    bf16_t* ZC;
    __device__ __forceinline__ void operator()(EPI_ARGS) const {
        const int g = u.aux, reim = u.pm;
#pragma unroll
        for (int ai = 0; ai < 2; ++ai)
#pragma unroll
            for (int m = 0; m < 4; ++m) { const int mm = ai * HALF + wr * 64 + m * 16 + fr;
#pragma unroll
                for (int bj = 0; bj < 2; ++bj) { const int n = bj * HALF + wc * 32 + 8 * fq;
                    *(u32x4*)(ZC + ((size_t)(g * 256 + mm) * 512 + reim * 256 + n)) = pack8(acc[ai][bj][m][0], acc[ai][bj][m][1]); } }
    }
};
struct EpiF2 {
    bf16_t* YB;
    __device__ __forceinline__ void operator()(EPI_ARGS) const {
#pragma unroll
        for (int m = 0; m < 4; ++m) { int ka = wr * 64 + m * 16 + fr; asm volatile("" : "+v"(ka));
#pragma unroll
            for (int bj = 0; bj < 2; ++bj) { const int gm = 2 * u.pn + bj, g = gm >> 8, mm = gm & 255, a0 = wc * 32 + 8 * fq;
                f32x4 re[2], im[2];
#pragma unroll
                for (int n = 0; n < 2; ++n)
#pragma unroll
                    for (int j = 0; j < 4; ++j) { const int a = a0 + 4 * n + j; const float t = (float)(a * ka) * (1.0f / 16384.0f);
                        const float c = __builtin_amdgcn_cosf(t), s = __builtin_amdgcn_sinf(t);
                        const float yr = acc[0][bj][m][n][j], yi = acc[1][bj][m][n][j];
                        re[n][j] = yr * c + yi * s; im[n][j] = yi * c - yr * s; }
                bf16_t* p = YB + ((size_t)((g * 128 + ka) * 256 + mm) * 256 + a0);
                *(u32x4*)p = pack8(re[0], re[1]); *(u32x4*)(p + 128) = pack8(im[0], im[1]); asm volatile("" ::: "memory"); } }
    }
};
struct EpiF3 {
    bf16_t* FOUR;
    __device__ __forceinline__ void operator()(EPI_ARGS) const {
        const int g = u.pn >> 7, ka = u.pn & 127;
#pragma unroll
        for (int m = 0; m < 4; ++m) { const int kb = wr * 64 + m * 16 + fr;
#pragma unroll
            for (int bj = 0; bj < 2; ++bj) { const int mm = bj * HALF + wc * 32 + 8 * fq;
                *(u32x4*)(FOUR + ((size_t)(128 * kb + ka) * FD + g * 256 + mm)) = pack8(acc[0][bj][m][0], acc[0][bj][m][1]); } }
    }
};
struct EpiF3c {
    bf16_t* FOUR;
    __device__ __forceinline__ void operator()(EPI_ARGS) const {
#pragma unroll
        for (int ai = 0; ai < 2; ++ai)
#pragma unroll
            for (int m = 0; m < 4; ++m) { const int k = ai * HALF + wr * 64 + m * 16 + fr;
#pragma unroll
                for (int bj = 0; bj < 2; ++bj) { const int mm = bj * HALF + wc * 32 + 8 * fq;
                    *(u32x4*)(FOUR + ((size_t)(SEQ + k) * FD + u.pn * 256 + mm)) = pack8(acc[ai][bj][m][0], acc[ai][bj][m][1]); } }
    }
};
template <int SECOND> struct EpiMerge {
    bf16_t* Y; const bf16_t* Gb;
    __device__ __forceinline__ void operator()(EPI_ARGS) const {
        const int row0 = u.pm * BM + wr * 64 + fr, col0 = u.pn * BM + wc * 32 + 8 * fq;
#pragma unroll
        for (int ai = 0; ai < 2; ++ai)
#pragma unroll
            for (int m = 0; m < 4; ++m) { const size_t row = (size_t)(row0 + ai * HALF + m * 16);
#pragma unroll
                for (int bj = 0; bj < 2; ++bj) { const int col = col0 + bj * HALF;
                    f32x4 g0, g1; unpack8(*(const u32x4*)(Gb + row * GW2 + SECOND * DM + col), g0, g1);
                    f32x4 v0 = acc[ai][bj][m][0] * g0, v1 = acc[ai][bj][m][1] * g1;
                    bf16_t* yp = Y + row * DM + col;
                    if (SECOND) { f32x4 y0, y1; unpack8(*(const u32x4*)yp, y0, y1); v0 += y0; v1 += y1; }
                    *(u32x4*)yp = pack8(v0, v1); } }
    }
};
struct EpiRes {
    const float* baseF; const bf16_t* baseB; bf16_t* outB; const float* gateL; const float* baseC; float* outC; const float* gateC;
    __device__ __forceinline__ void operator()(EPI_ARGS) const {
        const bool isc = u.pm >= SEQ / BM; const float* gate = isc ? gateC : gateL;
        const int row0 = (isc ? 0 : u.pm * BM) + wr * 64 + fr, col0 = u.pn * BM + wc * 32 + 8 * fq;
        f32x4 gv[2][2];
#pragma unroll
        for (int bj = 0; bj < 2; ++bj)
#pragma unroll
            for (int n = 0; n < 2; ++n) gv[bj][n] = *(const f32x4*)(gate + col0 + bj * HALF + 4 * n);
#pragma unroll
        for (int ai = 0; ai < 2; ++ai)
#pragma unroll
            for (int m = 0; m < 4; ++m) { const size_t off = (size_t)(row0 + ai * HALF + m * 16) * DM + col0;
#pragma unroll
                for (int bj = 0; bj < 2; ++bj) {
                    if (isc) {
#pragma unroll
                        for (int n = 0; n < 2; ++n) { const f32x4 b = *(const f32x4*)(baseC + off + bj * HALF + 4 * n); *(f32x4*)(outC + off + bj * HALF + 4 * n) = b + gv[bj][n] * acc[ai][bj][m][n]; }
                    } else {
                        f32x4 b0, b1;
                        if (baseB) unpack8(*(const u32x4*)(baseB + off + bj * HALF), b0, b1);
                        else { b0 = *(const f32x4*)(baseF + off + bj * HALF); b1 = *(const f32x4*)(baseF + off + bj * HALF + 4); }
                        *(u32x4*)(outB + off + bj * HALF) = pack8(b0 + gv[bj][0] * acc[ai][bj][m][0], b1 + gv[bj][1] * acc[ai][bj][m][1]); } }
                asm volatile("" ::: "memory"); }
    }
};
struct EpiPartial {
    float* part; const float* gate;
    __device__ __forceinline__ void operator()(EPI_ARGS) const {
        const int row0 = wr * 64 + fr, col0 = u.pn * BM + wc * 32 + 8 * fq; float* pbase = part + (size_t)u.aux * CTXL * DM;
        f32x4 gv[2][2];
#pragma unroll
        for (int bj = 0; bj < 2; ++bj)
#pragma unroll
            for (int n = 0; n < 2; ++n) gv[bj][n] = *(const f32x4*)(gate + col0 + bj * HALF + 4 * n);
#pragma unroll
        for (int ai = 0; ai < 2; ++ai)
#pragma unroll
            for (int m = 0; m < 4; ++m) { float* rowp = pbase + (size_t)(row0 + ai * HALF + m * 16) * DM + col0;
#pragma unroll
                for (int bj = 0; bj < 2; ++bj)
#pragma unroll
                    for (int n = 0; n < 2; ++n) *(f32x4*)(rowp + bj * HALF + 4 * n) = gv[bj][n] * acc[ai][bj][m][n]; }
    }
};
struct EpiSwiglu {
    bf16_t* U; int ldu;
    __device__ __forceinline__ void operator()(EPI_ARGS) const {
        const int row0 = u.pm * BM + wr * 64 + fr, col0 = u.pn * HALF + wc * 32 + 8 * fq;
#pragma unroll
        for (int ai = 0; ai < 2; ++ai)
#pragma unroll
            for (int m = 0; m < 4; ++m) { f32x4 o[2];
#pragma unroll
                for (int n = 0; n < 2; ++n)
#pragma unroll
                    for (int j = 0; j < 4; ++j) { const float gt = acc[ai][0][m][n][j], up = acc[ai][1][m][n][j]; o[n][j] = gt * sigmoidf_(gt) * up; }
                *(u32x4*)(U + (size_t)(row0 + ai * HALF + m * 16) * ldu + col0) = pack8(o[0], o[1]); }
    }
};
struct EpiPlain {
    bf16_t* O; int ldc;
    __device__ __forceinline__ void operator()(EPI_ARGS) const {
        const int row0 = u.pm * BM + wr * 64 + fr, col0 = u.pn * BM + wc * 32 + 8 * fq;
#pragma unroll
        for (int ai = 0; ai < 2; ++ai)
#pragma unroll
            for (int m = 0; m < 4; ++m) { bf16_t* rowp = O + (size_t)(row0 + ai * HALF + m * 16) * ldc + col0;
#pragma unroll
                for (int bj = 0; bj < 2; ++bj) *(u32x4*)(rowp + bj * HALF) = pack8(acc[ai][bj][m][0], acc[ai][bj][m][1]); }
    }
};
}

namespace at {
using bf16 = __hip_bfloat16;
constexpr int D = 128, NW = 8, QBLK = 32, KVBLK = 64;
constexpr float SCALE = 0.088388347648318440f;
constexpr float THR = 8.f;
constexpr int LDQ = QW, LDK = KVW, LDO = QW;
constexpr size_t SHM_V = KVBLK * D * 2, SHM_K = KVBLK * D * 2, SHM_ATTN = 2 * SHM_V + 2 * SHM_K + NW * 64 * 4;
#define KSWZ(row, colB) ((row) * 256 + ((colB) ^ (((row) & 15) << 4)))
#define SBAR() __builtin_amdgcn_sched_barrier(0)
__device__ __forceinline__ int crow(int r, int hi) { return (r & 3) + 8 * (r >> 2) + 4 * hi; }
__device__ __forceinline__ unsigned cvtpk(float lo, float hi) { unsigned r; asm volatile("v_cvt_pk_bf16_f32 %0, %1, %2" : "=v"(r) : "v"(lo), "v"(hi)); return r; }
__device__ __forceinline__ void partialSM(f32x16& p0, f32x16& p1, float& m_reg, float& mn, float& alpha) {
  constexpr float C = 1.0f;
  float pmax = p0[0]; for (int r = 1; r < 16; ++r) pmax = fmaxf(pmax, p0[r]); for (int r = 0; r < 16; ++r) pmax = fmaxf(pmax, p1[r]);
  { auto rr = __builtin_amdgcn_permlane32_swap(__float_as_uint(pmax), __float_as_uint(pmax), false, false);
    pmax = fmaxf(__uint_as_float(rr[0]), __uint_as_float(rr[1])); }
  if (__builtin_expect(__all(pmax - m_reg <= THR * 1.4426950408889634f), 1)) { mn = m_reg; alpha = 1.f; }
  else { mn = fmaxf(m_reg, pmax); alpha = __builtin_amdgcn_exp2f((m_reg - mn) * C); m_reg = mn; }
  float mnC = -mn * C;
  for (int r = 0; r < 16; ++r) p0[r] = fmaf(p0[r], C, mnC); for (int r = 0; r < 16; ++r) p1[r] = fmaf(p1[r], C, mnC);
  for (int r = 0; r < 16; ++r) p0[r] = __builtin_amdgcn_exp2f(p0[r]);
}
__device__ __forceinline__ void finishSM(f32x16& p0, f32x16& p1, float alpha, float& l_reg, bf16x8& pa0, bf16x8& pa1, bf16x8& pa2, bf16x8& pa3) {
  for (int r = 0; r < 16; ++r) p1[r] = __builtin_amdgcn_exp2f(p1[r]);
  float ps = 0; for (int r = 0; r < 16; ++r) ps += p0[r]; for (int r = 0; r < 16; ++r) ps += p1[r];
  { auto rr = __builtin_amdgcn_permlane32_swap(__float_as_uint(ps), __float_as_uint(ps), false, false);
    ps = __uint_as_float(rr[0]) + __uint_as_float(rr[1]); }
  l_reg = l_reg * alpha + ps;
#define PK4(P, BASE, OUT) do { unsigned a0 = cvtpk(P[BASE + 0], P[BASE + 1]), a1 = cvtpk(P[BASE + 2], P[BASE + 3]);   \
    unsigned b0 = cvtpk(P[BASE + 4], P[BASE + 5]), b1 = cvtpk(P[BASE + 6], P[BASE + 7]);                              \
    auto r0 = __builtin_amdgcn_permlane32_swap(a0, b0, false, false); auto r1 = __builtin_amdgcn_permlane32_swap(a1, b1, false, false); \
    u32x4 w = {r0[0], r1[0], r0[1], r1[1]}; OUT = *reinterpret_cast<bf16x8*>(&w); } while (0)
  PK4(p0, 0, pa0); PK4(p0, 8, pa1); PK4(p1, 0, pa2); PK4(p1, 8, pa3);
#undef PK4
}
__device__ __forceinline__ void qkt(f32x16& p0, f32x16& p1, const bf16* Ks, const bf16x8* qr, int r32, int hi) {
  p0 = f32x16{}; p1 = f32x16{};
  for (int d0 = 0; d0 < 8; ++d0) { int cb = (d0 * 16 + hi * 8) * 2;
    bf16x8 b0 = *reinterpret_cast<const bf16x8*>((const char*)Ks + KSWZ(r32, cb));
    bf16x8 b1 = *reinterpret_cast<const bf16x8*>((const char*)Ks + KSWZ(32 + r32, cb));
    p0 = __builtin_amdgcn_mfma_f32_32x32x16_bf16(b0, qr[d0], p0, 0, 0, 0);
    p1 = __builtin_amdgcn_mfma_f32_32x32x16_bf16(b1, qr[d0], p1, 0, 0, 0); }
}
__device__ __forceinline__ int v_st(int k, int c) { const int kk = (k & ~0xC) | ((k & 4) << 1) | ((k & 8) >> 1); return ((kk >> 3) * 4 + (c >> 5)) * 512 + ((kk & 7) * 32 + (c & 31)) * 2; }
__device__ __forceinline__ int v_rd_base(int lane) { return ((lane & 3) << 3) | (((lane >> 2) & 3) << 6) | (((lane >> 4) & 1) << 5) | (((lane >> 5) & 1) << 8); }
constexpr int v_rd_off(int d0, int ks, int half) { return d0 * 512 + ks * 4096 + half * 2048; }
template <int OFF> __device__ __forceinline__ s16x4 tr_read(int vb) {
  s16x4 r; asm volatile("ds_read_b64_tr_b16 %0, %1 offset:%2" : "=&v"(r) : "v"(vb), "i"(OFF) : "memory"); return r;
}
template <int D0> __device__ __forceinline__ void pv_one(f32x16& od, int vb, bf16x8 pa0, bf16x8 pa1, bf16x8 pa2, bf16x8 pa3) {
  const s16x4 l0 = tr_read<v_rd_off(D0, 0, 0)>(vb), h0 = tr_read<v_rd_off(D0, 0, 1)>(vb), l1 = tr_read<v_rd_off(D0, 1, 0)>(vb), h1 = tr_read<v_rd_off(D0, 1, 1)>(vb);
  const s16x4 l2 = tr_read<v_rd_off(D0, 2, 0)>(vb), h2 = tr_read<v_rd_off(D0, 2, 1)>(vb), l3 = tr_read<v_rd_off(D0, 3, 0)>(vb), h3 = tr_read<v_rd_off(D0, 3, 1)>(vb);
  asm volatile("s_waitcnt lgkmcnt(0)" ::: "memory"); SBAR();
#define PK(L, H) (bf16x8){L[0], L[1], L[2], L[3], H[0], H[1], H[2], H[3]}
  od = __builtin_amdgcn_mfma_f32_32x32x16_bf16(pa0, PK(l0, h0), od, 0, 0, 0);
  od = __builtin_amdgcn_mfma_f32_32x32x16_bf16(pa1, PK(l1, h1), od, 0, 0, 0);
  od = __builtin_amdgcn_mfma_f32_32x32x16_bf16(pa2, PK(l2, h2), od, 0, 0, 0);
  od = __builtin_amdgcn_mfma_f32_32x32x16_bf16(pa3, PK(l3, h3), od, 0, 0, 0);
#undef PK
}
__device__ __forceinline__ void pv_d0(f32x16* o, int vb, bf16x8 pa0, bf16x8 pa1, bf16x8 pa2, bf16x8 pa3) {
  pv_one<0>(o[0], vb, pa0, pa1, pa2, pa3); pv_one<1>(o[1], vb, pa0, pa1, pa2, pa3); pv_one<2>(o[2], vb, pa0, pa1, pa2, pa3); pv_one<3>(o[3], vb, pa0, pa1, pa2, pa3);
}
__device__ __forceinline__ void q_prologue(bf16x8 (&qr)[8], const float* __restrict__ qg, const float* __restrict__ rope, int tok, int hi) {
  constexpr float QC = SCALE * 1.4426950408889634f;
  float x[8][8]; float ss = 0.f;
#pragma unroll
  for (int d0 = 0; d0 < 8; ++d0)
#pragma unroll
    for (int j = 0; j < 8; ++j) { x[d0][j] = __builtin_bit_cast(float, (unsigned)(unsigned short)qr[d0][j] << 16); ss += x[d0][j] * x[d0][j]; }
  { auto rr = __builtin_amdgcn_permlane32_swap(__float_as_uint(ss), __float_as_uint(ss), false, false); ss = __uint_as_float(rr[0]) + __uint_as_float(rr[1]); }
  const float rs = QC / sqrtf(ss * (1.0f / D) + 1e-6f);
#pragma unroll
  for (int d0 = 0; d0 < 8; ++d0) { const f32x4 g0 = *(const f32x4*)(qg + 16 * d0 + 8 * hi), g1 = *(const f32x4*)(qg + 16 * d0 + 8 * hi + 4);
#pragma unroll
    for (int j = 0; j < 4; ++j) { x[d0][j] *= rs * g0[j]; x[d0][4 + j] *= rs * g1[j]; } }
  if (tok >= 0) {
#pragma unroll
    for (int a = 0; a < 2; ++a) { const int pos = a ? (tok & 63) : (tok >> 6); const float* ct = rope + (a ? 16384 : 0) + pos * 32 + 8 * hi; const float* st = ct + (a ? 2048 : 8192);
#pragma unroll
      for (int e = 0; e < 2; ++e) { const f32x4 c0 = *(const f32x4*)(ct + 16 * e), c1 = *(const f32x4*)(ct + 16 * e + 4), s0 = *(const f32x4*)(st + 16 * e), s1 = *(const f32x4*)(st + 16 * e + 4);
#pragma unroll
        for (int j = 0; j < 8; ++j) { const float c = j < 4 ? c0[j & 3] : c1[j & 3], sn = j < 4 ? s0[j & 3] : s1[j & 3]; const float lo = x[4 * a + e][j], hh = x[4 * a + 2 + e][j];
          x[4 * a + e][j] = lo * c - hh * sn; x[4 * a + 2 + e][j] = hh * c + lo * sn; } } } }
#pragma unroll
  for (int d0 = 0; d0 < 8; ++d0) { u32x4 w = {cvtpk(x[d0][0], x[d0][1]), cvtpk(x[d0][2], x[d0][3]), cvtpk(x[d0][4], x[d0][5]), cvtpk(x[d0][6], x[d0][7])}; qr[d0] = *reinterpret_cast<bf16x8*>(&w); }
}
__device__ __forceinline__ void attn_dense_body(const bf16* Qb, const bf16* __restrict__ Kh, const bf16* __restrict__ Vh, bf16* Ob, int seq, char* lds, int wave_, const float* qg, const float* rope, int tok0) {
  const int tid = tid_of(wave_), wid = tid >> 6, lane = tid & 63, r32 = lane & 31, hi = lane >> 5;
  bf16* V_lds = (bf16*)lds; bf16* K_lds = (bf16*)(lds + 2 * SHM_V);
  float* ws = (float*)(lds + 2 * SHM_V + 2 * SHM_K) + wid * 64; float* li_l = ws; float* al_l = ws + 32;
  float m_reg = -1e30f, l_reg = 0; f32x16 o[4] = {}; bf16x8 qr[8];
  const bf16* Qw = Qb + (long)(wid * QBLK + r32) * LDQ + hi * 8;
#pragma unroll
  for (int d0 = 0; d0 < 8; ++d0) qr[d0] = *reinterpret_cast<const bf16x8*>(Qw + d0 * 16);
  q_prologue(qr, qg, rope, tok0 < 0 ? -1 : tok0 + wid * QBLK + r32, hi);
  const int sr = tid >> 4, sc = (tid & 15) * 8, vst0 = v_st(sr, sc), vst1 = v_st(32 + sr, sc);
  const int vb0 = (int)(uintptr_t)V_lds + v_rd_base(lane);
  struct { bf16x8 vs0, vs1, ks0, ks1; } sr_[2];
#define SLOAD(i, k0) do { sr_[i].vs0 = *(const bf16x8*)(&Vh[(long)((k0) + sr) * LDK + sc]); sr_[i].vs1 = *(const bf16x8*)(&Vh[(long)((k0) + 32 + sr) * LDK + sc]); \
    sr_[i].ks0 = *(const bf16x8*)(&Kh[(long)((k0) + sr) * LDK + sc]); sr_[i].ks1 = *(const bf16x8*)(&Kh[(long)((k0) + 32 + sr) * LDK + sc]); } while (0)
#define SWRITE(b, i) do { *(bf16x8*)((char*)V_lds + (b) * SHM_V + vst0) = sr_[i].vs0;          \
    *(bf16x8*)((char*)V_lds + (b) * SHM_V + vst1) = sr_[i].vs1; int kc = sc * 2;               \
    *(bf16x8*)((char*)K_lds + (b) * SHM_K + KSWZ(sr, kc)) = sr_[i].ks0;                       \
    *(bf16x8*)((char*)K_lds + (b) * SHM_K + KSWZ(32 + sr, kc)) = sr_[i].ks1; } while (0)
#define SWAIT() asm volatile("s_waitcnt vmcnt(4)" ::: "memory")
#define RESC(a) do { if (__any((a) < 1.f)) { if (hi == 0) al_l[r32] = (a); asm volatile("s_waitcnt lgkmcnt(0)" ::: "memory"); \
    for (int d = 0; d < 4; ++d) for (int r = 0; r < 16; ++r) o[d][r] *= al_l[crow(r, hi)]; } } while (0)
  f32x16 pA0, pA1, pB0, pB1; float mnA, mnB, alA, alB; bf16x8 pa0, pa1, pa2, pa3; const int NT = seq / KVBLK;
  constexpr int SE = 0, SO = 1;
  SLOAD(SE, 0); asm volatile("s_waitcnt vmcnt(0)" ::: "memory"); SWRITE(0, SE); __syncthreads();
  qkt(pA0, pA1, K_lds, qr, r32, hi); partialSM(pA0, pA1, m_reg, mnA, alA);
  SLOAD(SO, KVBLK); if (2 < NT) SLOAD(SE, 2 * KVBLK);
  SWAIT(); SWRITE(1, SO); __syncthreads();
  for (int j = 1; j + 1 < NT; j += 2) {
    SBAR(); qkt(pB0, pB1, (bf16*)((char*)K_lds + SHM_K), qr, r32, hi);
    finishSM(pA0, pA1, alA, l_reg, pa0, pa1, pa2, pa3); SBAR();
    SLOAD(SO, (j + 2) * KVBLK); SBAR();
    pv_d0(o, vb0, pa0, pa1, pa2, pa3); partialSM(pB0, pB1, m_reg, mnB, alB);
    __syncthreads(); SWAIT(); SWRITE(0, SE);
    RESC(alB); __syncthreads();
    SBAR(); qkt(pA0, pA1, K_lds, qr, r32, hi);
    finishSM(pB0, pB1, alB, l_reg, pa0, pa1, pa2, pa3); SBAR();
    if (j + 3 < NT) SLOAD(SE, (j + 3) * KVBLK); SBAR();
    pv_d0(o, vb0 + (int)SHM_V, pa0, pa1, pa2, pa3); partialSM(pA0, pA1, m_reg, mnA, alA);
    __syncthreads(); SWAIT(); SWRITE(1, SO);
    RESC(alA); __syncthreads();
  }
  SBAR(); qkt(pB0, pB1, (bf16*)((char*)K_lds + SHM_K), qr, r32, hi);
  finishSM(pA0, pA1, alA, l_reg, pa0, pa1, pa2, pa3); SBAR();
  pv_d0(o, vb0, pa0, pa1, pa2, pa3); partialSM(pB0, pB1, m_reg, mnB, alB);
  __syncthreads(); RESC(alB);
  finishSM(pB0, pB1, alB, l_reg, pa0, pa1, pa2, pa3); SBAR();
  pv_d0(o, vb0 + (int)SHM_V, pa0, pa1, pa2, pa3);
  if (hi == 0) li_l[r32] = l_reg; asm volatile("s_waitcnt lgkmcnt(0)" ::: "memory");
  float rli[16];
#pragma unroll
  for (int r = 0; r < 16; ++r) rli[r] = __builtin_amdgcn_rcpf(li_l[crow(r, hi)]);
  unsigned short* Ow = (unsigned short*)Ob + (long)(wid * QBLK) * LDO;
#pragma unroll
  for (int r = 0; r < 16; ++r) { int orow = crow(r, hi);
    for (int d0 = 0; d0 < 4; ++d0) Ow[(long)orow * LDO + d0 * 32 + r32] = (unsigned short)f2bf(o[d0][r] * rli[r]); }
  __syncthreads();
#undef SLOAD
#undef SWRITE
#undef SWAIT
#undef RESC
}

__device__ __forceinline__ void expA(f32x16& p, float negBC) {
  (void)negBC;
  for (int r = 0; r < 16; ++r) p[r] = __builtin_amdgcn_exp2f(p[r]);
}
__device__ __forceinline__ void finishFX(f32x16& p0, f32x16& p1, float negBC, float& l_reg, bf16x8& pa0, bf16x8& pa1, bf16x8& pa2, bf16x8& pa3) {
  expA(p1, negBC);
  float ps = 0; for (int r = 0; r < 16; ++r) ps += p0[r]; for (int r = 0; r < 16; ++r) ps += p1[r];
  l_reg += ps;
#define PK4(P, BASE, OUT) do { unsigned a0 = cvtpk(P[BASE + 0], P[BASE + 1]), a1 = cvtpk(P[BASE + 2], P[BASE + 3]);   \
    unsigned b0 = cvtpk(P[BASE + 4], P[BASE + 5]), b1 = cvtpk(P[BASE + 6], P[BASE + 7]);                              \
    auto r0 = __builtin_amdgcn_permlane32_swap(a0, b0, false, false); auto r1 = __builtin_amdgcn_permlane32_swap(a1, b1, false, false); \
    u32x4 w = {r0[0], r1[0], r0[1], r1[1]}; OUT = *reinterpret_cast<bf16x8*>(&w); } while (0)
  PK4(p0, 0, pa0); PK4(p0, 8, pa1); PK4(p1, 0, pa2); PK4(p1, 8, pa3);
#undef PK4
}
__device__ __forceinline__ void attn_dense_body_fx(const bf16* Qb, const bf16* __restrict__ Kh, const bf16* __restrict__ Vh, bf16* Ob, int seq, char* lds, float negBC, int wave_) {
  const int tid = tid_of(wave_), wid = tid >> 6, lane = tid & 63, r32 = lane & 31, hi = lane >> 5;
  bf16* V_lds = (bf16*)lds; bf16* K_lds = (bf16*)(lds + 2 * SHM_V);
  float* ws = (float*)(lds + 2 * SHM_V + 2 * SHM_K) + wid * 64; float* li_l = ws;
  float l_reg = 0; f32x16 o[4] = {}; bf16x8 qr[8];
  const bf16* Qw = Qb + (long)(wid * QBLK + r32) * LDQ + hi * 8;
#pragma unroll
  for (int d0 = 0; d0 < 8; ++d0) qr[d0] = *reinterpret_cast<const bf16x8*>(Qw + d0 * 16);
  const int sr = tid >> 4, sc = (tid & 15) * 8, vst0 = v_st(sr, sc), vst1 = v_st(32 + sr, sc);
  const int vb0 = (int)(uintptr_t)V_lds + v_rd_base(lane);
  struct { bf16x8 vs0, vs1, ks0, ks1; } sr_[2];
#define SLOAD(i, k0) do { sr_[i].vs0 = *(const bf16x8*)(&Vh[(long)((k0) + sr) * LDK + sc]); sr_[i].vs1 = *(const bf16x8*)(&Vh[(long)((k0) + 32 + sr) * LDK + sc]); \
    sr_[i].ks0 = *(const bf16x8*)(&Kh[(long)((k0) + sr) * LDK + sc]); sr_[i].ks1 = *(const bf16x8*)(&Kh[(long)((k0) + 32 + sr) * LDK + sc]); } while (0)
#define SWRITE(b, i) do { *(bf16x8*)((char*)V_lds + (b) * SHM_V + vst0) = sr_[i].vs0;          \
    *(bf16x8*)((char*)V_lds + (b) * SHM_V + vst1) = sr_[i].vs1; int kc = sc * 2;               \
    *(bf16x8*)((char*)K_lds + (b) * SHM_K + KSWZ(sr, kc)) = sr_[i].ks0;                       \
    *(bf16x8*)((char*)K_lds + (b) * SHM_K + KSWZ(32 + sr, kc)) = sr_[i].ks1; } while (0)
#define SWAIT() asm volatile("s_waitcnt vmcnt(4)" ::: "memory")
  f32x16 pA0, pA1, pB0, pB1; bf16x8 pa0, pa1, pa2, pa3; const int NT = seq / KVBLK;
  constexpr int SE = 0, SO = 1;
  SLOAD(SE, 0); asm volatile("s_waitcnt vmcnt(0)" ::: "memory"); SWRITE(0, SE); __syncthreads();
  qkt(pA0, pA1, K_lds, qr, r32, hi); expA(pA0, negBC);
  SLOAD(SO, KVBLK); if (2 < NT) SLOAD(SE, 2 * KVBLK);
  SWAIT(); SWRITE(1, SO); __syncthreads();
  for (int j = 1; j + 1 < NT; j += 2) {
    SBAR(); qkt(pB0, pB1, (bf16*)((char*)K_lds + SHM_K), qr, r32, hi);
    finishFX(pA0, pA1, negBC, l_reg, pa0, pa1, pa2, pa3); SBAR();
    SLOAD(SO, (j + 2) * KVBLK); SBAR();
    pv_d0(o, vb0, pa0, pa1, pa2, pa3); expA(pB0, negBC);
    __syncthreads(); SWAIT(); SWRITE(0, SE);
    __syncthreads();
    SBAR(); qkt(pA0, pA1, K_lds, qr, r32, hi);
    finishFX(pB0, pB1, negBC, l_reg, pa0, pa1, pa2, pa3); SBAR();
    if (j + 3 < NT) SLOAD(SE, (j + 3) * KVBLK); SBAR();
    pv_d0(o, vb0 + (int)SHM_V, pa0, pa1, pa2, pa3); expA(pA0, negBC);
    __syncthreads(); SWAIT(); SWRITE(1, SO);
    __syncthreads();
  }
  SBAR(); qkt(pB0, pB1, (bf16*)((char*)K_lds + SHM_K), qr, r32, hi);
  finishFX(pA0, pA1, negBC, l_reg, pa0, pa1, pa2, pa3); SBAR();
  pv_d0(o, vb0, pa0, pa1, pa2, pa3); expA(pB0, negBC);
  __syncthreads();
  finishFX(pB0, pB1, negBC, l_reg, pa0, pa1, pa2, pa3); SBAR();
  pv_d0(o, vb0 + (int)SHM_V, pa0, pa1, pa2, pa3);
  { auto rr = __builtin_amdgcn_permlane32_swap(__float_as_uint(l_reg), __float_as_uint(l_reg), false, false); l_reg = __uint_as_float(rr[0]) + __uint_as_float(rr[1]); }
  if (hi == 0) li_l[r32] = l_reg; asm volatile("s_waitcnt lgkmcnt(0)" ::: "memory");
  float rli[16];
#pragma unroll
  for (int r = 0; r < 16; ++r) rli[r] = __builtin_amdgcn_rcpf(li_l[crow(r, hi)]);
  unsigned short* Ow = (unsigned short*)Ob + (long)(wid * QBLK) * LDO;
#pragma unroll
  for (int r = 0; r < 16; ++r) { int orow = crow(r, hi);
    for (int d0 = 0; d0 < 4; ++d0) Ow[(long)orow * LDO + d0 * 32 + r32] = (unsigned short)f2bf(o[d0][r] * rli[r]); }
  __syncthreads();
#undef SLOAD
#undef SWRITE
#undef SWAIT
}

template <bool FX>
__device__ __forceinline__ void attn_body_dma(const bf16* Qb, const bf16* __restrict__ Kh, const bf16* __restrict__ Vh, bf16* Ob, int seq, LAS unsigned char* ldsl, char* lds, float negBC, int wave_) {
  const int tid = tid_of(wave_), wid = __builtin_amdgcn_readfirstlane(tid >> 6), lane = tid & 63, r32 = lane & 31, hi = lane >> 5;
  constexpr int KRING = 0, VRING = 3 * 16384, SCR = 6 * 16384;
  float* ws = (float*)(lds + SCR) + wid * 64; float* li_l = ws; float* al_l = ws + 32;
  float m_reg = -1e30f, l_reg = 0; f32x16 o[4] = {}; bf16x8 qr[8];
  const bf16* Qw = Qb + (long)(wid * QBLK + r32) * LDQ + hi * 8;
#pragma unroll
  for (int d0 = 0; d0 < 8; ++d0) qr[d0] = *reinterpret_cast<const bf16x8*>(Qw + d0 * 16);
  unsigned kso[2], vso[2];
#pragma unroll
  for (int i = 0; i < 2; ++i) { const int q = i * 512 + tid;
    { const int row = q >> 4, c = (q & 15) ^ (row & 15); kso[i] = (unsigned)(row * LDK + c * 8) * 2u; }
    { const int b = q * 16, sub = b >> 9, within = b & 511, kk = (sub >> 2) * 8 + (within >> 6), cin = (within >> 1) & 31, k = (kk & ~0xC) | ((kk & 4) << 1) | ((kk & 8) >> 1), c = (sub & 3) * 32 + cin; vso[i] = (unsigned)(k * LDK + c) * 2u; } }
  const int NT = seq / KVBLK;
  const unsigned ldsw = (unsigned)wid * 1024u, ldsbase = (unsigned)(uintptr_t)ldsl;
#define GLDS16(gsrc, ldsdst) do { unsigned keep_; asm volatile("s_mov_b32 %0, m0\n\ts_mov_b32 m0, %2\n\ts_nop 0\n\tglobal_load_lds_dwordx4 %1, off\n\ts_mov_b32 m0, %0" : "=&s"(keep_) : "v"(gsrc), "s"(ldsdst) : "memory"); } while (0)
#define ISSUE_K(t, slot) do { const int tt_ = (t) < NT ? (t) : NT - 1; const char* kb_ = (const char*)Kh + (long)tt_ * (KVBLK * LDK * 2); _Pragma("unroll") for (int i_ = 0; i_ < 2; ++i_) \
    GLDS16((const void*)(kb_ + kso[i_]), ldsbase + (unsigned)(KRING + (slot) * 16384 + i_ * 8192) + ldsw); } while (0)
#define ISSUE_V(t, slot) do { const int tt_ = (t) < NT ? (t) : NT - 1; const char* vb_ = (const char*)Vh + (long)tt_ * (KVBLK * LDK * 2); _Pragma("unroll") for (int i_ = 0; i_ < 2; ++i_) \
    GLDS16((const void*)(vb_ + vso[i_]), ldsbase + (unsigned)(VRING + (slot) * 16384 + i_ * 8192) + ldsw); } while (0)
#define WAITBAR(N) asm volatile("s_waitcnt vmcnt(" #N ") lgkmcnt(0)\n\ts_barrier" ::: "memory")
#define RESC(a) do { if (__any((a) < 1.f)) { if (hi == 0) al_l[r32] = (a); asm volatile("s_waitcnt lgkmcnt(0)" ::: "memory"); \
    for (int d = 0; d < 4; ++d) for (int r = 0; r < 16; ++r) o[d][r] *= al_l[crow(r, hi)]; } } while (0)
  const int vb0 = (int)(uintptr_t)(lds + VRING) + v_rd_base(lane);
  const char* Kl = lds + KRING;
  f32x16 pA0, pA1, pB0, pB1; float mnA = 0, mnB = 0, alA = 1.f, alB = 1.f; bf16x8 pa0, pa1, pa2, pa3;
  ISSUE_K(0, 0); ISSUE_K(1, 1); ISSUE_V(0, 0); ISSUE_K(2, 2); ISSUE_V(1, 1);
  WAITBAR(8);
  qkt(pA0, pA1, (const bf16*)Kl, qr, r32, hi);
  if (FX) expA(pA0, negBC); else partialSM(pA0, pA1, m_reg, mnA, alA);
  WAITBAR(4);
  int s0 = 0, s1 = 1, s2 = 2;
  for (int j = 0; j < NT; j += 2) {
    ISSUE_K(j + 3, s0); ISSUE_V(j + 2, s2);
    SBAR(); qkt(pB0, pB1, (const bf16*)(Kl + s1 * 16384), qr, r32, hi);
    if (FX) finishFX(pA0, pA1, negBC, l_reg, pa0, pa1, pa2, pa3); else finishSM(pA0, pA1, alA, l_reg, pa0, pa1, pa2, pa3);
    SBAR();
    pv_d0(o, vb0 + s0 * 16384, pa0, pa1, pa2, pa3);
    if (FX) expA(pB0, negBC); else { partialSM(pB0, pB1, m_reg, mnB, alB); RESC(alB); }
    WAITBAR(4);
    ISSUE_K(j + 4, s1); ISSUE_V(j + 3, s0);
    const bool more = (j + 2 < NT);
    SBAR(); if (more) qkt(pA0, pA1, (const bf16*)(Kl + s2 * 16384), qr, r32, hi);
    if (FX) finishFX(pB0, pB1, negBC, l_reg, pa0, pa1, pa2, pa3); else finishSM(pB0, pB1, alB, l_reg, pa0, pa1, pa2, pa3);
    SBAR();
    pv_d0(o, vb0 + s1 * 16384, pa0, pa1, pa2, pa3);
    if (more) { if (FX) expA(pA0, negBC); else { partialSM(pA0, pA1, m_reg, mnA, alA); RESC(alA); } }
    WAITBAR(4);
    { const int t0 = s0, t1 = s1; s0 = s2; s1 = t0; s2 = t1; }
  }
  asm volatile("s_waitcnt vmcnt(0)" ::: "memory");
  if (FX) { auto rr = __builtin_amdgcn_permlane32_swap(__float_as_uint(l_reg), __float_as_uint(l_reg), false, false); l_reg = __uint_as_float(rr[0]) + __uint_as_float(rr[1]); }
  if (hi == 0) li_l[r32] = l_reg; asm volatile("s_waitcnt lgkmcnt(0)" ::: "memory");
  float rli[16];
#pragma unroll
  for (int r = 0; r < 16; ++r) rli[r] = __builtin_amdgcn_rcpf(li_l[crow(r, hi)]);
  unsigned short* Ow = (unsigned short*)Ob + (long)(wid * QBLK) * LDO;
#pragma unroll
  for (int r = 0; r < 16; ++r) { int orow = crow(r, hi);
    for (int d0 = 0; d0 < 4; ++d0) Ow[(long)orow * LDO + d0 * 32 + r32] = (unsigned short)f2bf(o[d0][r] * rli[r]); }
  asm volatile("s_waitcnt lgkmcnt(0)\n\ts_barrier" ::: "memory");
#undef GLDS16
#undef ISSUE_K
#undef ISSUE_V
#undef WAITBAR
#undef RESC
}

__device__ __forceinline__ void pk4x(const f32x16& P, int BASE, bf16x8& OUT) {
  unsigned a0 = cvtpk(P[BASE + 0], P[BASE + 1]), a1 = cvtpk(P[BASE + 2], P[BASE + 3]), b0 = cvtpk(P[BASE + 4], P[BASE + 5]), b1 = cvtpk(P[BASE + 6], P[BASE + 7]);
  auto r0 = __builtin_amdgcn_permlane32_swap(a0, b0, false, false); auto r1 = __builtin_amdgcn_permlane32_swap(a1, b1, false, false);
  u32x4 w = {r0[0], r1[0], r0[1], r1[1]}; OUT = *reinterpret_cast<bf16x8*>(&w);
}
template <int D0, int KS0> __device__ __forceinline__ void pv_half(f32x16& od, int vb, bf16x8 pa, bf16x8 pb) {
  const s16x4 l0 = tr_read<v_rd_off(D0, KS0, 0)>(vb), h0 = tr_read<v_rd_off(D0, KS0, 1)>(vb), l1 = tr_read<v_rd_off(D0, KS0 + 1, 0)>(vb), h1 = tr_read<v_rd_off(D0, KS0 + 1, 1)>(vb);
  asm volatile("s_waitcnt lgkmcnt(0)" ::: "memory"); SBAR();
#define PK(L, H) (bf16x8){L[0], L[1], L[2], L[3], H[0], H[1], H[2], H[3]}
  od = __builtin_amdgcn_mfma_f32_32x32x16_bf16(pa, PK(l0, h0), od, 0, 0, 0);
  od = __builtin_amdgcn_mfma_f32_32x32x16_bf16(pb, PK(l1, h1), od, 0, 0, 0);
#undef PK
}
__device__ __forceinline__ void attn_body_v2(const bf16* Qb, const bf16* __restrict__ Kh, const bf16* __restrict__ Vh, bf16* Ob, int seq, char* lds, float negBC, int wave_) {
  const int tid = tid_of(wave_), wid = tid >> 6, lane = tid & 63, r32 = lane & 31, hi = lane >> 5;
  bf16* V_lds = (bf16*)lds; bf16* K_lds = (bf16*)(lds + 2 * SHM_V);
  float* ws = (float*)(lds + 2 * SHM_V + 2 * SHM_K) + wid * 64; float* li_l = ws;
  float l_reg = 0; f32x16 o[4] = {}; bf16x8 qr[8];
  const bf16* Qw = Qb + (long)(wid * QBLK + r32) * LDQ + hi * 8;
#pragma unroll
  for (int d0 = 0; d0 < 8; ++d0) qr[d0] = *reinterpret_cast<const bf16x8*>(Qw + d0 * 16);
  const int sr = tid >> 4, sc = (tid & 15) * 8, vst0 = v_st(sr, sc), vst1 = v_st(32 + sr, sc);
  const int vb0 = (int)(uintptr_t)V_lds + v_rd_base(lane);
  struct { bf16x8 vs0, vs1, ks0, ks1; } sr_[2];
#define SLOAD(i, k0) do { sr_[i].vs0 = *(const bf16x8*)(&Vh[(long)((k0) + sr) * LDK + sc]); sr_[i].vs1 = *(const bf16x8*)(&Vh[(long)((k0) + 32 + sr) * LDK + sc]); \
    sr_[i].ks0 = *(const bf16x8*)(&Kh[(long)((k0) + sr) * LDK + sc]); sr_[i].ks1 = *(const bf16x8*)(&Kh[(long)((k0) + 32 + sr) * LDK + sc]); } while (0)
#define SWRITE(b, i) do { *(bf16x8*)((char*)V_lds + (b) * SHM_V + vst0) = sr_[i].vs0;          \
    *(bf16x8*)((char*)V_lds + (b) * SHM_V + vst1) = sr_[i].vs1; int kc = sc * 2;               \
    *(bf16x8*)((char*)K_lds + (b) * SHM_K + KSWZ(sr, kc)) = sr_[i].ks0;                       \
    *(bf16x8*)((char*)K_lds + (b) * SHM_K + KSWZ(32 + sr, kc)) = sr_[i].ks1; } while (0)
  const int NT = seq / KVBLK;
  f32x16 p0, p1; bf16x8 pa0, pa1, pa2, pa3;
#define TRR(dst, D0, KS, H) asm volatile("ds_read_b64_tr_b16 %0, %1 offset:%2" : "=&v"(dst) : "v"(vb_), "i"((D0) * 512 + (KS) * 4096 + (H) * 2048) : "memory")
#define RD4(x, D0, KS0) do { TRR(x##0_, D0, KS0, 0); TRR(x##1_, D0, KS0, 1); TRR(x##2_, D0, (KS0) + 1, 0); TRR(x##3_, D0, (KS0) + 1, 1); } while (0)
#define WAITL(N) asm volatile("s_waitcnt lgkmcnt(" #N ")" ::: "memory")
#define PKV(L, H) (bf16x8){L[0], L[1], L[2], L[3], H[0], H[1], H[2], H[3]}
#define MM2(od, pa, pb, x) do { od = __builtin_amdgcn_mfma_f32_32x32x16_bf16(pa, PKV(x##0_, x##1_), od, 0, 0, 0); od = __builtin_amdgcn_mfma_f32_32x32x16_bf16(pb, PKV(x##2_, x##3_), od, 0, 0, 0); } while (0)
#define TILE_COMPUTE(b) do { \
    const bf16* Ks_ = (const bf16*)((const char*)K_lds + (b) * SHM_K); const int vb_ = vb0 + (b) * (int)SHM_V; \
    p0 = f32x16{}; p1 = f32x16{}; \
    _Pragma("unroll") for (int d0 = 0; d0 < 8; ++d0) { const int cb = (d0 * 16 + hi * 8) * 2; \
      const bf16x8 b0 = *reinterpret_cast<const bf16x8*>((const char*)Ks_ + KSWZ(r32, cb)); p0 = __builtin_amdgcn_mfma_f32_32x32x16_bf16(b0, qr[d0], p0, 0, 0, 0); } \
    _Pragma("unroll") for (int d0 = 0; d0 < 8; ++d0) { const int cb = (d0 * 16 + hi * 8) * 2; \
      const bf16x8 b1 = *reinterpret_cast<const bf16x8*>((const char*)Ks_ + KSWZ(32 + r32, cb)); p1 = __builtin_amdgcn_mfma_f32_32x32x16_bf16(b1, qr[d0], p1, 0, 0, 0); } \
    { s16x4 ra0_, ra1_, ra2_, ra3_, rb0_, rb1_, rb2_, rb3_; \
      RD4(ra, 0, 0); RD4(rb, 1, 0);                                         \
      expA(p0, negBC); { float ps = 0; for (int r = 0; r < 16; ++r) ps += p0[r]; l_reg += ps; } pk4x(p0, 0, pa0); pk4x(p0, 8, pa1); \
      WAITL(4); SBAR(); MM2(o[0], pa0, pa1, ra); RD4(ra, 2, 0); WAITL(4); SBAR(); MM2(o[1], pa0, pa1, rb); RD4(rb, 3, 0); \
      WAITL(4); SBAR(); MM2(o[2], pa0, pa1, ra); WAITL(0); SBAR(); MM2(o[3], pa0, pa1, rb); \
      RD4(ra, 0, 2); RD4(rb, 1, 2);                                         \
      expA(p1, negBC); { float ps = 0; for (int r = 0; r < 16; ++r) ps += p1[r]; l_reg += ps; } pk4x(p1, 0, pa2); pk4x(p1, 8, pa3); \
      WAITL(4); SBAR(); MM2(o[0], pa2, pa3, ra); RD4(ra, 2, 2); WAITL(4); SBAR(); MM2(o[1], pa2, pa3, rb); RD4(rb, 3, 2); \
      WAITL(4); SBAR(); MM2(o[2], pa2, pa3, ra); WAITL(0); SBAR(); MM2(o[3], pa2, pa3, rb); } \
  } while (0)
  SLOAD(0, 0); asm volatile("s_waitcnt vmcnt(0)" ::: "memory"); SWRITE(0, 0);
  SLOAD(1, KVBLK); if (2 < NT) SLOAD(0, 2 * KVBLK);
  for (int j = 0; j < NT; j += 2) {
    asm volatile("s_waitcnt lgkmcnt(0)\n\ts_barrier" ::: "memory");
    if (j + 2 < NT) asm volatile("s_waitcnt vmcnt(4)" ::: "memory"); else asm volatile("s_waitcnt vmcnt(0)" ::: "memory");
    SWRITE(1, 1);
    if (j + 3 < NT) SLOAD(1, (j + 3) * KVBLK);
    SBAR(); TILE_COMPUTE(0);
    asm volatile("s_waitcnt lgkmcnt(0)\n\ts_barrier" ::: "memory");
    if (j + 2 < NT) { if (j + 3 < NT) asm volatile("s_waitcnt vmcnt(4)" ::: "memory"); else asm volatile("s_waitcnt vmcnt(0)" ::: "memory"); SWRITE(0, 0); }
    if (j + 4 < NT) SLOAD(0, (j + 4) * KVBLK);
    SBAR(); TILE_COMPUTE(1);
  }
  { auto rr = __builtin_amdgcn_permlane32_swap(__float_as_uint(l_reg), __float_as_uint(l_reg), false, false); l_reg = __uint_as_float(rr[0]) + __uint_as_float(rr[1]); }
  const int lane2 = tid_of(wave_) & 63, r32e = lane2 & 31, hie = lane2 >> 5;
  if (hie == 0) li_l[r32e] = l_reg; asm volatile("s_waitcnt lgkmcnt(0)" ::: "memory");
  float rli[16];
#pragma unroll
  for (int r = 0; r < 16; ++r) rli[r] = __builtin_amdgcn_rcpf(li_l[crow(r, hie)]);
  unsigned short* Ow = (unsigned short*)Ob + (long)(wid * QBLK) * LDO;
#pragma unroll
  for (int r = 0; r < 16; ++r) { int orow = crow(r, hie);
    for (int d0 = 0; d0 < 4; ++d0) Ow[(long)orow * LDO + d0 * 32 + r32e] = (unsigned short)f2bf(o[d0][r] * rli[r]); }
  __syncthreads();
#undef SLOAD
#undef SWRITE
#undef TILE_COMPUTE
#undef TRR
#undef RD4
#undef WAITL
#undef PKV
#undef MM2
}

#define TILE_BODY(BUFK, BUFV, WB, WS, NXT) do { \
    KRD(kf0, 0, (0) * 8192 + BUFK); \
    KRD(kf1, 1, (0) * 8192 + BUFK); \
    KRD(kf2, 2, (0) * 8192 + BUFK); \
    KRD(kf3, 3, (0) * 8192 + BUFK); \
    KRD(kf4, 4, (0) * 8192 + BUFK); \
    KRD(kf5, 5, (0) * 8192 + BUFK); \
    WMFMA_Z(4, p0, kf0, qr[0]); \
    KRD(kf0, 6, (0) * 8192 + BUFK); \
    MFMA_A(p0, kf1, qr[1]); \
    KRD(kf1, 7, (0) * 8192 + BUFK); \
    DSW0(WB, WS); \
    WMFMA_A(5, p0, kf2, qr[2]); \
    KRD(kf2, 0, (1) * 8192 + BUFK); \
    MFMA_A(p0, kf3, qr[3]); \
    KRD(kf3, 1, (1) * 8192 + BUFK); \
    DSW1(WB, WS); \
    WMFMA_A(6, p0, kf4, qr[4]); \
    KRD(kf4, 2, (1) * 8192 + BUFK); \
    MFMA_A(p0, kf5, qr[5]); \
    KRD(kf5, 3, (1) * 8192 + BUFK); \
    DSW2(WB, WS); \
    WMFMA_A(7, p0, kf0, qr[6]); \
    KRD(kf0, 4, (1) * 8192 + BUFK); \
    MFMA_A(p0, kf1, qr[7]); \
    KRD(kf1, 5, (1) * 8192 + BUFK); \
    DSW3(WB, WS); \
    WMFMA_Z(7, p1, kf2, qr[0]); \
    KRD(kf2, 6, (1) * 8192 + BUFK); \
    SLOADN(WS, NXT); \
    MFMA_A(p1, kf3, qr[1]); \
    KRD(kf3, 7, (1) * 8192 + BUFK); \
    TIE(p0); \
    EXPN(p0, 0, 4); \
    WMFMA_A(6, p1, kf4, qr[2]); \
    TIE(p0); \
    EXPN(p0, 4, 4); \
    MFMA_A(p1, kf5, qr[3]); \
    TIE(p0); \
    SUM8(p0, 0); pk4x(p0, 0, pa0); \
    WMFMA_A(3, p1, kf0, qr[4]); \
    TIE3(p0, l2, pa0); \
    EXPN(p0, 8, 4); \
    TRR(ra0_, (0) * 512 + (0) * 4096 + (0) * 2048 + BUFV); \
    TRR(ra1_, (0) * 512 + (0) * 4096 + (1) * 2048 + BUFV); \
    TRR(ra2_, (0) * 512 + (1) * 4096 + (0) * 2048 + BUFV); \
    TRR(ra3_, (0) * 512 + (1) * 4096 + (1) * 2048 + BUFV); \
    MFMA_A(p1, kf1, qr[5]); \
    TIE(p0); \
    EXPN(p0, 12, 4); \
    TRR(rb0_, (1) * 512 + (0) * 4096 + (0) * 2048 + BUFV); \
    TRR(rb1_, (1) * 512 + (0) * 4096 + (1) * 2048 + BUFV); \
    TRR(rb2_, (1) * 512 + (1) * 4096 + (0) * 2048 + BUFV); \
    TRR(rb3_, (1) * 512 + (1) * 4096 + (1) * 2048 + BUFV); \
    WMFMA_A(8, p1, kf2, qr[6]); \
    TIE(p0); \
    SUM8(p0, 8); pk4x(p0, 8, pa1); \
    MFMA_A(p1, kf3, qr[7]); \
    TIE3(p0, l2, pa1); \
    WMM2(4, o[0], pa0, pa1, ra); \
    TRR(ra0_, (2) * 512 + (0) * 4096 + (0) * 2048 + BUFV); \
    TRR(ra1_, (2) * 512 + (0) * 4096 + (1) * 2048 + BUFV); \
    TRR(ra2_, (2) * 512 + (1) * 4096 + (0) * 2048 + BUFV); \
    TRR(ra3_, (2) * 512 + (1) * 4096 + (1) * 2048 + BUFV); \
    TIE(p1); \
    EXPN(p1, 0, 8); \
    WMM2(4, o[1], pa0, pa1, rb); \
    TRR(rb0_, (3) * 512 + (0) * 4096 + (0) * 2048 + BUFV); \
    TRR(rb1_, (3) * 512 + (0) * 4096 + (1) * 2048 + BUFV); \
    TRR(rb2_, (3) * 512 + (1) * 4096 + (0) * 2048 + BUFV); \
    TRR(rb3_, (3) * 512 + (1) * 4096 + (1) * 2048 + BUFV); \
    TIE(p1); \
    SUM8(p1, 0); pk4x(p1, 0, pa2); \
    WMM2(4, o[2], pa0, pa1, ra); \
    TRR(ra0_, (0) * 512 + (2) * 4096 + (0) * 2048 + BUFV); \
    TRR(ra1_, (0) * 512 + (2) * 4096 + (1) * 2048 + BUFV); \
    TRR(ra2_, (0) * 512 + (3) * 4096 + (0) * 2048 + BUFV); \
    TRR(ra3_, (0) * 512 + (3) * 4096 + (1) * 2048 + BUFV); \
    TIE3(p1, l2, pa2); \
    EXPN(p1, 8, 8); \
    WMM2(4, o[3], pa0, pa1, rb); \
    TRR(rb0_, (1) * 512 + (2) * 4096 + (0) * 2048 + BUFV); \
    TRR(rb1_, (1) * 512 + (2) * 4096 + (1) * 2048 + BUFV); \
    TRR(rb2_, (1) * 512 + (3) * 4096 + (0) * 2048 + BUFV); \
    TRR(rb3_, (1) * 512 + (3) * 4096 + (1) * 2048 + BUFV); \
    TIE(p1); \
    SUM8(p1, 8); pk4x(p1, 8, pa3); \
    TIE3(p1, l2, pa3); \
    WMM2(4, o[0], pa2, pa3, ra); \
    TRR(ra0_, (2) * 512 + (2) * 4096 + (0) * 2048 + BUFV); \
    TRR(ra1_, (2) * 512 + (2) * 4096 + (1) * 2048 + BUFV); \
    TRR(ra2_, (2) * 512 + (3) * 4096 + (0) * 2048 + BUFV); \
    TRR(ra3_, (2) * 512 + (3) * 4096 + (1) * 2048 + BUFV); \
    WMM2(4, o[1], pa2, pa3, rb); \
    TRR(rb0_, (3) * 512 + (2) * 4096 + (0) * 2048 + BUFV); \
    TRR(rb1_, (3) * 512 + (2) * 4096 + (1) * 2048 + BUFV); \
    TRR(rb2_, (3) * 512 + (3) * 4096 + (0) * 2048 + BUFV); \
    TRR(rb3_, (3) * 512 + (3) * 4096 + (1) * 2048 + BUFV); \
    WMM2(4, o[2], pa2, pa3, ra); \
    WMM2(0, o[3], pa2, pa3, rb); \
  } while (0)

__device__ __forceinline__ void attn_body_v3(const bf16* Qb, const bf16* __restrict__ Kh, const bf16* __restrict__ Vh, bf16* Ob, int seq, char* lds, int wave_) {
  const int tid = tid_of(wave_), wid = tid >> 6, lane = tid & 63, r32 = lane & 31, hi = lane >> 5;
  bf16* V_lds = (bf16*)lds; bf16* K_lds = (bf16*)(lds + 4 * SHM_V);
  float* ws = (float*)(lds + 133120) + wid * 64; float* li_l = ws;
  f32x2 l2 = {0.f, 0.f}; f32x16 o[4] = {}; bf16x8 qr[8];
  const bf16* Qw = Qb + (long)(wid * QBLK + r32) * LDQ + hi * 8;
#pragma unroll
  for (int d0 = 0; d0 < 8; ++d0) qr[d0] = *reinterpret_cast<const bf16x8*>(Qw + d0 * 16);
  asm volatile("s_waitcnt vmcnt(0)" : "+v"(qr[0]), "+v"(qr[1]), "+v"(qr[2]), "+v"(qr[3]), "+v"(qr[4]), "+v"(qr[5]), "+v"(qr[6]), "+v"(qr[7]));
  const int sr = tid >> 4, sc = (tid & 15) * 8, vst0 = v_st(sr, sc), vst1 = v_st(32 + sr, sc);
  const int vb_ = (int)(uintptr_t)V_lds + v_rd_base(lane);
  const int kbase_ = (int)(uintptr_t)K_lds + r32 * 256 + ((hi ^ (r32 & 1)) << 4), kt_ = (r32 & 15) >> 1;
  const int kaddr0 = kbase_ + ((0 ^ kt_) << 5), kaddr1 = kbase_ + ((1 ^ kt_) << 5), kaddr2 = kbase_ + ((2 ^ kt_) << 5), kaddr3 = kbase_ + ((3 ^ kt_) << 5),
            kaddr4 = kbase_ + ((4 ^ kt_) << 5), kaddr5 = kbase_ + ((5 ^ kt_) << 5), kaddr6 = kbase_ + ((6 ^ kt_) << 5), kaddr7 = kbase_ + ((7 ^ kt_) << 5);
  const int vwa0 = (int)(uintptr_t)V_lds + vst0, vwa1 = (int)(uintptr_t)V_lds + vst1, kwa0 = (int)(uintptr_t)K_lds + KSWZ(sr, sc * 2), kwa1 = (int)(uintptr_t)K_lds + KSWZ(32 + sr, sc * 2);
  const unsigned goff0 = (unsigned)(sr * LDK + sc) * 2u, goff1 = goff0 + 32u * LDK * 2u;
  struct { bf16x8 vs0, vs1, ks0, ks1; } sr_[2];
#define GLD16S(dst, voff, sbase) asm volatile("global_load_dwordx4 %0, %1, %2" : "=&v"(dst) : "v"(voff), "s"(sbase) : "memory")
#define SLOAD(i, k0) do { const char* vb__ = (const char*)Vh + (long)(k0) * (LDK * 2); const char* kb__ = (const char*)Kh + (long)(k0) * (LDK * 2); \
    GLD16S(sr_[i].vs0, goff0, vb__); GLD16S(sr_[i].vs1, goff1, vb__); GLD16S(sr_[i].ks0, goff0, kb__); GLD16S(sr_[i].ks1, goff1, kb__); } while (0)
#define SLOADP(i) do { GLD16S(sr_[i].vs0, goff0, vnext_); GLD16S(sr_[i].vs1, goff1, vnext_); GLD16S(sr_[i].ks0, goff0, knext_); GLD16S(sr_[i].ks1, goff1, knext_); \
    vnext_ += KVBLK * LDK * 2; knext_ += KVBLK * LDK * 2; } while (0)
#define SWRITE(b, i) do { *(bf16x8*)((char*)V_lds + (b) * SHM_V + vst0) = sr_[i].vs0;          \
    *(bf16x8*)((char*)V_lds + (b) * SHM_V + vst1) = sr_[i].vs1; int kc = sc * 2;               \
    *(bf16x8*)((char*)K_lds + (b) * SHM_K + KSWZ(sr, kc)) = sr_[i].ks0;                       \
    *(bf16x8*)((char*)K_lds + (b) * SHM_K + KSWZ(32 + sr, kc)) = sr_[i].ks1; } while (0)
#define DSW0(WB, WS) asm volatile("s_waitcnt vmcnt(4)\n\tds_write_b128 %0, %1 offset:%2" :: "v"(vwa0), "v"(sr_[WS].vs0), "i"(WB) : "memory")
#define DSW1(WB, WS) asm volatile("ds_write_b128 %0, %1 offset:%2" :: "v"(vwa1), "v"(sr_[WS].vs1), "i"(WB) : "memory")
#define DSW2(WB, WS) asm volatile("ds_write_b128 %0, %1 offset:%2" :: "v"(kwa0), "v"(sr_[WS].ks0), "i"(WB) : "memory")
#define DSW3(WB, WS) asm volatile("ds_write_b128 %0, %1 offset:%2" :: "v"(kwa1), "v"(sr_[WS].ks1), "i"(WB) : "memory")
#define SLOADN(WS, T) SLOADP(WS)
#define KRD(dst, bq, imm) asm volatile("ds_read_b128 %0, %1 offset:%2" : "=&v"(dst) : "v"(kaddr##bq), "i"(imm) : "memory")
#define TRR(dst, imm) asm volatile("ds_read_b64_tr_b16 %0, %1 offset:%2" : "=&v"(dst) : "v"(vb_), "i"(imm) : "memory")
#define WAITL(N) asm volatile("s_waitcnt lgkmcnt(" #N ")" ::: "memory")
#define PKV(L, H) (bf16x8){L[0], L[1], L[2], L[3], H[0], H[1], H[2], H[3]}
#define MFMA_Z(acc, a, b) asm volatile("v_mfma_f32_32x32x16_bf16 %0, %1, %2, 0" : "=&v"(acc) : "v"(a), "v"(b))
#define MFMA_A(acc, a, b) asm volatile("v_mfma_f32_32x32x16_bf16 %0, %1, %2, %0" : "+v"(acc) : "v"(a), "v"(b))
#define WMFMA_Z(n, acc, a, b) asm volatile("s_waitcnt lgkmcnt(" #n ")\n\tv_mfma_f32_32x32x16_bf16 %0, %1, %2, 0" : "=&v"(acc) : "v"(a), "v"(b) : "memory")
#define WMFMA_A(n, acc, a, b) asm volatile("s_waitcnt lgkmcnt(" #n ")\n\tv_mfma_f32_32x32x16_bf16 %0, %1, %2, %0" : "+v"(acc) : "v"(a), "v"(b) : "memory")
#define WMM2(n, od, pa, pb, x) do { asm volatile("s_waitcnt lgkmcnt(" #n ")\n\tv_mfma_f32_32x32x16_bf16 %0, %1, %2, %0" : "+v"(od) : "v"(pa), "v"(PKV(x##0_, x##1_)) : "memory"); \
    asm volatile("v_mfma_f32_32x32x16_bf16 %0, %1, %2, %0" : "+v"(od) : "v"(pb), "v"(PKV(x##2_, x##3_))); } while (0)
#define TIE(p) asm volatile("" : "+v"(p))
#define TIE3(p, a, b) asm volatile("" : "+v"(p), "+v"(a), "+v"(b))
#define MM2(od, pa, pb, x) do { asm volatile("s_nop 1\n\tv_mfma_f32_32x32x16_bf16 %0, %1, %2, %0" : "+v"(od) : "v"(pa), "v"(PKV(x##0_, x##1_))); \
    asm volatile("v_mfma_f32_32x32x16_bf16 %0, %1, %2, %0" : "+v"(od) : "v"(pb), "v"(PKV(x##2_, x##3_))); } while (0)
#define EXPN(p, lo, n) do { _Pragma("unroll") for (int r_ = (lo); r_ < (lo) + (n); ++r_) p[r_] = __builtin_amdgcn_exp2f(p[r_]); } while (0)
#define SUM8(p, lo) do { _Pragma("unroll") for (int r_ = (lo); r_ < (lo) + 8; r_ += 2) l2 += (f32x2){p[r_], p[r_ + 1]}; } while (0)
  const int NT = seq / KVBLK;
  f32x16 p0, p1; bf16x8 pa0, pa1, pa2, pa3, kf0, kf1, kf2, kf3, kf4, kf5; s16x4 ra0_, ra1_, ra2_, ra3_, rb0_, rb1_, rb2_, rb3_;
  SLOAD(0, 0); SLOAD(1, KVBLK); asm volatile("s_waitcnt vmcnt(0)" ::: "memory"); SWRITE(0, 0); SWRITE(1, 1);
  const char* vnext_ = (const char*)Vh + 2L * KVBLK * LDK * 2; const char* knext_ = (const char*)Kh + 2L * KVBLK * LDK * 2;
  SLOADN(0, 2); SLOADN(1, 3);
  for (int j = 0; j < NT; j += 4) {
    asm volatile("s_waitcnt lgkmcnt(0)\n\ts_barrier" ::: "memory");
    TILE_BODY(0, 0, 32768, 0, j + 4);
    TILE_BODY(16384, 16384, 49152, 1, j + 5);
    asm volatile("s_waitcnt lgkmcnt(0)\n\ts_barrier" ::: "memory");
    TILE_BODY(32768, 32768, 0, 0, j + 6);
    TILE_BODY(49152, 49152, 16384, 1, j + 7);
  }
  asm volatile("s_nop 15\n\ts_nop 15" : "+v"(o[0]), "+v"(o[1]), "+v"(o[2]), "+v"(o[3]));
  float l_reg = l2.x + l2.y;
  { auto rr = __builtin_amdgcn_permlane32_swap(__float_as_uint(l_reg), __float_as_uint(l_reg), false, false); l_reg = __uint_as_float(rr[0]) + __uint_as_float(rr[1]); }
  const int lane2 = tid_of(wave_) & 63, r32e = lane2 & 31, hie = lane2 >> 5;
  if (hie == 0) li_l[r32e] = l_reg; asm volatile("s_waitcnt lgkmcnt(0)" ::: "memory");
  float rli[16];
#pragma unroll
  for (int r = 0; r < 16; ++r) rli[r] = __builtin_amdgcn_rcpf(li_l[crow(r, hie)]);
  unsigned short* Ow = (unsigned short*)Ob + (long)(wid * QBLK) * LDO;
#pragma unroll
  for (int r = 0; r < 16; ++r) { int orow = crow(r, hie);
    for (int d0 = 0; d0 < 4; ++d0) Ow[(long)orow * LDO + d0 * 32 + r32e] = (unsigned short)f2bf(o[d0][r] * rli[r]); }
  __syncthreads();
#undef SLOAD
#undef SLOADP
#undef GLD16S
#undef SWRITE
#undef DSW0
#undef DSW1
#undef DSW2
#undef DSW3
#undef SLOADN
#undef KRD
#undef TRR
#undef WAITL
#undef PKV
#undef MM2
#undef EXPN
#undef SUM8
#undef MFMA_Z
#undef MFMA_A
#undef WMFMA_Z
#undef WMFMA_A
#undef WMM2
#undef TIE
#undef TIE3
}
#undef TILE_BODY

#define TILE_BODY(BUFK, BUFV, WB, WS, NXT) do { \
    KRD(kf0, 0, (0) * 8192 + BUFK); \
    KRD(kf1, 1, (0) * 8192 + BUFK); \
    KRD(kf2, 2, (0) * 8192 + BUFK); \
    KRD(kf3, 3, (0) * 8192 + BUFK); \
    KRD(kf4, 4, (0) * 8192 + BUFK); \
    KRD(kf5, 5, (0) * 8192 + BUFK); \
    WMFMA_Z_KR(4, p0, kf0, qr[0], kf0, 6, (0) * 8192 + BUFK); \
    MFMA_A_KR(p0, kf1, qr[1], kf1, 7, (0) * 8192 + BUFK); \
    DSWK0(WB, WS); \
    WMFMA_A_KR(5, p0, kf2, qr[2], kf2, 0, (1) * 8192 + BUFK); \
    DSWK1(WB, WS); \
    MFMA_A_KR(p0, kf3, qr[3], kf3, 1, (1) * 8192 + BUFK); \
    DSWV0(WB, WS); \
    WMFMA_A_KR(7, p0, kf4, qr[4], kf4, 2, (1) * 8192 + BUFK); \
    DSWV1(WB, WS); \
    MFMA_A_KR(p0, kf5, qr[5], kf5, 3, (1) * 8192 + BUFK); \
    DSWV2(WB, WS); \
    WMFMA_A_KR(9, p0, kf0, qr[6], kf0, 4, (1) * 8192 + BUFK); \
    DSWV3(WB, WS); \
    MFMA_A_KR(p0, kf1, qr[7], kf1, 5, (1) * 8192 + BUFK); \
    WMFMA_Z_KR(8, p1, kf2, qr[0], kf2, 6, (1) * 8192 + BUFK); \
    SLOADN(WS, NXT); \
    MFMA_A_KR(p1, kf3, qr[1], kf3, 7, (1) * 8192 + BUFK); \
    TIE(p0); \
    EXPN(p0, 0, 4); \
    WMFMA_A(6, p1, kf4, qr[2]); \
    TIE(p0); \
    EXPN(p0, 4, 4); \
    MFMA_A(p1, kf5, qr[3]); \
    TIE(p0); \
    SUM8(p0, 0); PACK8(p0, 0, pb0); \
    WMFMA_A(2, p1, kf0, qr[4]); \
    TIE3(p0, l2, pb0); \
    EXPN(p0, 8, 4); \
    VRD(ra0_, 0, (0) * 4096 + BUFV); \
    VRD(ra1_, 1, (0) * 4096 + BUFV); \
    MFMA_A(p1, kf1, qr[5]); \
    TIE(p0); \
    EXPN(p0, 12, 4); \
    VRD(rb0_, 0, (1) * 4096 + BUFV); \
    VRD(rb1_, 1, (1) * 4096 + BUFV); \
    WMFMA_A(4, p1, kf2, qr[6]); \
    TIE(p0); \
    SUM8(p0, 8); PACK8(p0, 8, pb1); \
    MFMA_A(p1, kf3, qr[7]); \
    TIE3(p0, l2, pb1); \
    WMM2T(2, ot[0], ra, pb0, pb1); \
    VRD(ra0_, 0, (2) * 4096 + BUFV); \
    VRD(ra1_, 1, (2) * 4096 + BUFV); \
    TIE(p1); \
    EXPN(p1, 0, 8); \
    WMM2T(2, ot[1], rb, pb0, pb1); \
    VRD(rb0_, 0, (3) * 4096 + BUFV); \
    VRD(rb1_, 1, (3) * 4096 + BUFV); \
    TIE(p1); \
    SUM8(p1, 0); PACK8(p1, 0, pb2); \
    WMM2T(2, ot[2], ra, pb0, pb1); \
    VRD(ra0_, 2, (0) * 4096 + BUFV); \
    VRD(ra1_, 3, (0) * 4096 + BUFV); \
    TIE3(p1, l2, pb2); \
    EXPN(p1, 8, 8); \
    WMM2T(2, ot[3], rb, pb0, pb1); \
    VRD(rb0_, 2, (1) * 4096 + BUFV); \
    VRD(rb1_, 3, (1) * 4096 + BUFV); \
    TIE(p1); \
    SUM8(p1, 8); PACK8(p1, 8, pb3); \
    TIE3(p1, l2, pb3); \
    WMM2T(2, ot[0], ra, pb2, pb3); \
    VRD(ra0_, 2, (2) * 4096 + BUFV); \
    VRD(ra1_, 3, (2) * 4096 + BUFV); \
    WMM2T(2, ot[1], rb, pb2, pb3); \
    VRD(rb0_, 2, (3) * 4096 + BUFV); \
    VRD(rb1_, 3, (3) * 4096 + BUFV); \
    WMM2T(2, ot[2], ra, pb2, pb3); \
    WMM2T(0, ot[3], rb, pb2, pb3); \
  } while (0)

__device__ __forceinline__ void attn_body_v4(const bf16* Qb, const bf16* __restrict__ Kh, const bf16* __restrict__ Vth, bf16* Ob, int seq, char* lds, int wave_, const float* qg, const float* rope, int tok0) {
  constexpr int VTLD = MR;
  const int tid = tid_of(wave_), wid = tid >> 6, lane = tid & 63, r32 = lane & 31, hi = lane >> 5;
  bf16* V_lds = (bf16*)lds; bf16* K_lds = (bf16*)(lds + 4 * SHM_V);
  f32x2 l2 = {0.f, 0.f}; f32x16 ot[4] = {}; bf16x8 qr[8];
  const bf16* Qw = Qb + (long)(wid * QBLK + r32) * LDQ + hi * 8;
#pragma unroll
  for (int d0 = 0; d0 < 8; ++d0) qr[d0] = *reinterpret_cast<const bf16x8*>(Qw + d0 * 16);
  q_prologue(qr, qg, rope, tok0 < 0 ? -1 : tok0 + wid * QBLK + r32, hi);
  asm volatile("s_waitcnt vmcnt(0)" : "+v"(qr[0]), "+v"(qr[1]), "+v"(qr[2]), "+v"(qr[3]), "+v"(qr[4]), "+v"(qr[5]), "+v"(qr[6]), "+v"(qr[7]));
  const int sr = tid >> 4, sc = (tid & 15) * 8;
  const int kbase_ = (int)(uintptr_t)K_lds + r32 * 256 + ((hi ^ (r32 & 1)) << 4), kt_ = (r32 & 15) >> 1;
  const int kaddr0 = kbase_ + ((0 ^ kt_) << 5), kaddr1 = kbase_ + ((1 ^ kt_) << 5), kaddr2 = kbase_ + ((2 ^ kt_) << 5), kaddr3 = kbase_ + ((3 ^ kt_) << 5),
            kaddr4 = kbase_ + ((4 ^ kt_) << 5), kaddr5 = kbase_ + ((5 ^ kt_) << 5), kaddr6 = kbase_ + ((6 ^ kt_) << 5), kaddr7 = kbase_ + ((7 ^ kt_) << 5);
  const int vbase_ = (int)(uintptr_t)V_lds + r32 * 128, vt_ = (r32 >> 1) & 7;
  const int vaddr0 = vbase_ + (((0 + hi) ^ vt_) << 4), vaddr1 = vbase_ + (((2 + hi) ^ vt_) << 4), vaddr2 = vbase_ + (((4 + hi) ^ vt_) << 4), vaddr3 = vbase_ + (((6 + hi) ^ vt_) << 4);
  const int kwa0 = (int)(uintptr_t)K_lds + KSWZ(sr, sc * 2), kwa1 = (int)(uintptr_t)K_lds + KSWZ(32 + sr, sc * 2);
  const unsigned goff0 = (unsigned)(sr * LDK + sc) * 2u, goff1 = goff0 + 32u * LDK * 2u;
  const int vd0_ = tid >> 3, vd1_ = 64 + (tid >> 3), vcs_ = tid & 7, vg_ = vcs_ >> 1, ve_ = vcs_ & 1;
  const unsigned goffv0 = (unsigned)(vd0_ * VTLD + vcs_ * 8) * 2u, goffv1 = (unsigned)(vd1_ * VTLD + vcs_ * 8) * 2u;
  const int vwl0 = (int)(uintptr_t)V_lds + vd0_ * 128 + (((2 * vg_) ^ ((vd0_ >> 1) & 7)) << 4) + 8 * ve_, vwh0 = (int)(uintptr_t)V_lds + vd0_ * 128 + (((2 * vg_ + 1) ^ ((vd0_ >> 1) & 7)) << 4) + 8 * ve_;
  const int vwl1 = (int)(uintptr_t)V_lds + vd1_ * 128 + (((2 * vg_) ^ ((vd1_ >> 1) & 7)) << 4) + 8 * ve_, vwh1 = (int)(uintptr_t)V_lds + vd1_ * 128 + (((2 * vg_ + 1) ^ ((vd1_ >> 1) & 7)) << 4) + 8 * ve_;
  struct { bf16x8 vs0, vs1, ks0, ks1; } sr_[2];
#define GLD16S(dst, voff, sbase) asm volatile("global_load_dwordx4 %0, %1, %2" : "=&v"(dst) : "v"(voff), "s"(sbase) : "memory")
#define SLOADP(i) do { GLD16S(sr_[i].vs0, goffv0, vnext_); GLD16S(sr_[i].vs1, goffv1, vnext_); GLD16S(sr_[i].ks0, goff0, knext_); GLD16S(sr_[i].ks1, goff1, knext_); \
    vnext_ += KVBLK * 2; knext_ += KVBLK * LDK * 2; } while (0)
#define SLOADN(WS, T) SLOADP(WS)
#define LO4(x) __builtin_shufflevector(x, x, 0, 1, 2, 3)
#define HI4(x) __builtin_shufflevector(x, x, 4, 5, 6, 7)
#define DSWK0(WB, WS) asm volatile("s_waitcnt vmcnt(4)\n\tds_write_b128 %0, %1 offset:%2" :: "v"(kwa0), "v"(sr_[WS].ks0), "i"(WB) : "memory")
#define DSWK1(WB, WS) asm volatile("ds_write_b128 %0, %1 offset:%2" :: "v"(kwa1), "v"(sr_[WS].ks1), "i"(WB) : "memory")
#define DSWV0(WB, WS) asm volatile("ds_write_b64 %0, %1 offset:%2" :: "v"(vwl0), "v"(LO4(sr_[WS].vs0)), "i"(WB) : "memory")
#define DSWV1(WB, WS) asm volatile("ds_write_b64 %0, %1 offset:%2" :: "v"(vwh0), "v"(HI4(sr_[WS].vs0)), "i"(WB) : "memory")
#define DSWV2(WB, WS) asm volatile("ds_write_b64 %0, %1 offset:%2" :: "v"(vwl1), "v"(LO4(sr_[WS].vs1)), "i"(WB) : "memory")
#define DSWV3(WB, WS) asm volatile("ds_write_b64 %0, %1 offset:%2" :: "v"(vwh1), "v"(HI4(sr_[WS].vs1)), "i"(WB) : "memory")
#define DSWALL(WB, WS) do { DSWK0(WB, WS); DSWK1(WB, WS); DSWV0(WB, WS); DSWV1(WB, WS); DSWV2(WB, WS); DSWV3(WB, WS); } while (0)
#define KRD(dst, bq, imm) asm volatile("ds_read_b128 %0, %1 offset:%2" : "=&v"(dst) : "v"(kaddr##bq), "i"(imm) : "memory")
#define VRD(dst, ks, imm) asm volatile("ds_read_b128 %0, %1 offset:%2" : "=&v"(dst) : "v"(vaddr##ks), "i"(imm) : "memory")
#define MFMA_A(acc, a, b) asm volatile("v_mfma_f32_32x32x16_bf16 %0, %1, %2, %0" : "+v"(acc) : "v"(a), "v"(b))
#define WMFMA_Z(n, acc, a, b) asm volatile("s_waitcnt lgkmcnt(" #n ")\n\tv_mfma_f32_32x32x16_bf16 %0, %1, %2, 0" : "=&v"(acc) : "v"(a), "v"(b) : "memory")
#define WMFMA_A(n, acc, a, b) asm volatile("s_waitcnt lgkmcnt(" #n ")\n\tv_mfma_f32_32x32x16_bf16 %0, %1, %2, %0" : "+v"(acc) : "v"(a), "v"(b) : "memory")
#define WMFMA_Z_KR(n, acc, a, b, kfn, bq, imm) asm volatile("s_waitcnt lgkmcnt(" #n ")\n\tv_mfma_f32_32x32x16_bf16 %0, %2, %3, 0\n\tds_read_b128 %1, %4 offset:%5" : "=&v"(acc), "=&v"(kfn) : "v"(a), "v"(b), "v"(kaddr##bq), "i"(imm) : "memory")
#define WMFMA_A_KR(n, acc, a, b, kfn, bq, imm) asm volatile("s_waitcnt lgkmcnt(" #n ")\n\tv_mfma_f32_32x32x16_bf16 %0, %2, %3, %0\n\tds_read_b128 %1, %4 offset:%5" : "+v"(acc), "=&v"(kfn) : "v"(a), "v"(b), "v"(kaddr##bq), "i"(imm) : "memory")
#define MFMA_A_KR(acc, a, b, kfn, bq, imm) asm volatile("v_mfma_f32_32x32x16_bf16 %0, %2, %3, %0\n\tds_read_b128 %1, %4 offset:%5" : "+v"(acc), "=&v"(kfn) : "v"(a), "v"(b), "v"(kaddr##bq), "i"(imm) : "memory")
#define WMM2T(n, od, x, pa, pb) asm volatile("s_waitcnt lgkmcnt(" #n ")\n\tv_mfma_f32_32x32x16_bf16 %0, %1, %2, %0\n\tv_mfma_f32_32x32x16_bf16 %0, %3, %4, %0" : "+v"(od) : "v"(x##0_), "v"(pa), "v"(x##1_), "v"(pb) : "memory")
#define TIE(p) asm volatile("" : "+v"(p))
#define TIE3(p, a, b) asm volatile("" : "+v"(p), "+v"(a), "+v"(b))
#define EXPN(p, lo, n) do { _Pragma("unroll") for (int r_ = (lo); r_ < (lo) + (n); ++r_) p[r_] = __builtin_amdgcn_exp2f(p[r_]); } while (0)
#define SUM8(p, lo) do { _Pragma("unroll") for (int r_ = (lo); r_ < (lo) + 8; r_ += 2) l2 += (f32x2){p[r_], p[r_ + 1]}; } while (0)
#define PACK8(P, BASE, OUT) do { u32x4 w_ = {cvtpk(P[(BASE) + 0], P[(BASE) + 1]), cvtpk(P[(BASE) + 2], P[(BASE) + 3]), cvtpk(P[(BASE) + 4], P[(BASE) + 5]), cvtpk(P[(BASE) + 6], P[(BASE) + 7])}; OUT = *reinterpret_cast<bf16x8*>(&w_); } while (0)
  const int NT = seq / KVBLK;
  f32x16 p0, p1; bf16x8 pb0, pb1, pb2, pb3, kf0, kf1, kf2, kf3, kf4, kf5, ra0_, ra1_, rb0_, rb1_;
  const char* vnext_ = (const char*)Vth; const char* knext_ = (const char*)Kh;
  SLOADP(0); SLOADP(1); asm volatile("s_waitcnt vmcnt(0)" ::: "memory"); DSWALL(0, 0); DSWALL(16384, 1);
  SLOADP(0); SLOADP(1);
  for (int j = 0; j < NT; j += 4) {
    asm volatile("s_waitcnt lgkmcnt(0)\n\ts_barrier" ::: "memory");
    TILE_BODY(0, 0, 32768, 0, j + 4);
    TILE_BODY(16384, 16384, 49152, 1, j + 5);
    asm volatile("s_waitcnt lgkmcnt(0)\n\ts_barrier" ::: "memory");
    TILE_BODY(32768, 32768, 0, 0, j + 6);
    TILE_BODY(49152, 49152, 16384, 1, j + 7);
  }
  asm volatile("s_waitcnt vmcnt(0)" : "+v"(sr_[0].vs0), "+v"(sr_[0].vs1), "+v"(sr_[0].ks0), "+v"(sr_[0].ks1), "+v"(sr_[1].vs0), "+v"(sr_[1].vs1), "+v"(sr_[1].ks0), "+v"(sr_[1].ks1));
  asm volatile("s_nop 15\n\ts_nop 15" : "+v"(ot[0]), "+v"(ot[1]), "+v"(ot[2]), "+v"(ot[3]));
  float l_reg = l2.x + l2.y;
  { auto rr = __builtin_amdgcn_permlane32_swap(__float_as_uint(l_reg), __float_as_uint(l_reg), false, false); l_reg = __uint_as_float(rr[0]) + __uint_as_float(rr[1]); }
  const float rl = __builtin_amdgcn_rcpf(l_reg);
  const int lane2 = tid_of(wave_) & 63, r32e = lane2 & 31, hie = lane2 >> 5;
  unsigned short* Ow = (unsigned short*)Ob + (long)(wid * QBLK + r32e) * LDO + 4 * hie;
#pragma unroll
  for (int D0 = 0; D0 < 4; ++D0)
#pragma unroll
    for (int g4 = 0; g4 < 4; ++g4) { u32x2 w; w.x = cvtpk(ot[D0][4 * g4 + 0] * rl, ot[D0][4 * g4 + 1] * rl); w.y = cvtpk(ot[D0][4 * g4 + 2] * rl, ot[D0][4 * g4 + 3] * rl);
      *(u32x2*)(Ow + D0 * 32 + 8 * g4) = w; }
  __syncthreads();
#undef GLD16S
#undef SLOADP
#undef SLOADN
#undef LO4
#undef HI4
#undef DSWK0
#undef DSWK1
#undef DSWV0
#undef DSWV1
#undef DSWV2
#undef DSWV3
#undef DSWALL
#undef KRD
#undef VRD
#undef MFMA_A
#undef WMFMA_Z
#undef WMFMA_A
#undef WMFMA_Z_KR
#undef WMFMA_A_KR
#undef MFMA_A_KR
#undef WMM2T
#undef TIE
#undef TIE3
#undef EXPN
#undef SUM8
#undef PACK8
}
#undef TILE_BODY
}

#ifdef ATT_DMA
#define ATT_FAST attn_body_dma<true>
#define ATT_FAST_ARGS F.lds, (char*)lds,
#elif defined(ATT_FX1)
#define ATT_FAST attn_dense_body_fx
#define ATT_FAST_ARGS (char*)lds,
#elif defined(ATT_V2)
#define ATT_FAST attn_body_v2
#define ATT_FAST_ARGS (char*)lds,
#else
#define ATT_V3 1
#endif
struct Args { const float* in[23]; float* out; unsigned char* ws; int ph_lo, ph_hi; };

struct Frame {
    LAS unsigned char* lds; unsigned char* ldsg;
    gu32* ctl; unsigned char* ws;
    int tid, lane, wave, vcu, G, gw, NGW;
};
__device__ __forceinline__ Frame opaque(const Frame& F0) { Frame F = F0; const int t = tid_of(F0.wave); F.tid = t; F.lane = t & 63; return F; }

__device__ __forceinline__ void p0_transpose_item(const float* W, int N, bf16_t* WT, int ldt, int drow0, int k0, int n0, LAS float* scr, int lane) {
#pragma unroll 8
    for (int i = 0; i < 32; ++i) { const int kk = 2 * i + (lane >> 5); scr[kk * 33 + (lane & 31)] = W[(size_t)(k0 + kk) * N + n0 + (lane & 31)]; }
    LDS_WAIT(); asm volatile("" ::: "memory");
    const int c = lane & 7;
#pragma unroll
    for (int j = 0; j < 4; ++j) { const int n = (lane >> 3) + 8 * j; const LAS float* s = scr + (8 * c) * 33 + n;
        u32x4 o; o.x = pk2(s[0 * 33], s[1 * 33]); o.y = pk2(s[2 * 33], s[3 * 33]); o.z = pk2(s[4 * 33], s[5 * 33]); o.w = pk2(s[6 * 33], s[7 * 33]);
        *(GAS u32x4*)(WT + (size_t)(drow0 + n) * ldt + k0 + 8 * c) = o; }
    LDS_WAIT(); asm volatile("" ::: "memory");
}
__device__ __forceinline__ void p0_convert(Frame& F, const float* W, int K, int N, bf16_t* WT, int mode) {
    LAS float* scr = (LAS float*)(F.lds + F.wave * 16384);
    const int nblk = N / 32, nitems = (K / 64) * nblk;
    for (int it = F.gw; it < nitems; it += F.NGW) { const int kb = it / nblk, nb = it % nblk, n0 = nb * 32;
        const int drow0 = mode == 0 ? n0 : ((n0 >> 7) * 256 + (n0 & 127) + (mode == 2 ? 128 : 0));
        p0_transpose_item(W, N, WT, K, drow0, kb * 64, n0, scr, F.lane); }
}
__device__ __forceinline__ float siluf_(float x) { return x / (1.0f + __expf(-x)); }

__device__ __forceinline__ void p0_prologue(const Frame& F0, const Args& A) {
    Frame F = opaque(F0);
    unsigned char* ws = F.ws;
    if (F.gw < 1536) {
        const int task = F.gw, l = task / 768, rem = task % 768, chunk = rem / 16, slab = rem % 16;
        const float* w = A.in[4] + (size_t)l * DM * 12288 + chunk * 256 + F.lane * 4;
        const float* cv = A.in[1]; const float* xv = A.in[3];
        f32x4 a0 = {0.f, 0.f, 0.f, 0.f}, a1 = {0.f, 0.f, 0.f, 0.f};
#pragma unroll 8
        for (int k = slab * 128; k < slab * 128 + 128; ++k) { const f32x4 wv = *(const f32x4*)(w + (size_t)k * 12288); const float s0 = siluf_(cv[k]), s1 = siluf_(xv[k]); a0 += wv * s0; a1 += wv * s1; }
        float* part = (float*)(ws + WS_PART);
        *(f32x4*)(part + ((size_t)((slab * 2 + l) * 2 + 0) * 12288 + chunk * 256 + F.lane * 4)) = a0;
        *(f32x4*)(part + ((size_t)((slab * 2 + l) * 2 + 1) * 12288 + chunk * 256 + F.lane * 4)) = a1;
    }
    const int gtid = F.gw * 64 + F.lane, gstride = F.NGW * 64;
    { bf16_t* DC = (bf16_t*)(ws + WS_TAB + TAB_DC);
      for (int idx = gtid; idx < 512 * 256; idx += gstride) { const int r = idx >> 8, c = idx & 255, reim = r >> 8, m = r & 255, ph = (m * c) & 255; float s, co; sincospif((float)ph * (2.0f / 256.0f), &s, &co);
          DC[idx] = (bf16_t)f2bf((reim ? -s : co) * 0.0625f); }
      bf16_t* DN = (bf16_t*)(ws + WS_TAB + TAB_DN);
      for (int idx = gtid; idx < 256 * 256; idx += gstride) { const int r = idx >> 8, cc = idx & 255, ro = r >> 7, k = r & 127, ci = cc >> 7, b = cc & 127, ph = (k * b) & 127; float s, co; sincospif((float)ph * (2.0f / 128.0f), &s, &co);
          const float v = (ro == ci) ? co : (ro == 0 ? s : -s); DN[idx] = (bf16_t)f2bf(v * 0.08838834764831845f); }
      bf16_t* D2 = (bf16_t*)(ws + WS_TAB + TAB_D256);
      for (int idx = gtid; idx < 256 * 512; idx += gstride) { const int k = idx >> 9, cc = idx & 511, ci = cc >> 8, n = cc & 255, ph = (k * n) & 255; float s, co; sincospif((float)ph * (2.0f / 256.0f), &s, &co);
          D2[idx] = (bf16_t)f2bf((ci ? s : co) * 0.0625f); }
      float* rope = (float*)(ws + WS_TAB + TAB_ROPE);
      for (int idx = gtid; idx < 320 * 32; idx += gstride) { const int p = idx >> 5, j = idx & 31; const float inv = powf(10000.0f, -(float)j / 32.0f);
          const float pos = (float)(p < 256 ? p : p - 256); const float ang = pos * inv; float s, co; sincosf(ang, &s, &co);
          if (p < 256) { rope[p * 32 + j] = co; rope[8192 + p * 32 + j] = s; } else { rope[16384 + (p - 256) * 32 + j] = co; rope[16384 + 2048 + (p - 256) * 32 + j] = s; } }
    }
    for (int l = 0; l < 2; ++l) {
        p0_convert(F, A.in[8] + (size_t)l * DM * INC, DM, INC, (bf16_t*)(ws + WS_WIN) + (size_t)l * INC * DM, 0);
        p0_convert(F, A.in[12] + (size_t)l * QW * DM, QW, DM, (bf16_t*)(ws + WS_WAP) + (size_t)l * DM * QW, 0);
        p0_convert(F, A.in[13] + (size_t)l * FD * DM, FD, DM, (bf16_t*)(ws + WS_WFP) + (size_t)l * DM * FD, 0);
        p0_convert(F, A.in[14] + (size_t)l * DM * DM, DM, DM, (bf16_t*)(ws + WS_WOUT) + (size_t)l * DM * DM, 0);
    }
    p0_convert(F, A.in[15], DM, DFF, (bf16_t*)(ws + WS_WGU), 1);
    p0_convert(F, A.in[16], DM, DFF, (bf16_t*)(ws + WS_WGU), 2);
    p0_convert(F, A.in[17], DFF, DM, (bf16_t*)(ws + WS_WD), 0);
    for (int e = 0; e < NE; ++e) {
        p0_convert(F, A.in[19] + (size_t)e * DM * DFE, DM, DFE, (bf16_t*)(ws + WS_MGU) + (size_t)e * 2 * DFE * DM, 1);
        p0_convert(F, A.in[20] + (size_t)e * DM * DFE, DM, DFE, (bf16_t*)(ws + WS_MGU) + (size_t)e * 2 * DFE * DM, 2);
        p0_convert(F, A.in[21] + (size_t)e * DFE * DM, DFE, DM, (bf16_t*)(ws + WS_MD) + (size_t)e * DM * DFE, 0);
    }
}
__device__ __forceinline__ void p0b_mod(const Frame& F0, const Args& A) {
    Frame F = opaque(F0);
    const float* part = (const float*)(F.ws + WS_PART); float* mod = (float*)(F.ws + WS_MOD);
    for (int idx = F.gw * 64 + F.lane; idx < 2 * 2 * 12288; idx += F.NGW * 64) { const int l = idx / 24576, cond = (idx / 12288) & 1, col = idx % 12288;
        float s = A.in[5][l * 12288 + col];
#pragma unroll
        for (int slab = 0; slab < 16; ++slab) s += part[(size_t)((slab * 2 + l) * 2 + cond) * 12288 + col];
        mod[idx] = s; }
}

template <bool ROUTER>
__device__ __forceinline__ void norm_phase(const Frame& F0, const float* xl, const float* xc, int nrows, const float* gamma, const float* modL, const float* modC, int ksh, bf16_t* H,
                                           const float* router_w, i32x4* route, f32x2* rwt, const float* cparts = nullptr, int ncparts = 0, float* xc_out = nullptr, const bf16_t* xlb = nullptr) {
    Frame F = opaque(F0);
    LAS float* PA = (LAS float*)F.lds;
    LAS float* PB = PA + 2 * DM;
    LAS float* RW = PB + 2 * DM;
    {
        float g_[4], sl_[4], hl_[4], sc_[4], hc_[4];
#pragma unroll
        for (int q = 0; q < DM / 512; ++q) { const int i = F.tid + 512 * q; g_[q] = gamma[i]; sl_[q] = modL[(ksh + 1) * DM + i]; hl_[q] = modL[ksh * DM + i]; sc_[q] = modC[(ksh + 1) * DM + i]; hc_[q] = modC[ksh * DM + i]; }
        f32x4 w0[4], w1[4];
        if (ROUTER) {
#pragma unroll
            for (int q = 0; q < DM / 512; ++q) { const int c = F.tid + 512 * q; w0[q] = *(const f32x4*)(router_w + c * NE); w1[q] = *(const f32x4*)(router_w + c * NE + 4); } }
#pragma unroll
        for (int q = 0; q < DM / 512; ++q) { const int i = F.tid + 512 * q;
            PA[i] = g_[q] * (1.0f + sl_[q]); PB[i] = hl_[q]; PA[DM + i] = g_[q] * (1.0f + sc_[q]); PB[DM + i] = hc_[q]; }
        if (ROUTER) {
#pragma unroll
            for (int q = 0; q < DM / 512; ++q) { const int c = F.tid + 512 * q;
                RW[0 * DM + c] = w0[q].x; RW[1 * DM + c] = w0[q].y; RW[2 * DM + c] = w0[q].z; RW[3 * DM + c] = w0[q].w;
                RW[4 * DM + c] = w1[q].x; RW[5 * DM + c] = w1[q].y; RW[6 * DM + c] = w1[q].z; RW[7 * DM + c] = w1[q].w; } }
    }
    LAS unsigned* cntL = (LAS unsigned*)(RW + DM * NE); LAS unsigned* baseL = cntL + 8; LAS i32x4* RI = (LAS i32x4*)(cntL + 16); LAS f32x2* RT = (LAS f32x2*)(RI + NWAVES * 32);
    if (ROUTER && F.tid < 8) cntL[F.tid] = 0u;
    __syncthreads();
    int kslot = 0;
    auto load_main = [&](int row, f32x4 (&v)[8]) {
        const bool isc = row >= SEQ; const float* src = isc ? xc + (size_t)(row - SEQ) * DM : xl + (size_t)row * DM;
#pragma unroll
        for (int j = 0; j < 8; ++j) {
            if (!isc && xlb) { const u32x2 w = *(const u32x2*)(xlb + (size_t)row * DM + 4 * F.lane + 256 * j); v[j] = (f32x4){bflo(w.x), bfhi(w.x), bflo(w.y), bfhi(w.y)}; }
            else v[j] = *(const f32x4*)(src + 4 * F.lane + 256 * j); }
    };
    auto finish = [&](int row, f32x4 (&v)[8], bool live) {
        const bool isc = row >= SEQ;
        const LAS float* pa = PA + (isc ? DM : 0); const LAS float* pb = PB + (isc ? DM : 0);
        if (isc && ncparts > 0) {
            const float* cp = cparts + (size_t)(row - SEQ) * DM + 4 * F.lane; int s_ = 0;
            for (; s_ + 2 <= ncparts; s_ += 2) { f32x4 t0[8], t1[8];
#pragma unroll
                for (int j = 0; j < 8; ++j) { t0[j] = *(const f32x4*)(cp + (size_t)s_ * CTXL * DM + 256 * j); t1[j] = *(const f32x4*)(cp + (size_t)(s_ + 1) * CTXL * DM + 256 * j); }
#pragma unroll
                for (int j = 0; j < 8; ++j) { v[j] += t0[j]; v[j] += t1[j]; } }
            if (s_ < ncparts) { f32x4 t0[8];
#pragma unroll
                for (int j = 0; j < 8; ++j) t0[j] = *(const f32x4*)(cp + (size_t)s_ * CTXL * DM + 256 * j);
#pragma unroll
                for (int j = 0; j < 8; ++j) v[j] += t0[j]; }
            if (live) {
#pragma unroll
                for (int j = 0; j < 8; ++j) *(f32x4*)(xc_out + (size_t)(row - SEQ) * DM + 4 * F.lane + 256 * j) = v[j]; } }
        float ss = 0.f;
#pragma unroll
        for (int j = 0; j < 8; ++j) ss += (v[j].x * v[j].x + v[j].y * v[j].y) + (v[j].z * v[j].z + v[j].w * v[j].w);
        const float rstd = 1.0f / sqrtf(wave_sum(ss) * (1.0f / DM) + EPS);
        float lg[NE];
        if (ROUTER) {
#pragma unroll
            for (int e = 0; e < NE; ++e) lg[e] = 0.f; }
        bf16_t* orow = H + (size_t)row * DM;
#pragma unroll
        for (int j = 0; j < 8; ++j) { const int c0 = 4 * F.lane + 256 * j; const f32x4 a = *(const LAS f32x4*)(pa + c0), b = *(const LAS f32x4*)(pb + c0);
            const f32x4 h = v[j] * rstd * a + b;
            u32x2 o; o.x = pk2(h.x, h.y); o.y = pk2(h.z, h.w); if (live) *(u32x2*)(orow + c0) = o;
            if (ROUTER) {
#pragma unroll
                for (int e = 0; e < NE; ++e) { const f32x4 wv = *(const LAS f32x4*)(RW + e * DM + c0); lg[e] += (h.x * wv.x + h.y * wv.y) + (h.z * wv.z + h.w * wv.w); }
                asm volatile("" ::: "memory"); } }
        if (ROUTER) {
#pragma unroll
            for (int e = 0; e < NE; ++e) lg[e] = wave_sum(lg[e]);
            int i1 = 0; float v1 = lg[0];
#pragma unroll
            for (int e = 1; e < NE; ++e) if (lg[e] > v1) { v1 = lg[e]; i1 = e; }
            int i2 = -1; float v2 = -3.0e38f;
#pragma unroll
            for (int e = 0; e < NE; ++e) if (e != i1 && lg[e] > v2) { v2 = lg[e]; i2 = e; }
            const float w1 = 1.0f / (1.0f + __expf(v2 - v1)), w2 = 1.0f - w1;
            if (live && F.lane == 0) {
                if (kslot < 32) { const int r1 = (int)__hip_atomic_fetch_add(cntL + i1, 1u, __ATOMIC_RELAXED, __HIP_MEMORY_SCOPE_WORKGROUP), r2 = (int)__hip_atomic_fetch_add(cntL + i2, 1u, __ATOMIC_RELAXED, __HIP_MEMORY_SCOPE_WORKGROUP);
                    RI[F.wave * 32 + kslot] = (i32x4){i1, r1, i2, r2}; RT[F.wave * 32 + kslot] = (f32x2){w1, w2}; }
                else { const int s1 = (int)__hip_atomic_fetch_add(F.ctl + CW_CNT + 64 * i1, 1u, RLX_AGENT), s2 = (int)__hip_atomic_fetch_add(F.ctl + CW_CNT + 64 * i2, 1u, RLX_AGENT);
                    route[row] = (i32x4){i1, s1, i2, s2}; rwt[row] = (f32x2){w1, w2}; } }
        }
    };
    const int nlat = nrows < SEQ ? nrows : SEQ;
    if constexpr (!ROUTER) {
        for (int row = F.gw; row < nlat; row += 2 * F.NGW) { const int row1 = row + F.NGW; const bool has1 = row1 < nlat; const int r1 = has1 ? row1 : row;
            f32x4 va[8], vb[8];
            load_main(row, va); load_main(r1, vb);
            finish(row, va, true); finish(r1, vb, has1);
        }
    } else {
        for (int row = F.gw; row < nlat; row += F.NGW) { f32x4 va[8]; load_main(row, va); finish(row, va, true); ++kslot; }
        __syncthreads();
        if (F.tid < 8) baseL[F.tid] = __hip_atomic_fetch_add(F.ctl + CW_CNT + 64 * F.tid, cntL[F.tid], RLX_AGENT);
        __syncthreads();
        { const int nk = kslot < 32 ? kslot : 32;
          if (F.lane < nk) { const i32x4 ri = RI[F.wave * 32 + F.lane]; const int row = F.gw + F.lane * F.NGW;
              route[row] = (i32x4){ri.x, (int)baseL[ri.x] + ri.y, ri.z, (int)baseL[ri.z] + ri.w}; rwt[row] = RT[F.wave * 32 + F.lane]; } }
    }
    if (F.wave == 0) for (int row = SEQ + F.vcu; row < nrows; row += F.G) { f32x4 va[8]; load_main(row, va); finish(row, va, true); }
    __syncthreads();
}

__device__ __forceinline__ void qknorm_rope_phase(const Frame& F0, bf16_t* Q, bf16_t* Kb, const float* qg, const float* kg, int nrows, bool ctx_q) {
    Frame F = opaque(F0);
    const float* rope = (const float*)(F.ws + WS_TAB + TAB_ROPE);
    const int L = F.lane, axis = L >> 5, half = (L & 31) >> 4, j0 = 2 * (L & 15);
    constexpr float QC = 0.088388347648318440f * 1.4426950408889634f;
    const f32x2 gq = *(const f32x2*)(qg + 2 * L) * QC, gk = *(const f32x2*)(kg + 2 * L);
    for (int row = F.gw; row < nrows; row += F.NGW) {
        const bool isc = row >= SEQ;
        f32x2 cs = {1.f, 1.f}, sn = {0.f, 0.f};
        if (!isc) { const int p = axis ? (row & 63) : (row >> 6); const float* cb = rope + (axis ? 16384 : 0) + p * 32 + j0; const float* sb = cb + (axis ? 2048 : 8192);
            cs = *(const f32x2*)cb; sn = *(const f32x2*)sb; if (half == 0) { sn.x = -sn.x; sn.y = -sn.y; } }
        const int nq = 0;
        unsigned* qrow = (unsigned*)(Q + (size_t)row * QW) + L; unsigned* krow = (unsigned*)(Kb + (size_t)row * KVW) + L;
        unsigned w[NH + NKV];
#pragma unroll
        for (int h = 0; h < NH + NKV; ++h) { const unsigned* p = h < NH ? qrow + h * 64 : krow + (h - NH) * 64; w[h] = (h < NH && h >= nq) ? 0u : *p; }
#pragma unroll
        for (int h = 0; h < NH + NKV; ++h) { if (h < NH && h >= nq) continue;
            unsigned* p = h < NH ? qrow + h * 64 : krow + (h - NH) * 64; const f32x2 g = h < NH ? gq : gk;
            float x0 = bflo(w[h]), x1 = bfhi(w[h]);
            const float rs = 1.0f / sqrtf(wave_sum(x0 * x0 + x1 * x1) * (1.0f / HD) + EPS);
            x0 = x0 * rs * g.x; x1 = x1 * rs * g.y;
            const float y0 = xor16f(x0), y1 = xor16f(x1);
            *p = pk2(x0 * cs.x + y0 * sn.x, x1 * cs.y + y1 * sn.y); }
    }
}

__device__ __forceinline__ void moe_cum(Frame& F, int (&cum)[9], int (&rbase)[8]) {
    const int ln = tid_of(F.wave) & 63;
    unsigned cv = 0u; if (ln < NE) cv = __hip_atomic_load(F.ctl + CW_CNT + 64 * ln, RLX_AGENT);
    int t = 0;
#pragma unroll
    for (int e = 0; e < NE; ++e) { const unsigned c = (unsigned)__builtin_amdgcn_readlane((int)cv, e); cum[e] = t; rbase[e] = t * 256; t += (int)((c + 255u) >> 8); }
    cum[8] = t;
}
__device__ __forceinline__ void moe_gather_phase(const Frame& F0, const bf16_t* H, bf16_t* HG, const i32x4* route, i32x2* pairpos) {
    Frame F = opaque(F0);
    int cum[9], rbase[8]; moe_cum(F, cum, rbase);
    LAS int* RB = (LAS int*)F.lds;
    if (F.tid == 0) {
#pragma unroll
        for (int e = 0; e < NE; ++e) RB[e] = rbase[e]; }
    __syncthreads();
    for (int t = F.gw; t < SEQ; t += 2 * F.NGW) { const int t1 = t + F.NGW; const bool has1 = t1 < SEQ; const int tb = has1 ? t1 : t;
        const i32x4 ra = route[t], rb = route[tb]; const int pa1 = RB[ra.x] + ra.y, pa2 = RB[ra.z] + ra.w, pb1 = RB[rb.x] + rb.y, pb2 = RB[rb.z] + rb.w;
        const u32x4* sa = (const u32x4*)(H + (size_t)t * DM) + F.lane; const u32x4* sb = (const u32x4*)(H + (size_t)tb * DM) + F.lane;
        u32x4 va[4], vb[4];
#pragma unroll
        for (int j = 0; j < 4; ++j) { va[j] = sa[64 * j]; vb[j] = sb[64 * j]; }
        u32x4* da1 = (u32x4*)(HG + (size_t)pa1 * DM) + F.lane; u32x4* da2 = (u32x4*)(HG + (size_t)pa2 * DM) + F.lane;
        u32x4* db1 = (u32x4*)(HG + (size_t)pb1 * DM) + F.lane; u32x4* db2 = (u32x4*)(HG + (size_t)pb2 * DM) + F.lane;
#pragma unroll
        for (int j = 0; j < 4; ++j) { da1[64 * j] = va[j]; da2[64 * j] = va[j]; if (has1) { db1[64 * j] = vb[j]; db2[64 * j] = vb[j]; } }
        if (F.lane == 0) { pairpos[t] = (i32x2){pa1, pa2}; if (has1) pairpos[t1] = (i32x2){pb1, pb2}; } }
    __syncthreads();
}

__device__ __forceinline__ void final_phase(const Frame& F0, float* out, const bf16_t* XBp, const bf16_t* OP, const i32x2* pairpos, const f32x2* rwt, const float* ga2, const float* fg, bool poison) {
    Frame F = opaque(F0);
    for (int row = F.gw; row < SEQ; row += 2 * F.NGW) { const int row1 = row + F.NGW; const bool has1 = row1 < SEQ; const int r1 = has1 ? row1 : row;
        const i32x2 ppa = pairpos[row], ppb = pairpos[r1]; const f32x2 wa = rwt[row], wb = rwt[r1];
        u32x2 xa[8], xb[8], a1[8], a2[8], b1[8], b2[8];
#pragma unroll
        for (int j = 0; j < 8; ++j) { const int c0 = 4 * F.lane + 256 * j;
            xa[j] = *(const u32x2*)(XBp + (size_t)row * DM + c0); a1[j] = *(const u32x2*)(OP + (size_t)ppa.x * DM + c0); a2[j] = *(const u32x2*)(OP + (size_t)ppa.y * DM + c0);
            xb[j] = *(const u32x2*)(XBp + (size_t)r1 * DM + c0); b1[j] = *(const u32x2*)(OP + (size_t)ppb.x * DM + c0); b2[j] = *(const u32x2*)(OP + (size_t)ppb.y * DM + c0); }
        f32x4 va[8], vb[8]; float sa = 0.f, sb = 0.f;
#pragma unroll
        for (int j = 0; j < 8; ++j) { const int c0 = 4 * F.lane + 256 * j; const f32x4 g = *(const f32x4*)(ga2 + c0);
            { const f32x4 x = (f32x4){bflo(xa[j].x), bfhi(xa[j].x), bflo(xa[j].y), bfhi(xa[j].y)};
              const f32x4 m = (f32x4){bflo(a1[j].x), bfhi(a1[j].x), bflo(a1[j].y), bfhi(a1[j].y)} * wa.x + (f32x4){bflo(a2[j].x), bfhi(a2[j].x), bflo(a2[j].y), bfhi(a2[j].y)} * wa.y;
              va[j] = x + g * m; sa += (va[j].x * va[j].x + va[j].y * va[j].y) + (va[j].z * va[j].z + va[j].w * va[j].w); }
            { const f32x4 x = (f32x4){bflo(xb[j].x), bfhi(xb[j].x), bflo(xb[j].y), bfhi(xb[j].y)};
              const f32x4 m = (f32x4){bflo(b1[j].x), bfhi(b1[j].x), bflo(b1[j].y), bfhi(b1[j].y)} * wb.x + (f32x4){bflo(b2[j].x), bfhi(b2[j].x), bflo(b2[j].y), bfhi(b2[j].y)} * wb.y;
              vb[j] = x + g * m; sb += (vb[j].x * vb[j].x + vb[j].y * vb[j].y) + (vb[j].z * vb[j].z + vb[j].w * vb[j].w); } }
        const float ra = 1.0f / sqrtf(wave_sum(sa) * (1.0f / DM) + EPS), rb = 1.0f / sqrtf(wave_sum(sb) * (1.0f / DM) + EPS);
        float* xr = out + (size_t)row * DM; float* xr1 = out + (size_t)r1 * DM;
#pragma unroll
        for (int j = 0; j < 8; ++j) { const int c0 = 4 * F.lane + 256 * j; const f32x4 fgv = *(const f32x4*)(fg + c0); f32x4 oa = va[j] * ra * fgv, ob = vb[j] * rb * fgv;
            if (poison) { const float q = __builtin_nanf(""); oa = (f32x4){q, q, q, q}; ob = oa; }
            *(f32x4*)(xr + c0) = oa; if (has1) *(f32x4*)(xr1 + c0) = ob; } }
}

constexpr int PH_P0 = 0, PH_P0B = 1, PH_L0 = 2, PH_PER_LAYER = 12, PH_END = PH_L0 + 2 * PH_PER_LAYER;

__global__ void __launch_bounds__(NWAVES * 64, 2) mk_fwd(Args args) {
    extern __shared__ __attribute__((aligned(16))) unsigned char lds[];
    Frame F;
    F.lds = (LAS unsigned char*)lds; F.ldsg = lds;
    volatile LAS unsigned* MISC = (volatile LAS unsigned*)(F.lds + MISC_OFF);
    F.tid = threadIdx.x; F.lane = F.tid & 63; F.wave = __builtin_amdgcn_readfirstlane(F.tid >> 6);
    F.G = gridDim.x; { const int bx = blockIdx.x; F.vcu = (F.G % 8 == 0) ? (bx % 8) * (F.G / 8) + bx / 8 : bx; }
    F.gw = F.vcu * NWAVES + F.wave; F.NGW = F.G * NWAVES;
    F.ws = args.ws; F.ctl = (gu32*)(args.ws + WS_CTL);
    for (int u = F.tid; u < (LDS_BYTES - LDSCTL_OFF) / 4; u += NWAVES * 64) ((LAS unsigned*)(F.lds + LDSCTL_OFF))[u] = 0u;
    __syncthreads();
    const int lo = args.ph_lo, hi = args.ph_hi;
    XcdBarrier bar; bar.bar = (unsigned*)(F.ctl + CW_BAR); bar.x = 0; bar.st = nullptr; bar.wave = 0;
    if (!MK_SPLIT) bar = xcd_barrier_post((unsigned*)(F.ctl + CW_BAR), MISC + 8);
    bar.wave = F.wave;
#ifndef PH_MASK
#define PH_MASK 0xFFFFFFFFu
#endif
#define PHT(k) ((k) < PH_L0 ? (k) : 2 + ((k) - PH_L0) % PH_PER_LAYER)
#define IN(k) (((PH_MASK >> PHT(k)) & 1u) && lo <= (k) && (k) < hi)
#ifdef PROF_MASK
    unsigned long long tacc = 0, tph = __builtin_amdgcn_s_memrealtime();
#define SEAM(k) do { if (!MK_SPLIT) xcd_barrier(bar); { const unsigned long long t_ = __builtin_amdgcn_s_memrealtime(); if ((PROF_MASK >> (k)) & 1ull) tacc += t_ - tph; tph = t_; } } while (0)
#else
#define SEAM(k) do { if (!MK_SPLIT) xcd_barrier(bar); } while (0)
#endif
    unsigned char* ws = args.ws;
    bf16_t* Hb = (bf16_t*)(ws + WS_H); bf16_t* Qb = (bf16_t*)(ws + WS_Q); bf16_t* Kb = (bf16_t*)(ws + WS_K); bf16_t* Vb = (bf16_t*)(ws + WS_V);
    bf16_t* Fb = (bf16_t*)(ws + WS_F); bf16_t* Gb = (bf16_t*)(ws + WS_G); bf16_t* ZA = (bf16_t*)(ws + WS_ZA); bf16_t* YB = (bf16_t*)(ws + WS_YB);
    bf16_t* FOUR = (bf16_t*)(ws + WS_FOUR); bf16_t* ZC = (bf16_t*)(ws + WS_ZC); float* XC = (float*)(ws + WS_XC); bf16_t* XB = (bf16_t*)(ws + WS_XB);
    bf16_t* Ub = (bf16_t*)(ws + WS_U); bf16_t* HG = (bf16_t*)(ws + WS_HG); bf16_t* UG = (bf16_t*)(ws + WS_UG);
    i32x4* route = (i32x4*)(ws + WS_ROUTE); f32x2* rwt = (f32x2*)(ws + WS_ROUTE + 256 * 1024); i32x2* pairpos = (i32x2*)(ws + WS_ROUTE + 512 * 1024);
    const bf16_t* DC = (const bf16_t*)(ws + WS_TAB + TAB_DC); const bf16_t* DN = (const bf16_t*)(ws + WS_TAB + TAB_DN); const bf16_t* D256 = (const bf16_t*)(ws + WS_TAB + TAB_D256);
    const float* MOD = (const float*)(ws + WS_MOD); float* PARTC = (float*)(ws + WS_PARTC);
    const int bx = (int)blockIdx.x;

    if (IN(PH_P0)) { p0_prologue(F, args); __syncthreads(); SEAM(PH_P0); }
    if (IN(PH_P0B)) { p0b_mod(F, args); SEAM(PH_P0B); }

#pragma unroll 1
    for (int l = 0; l < 2; ++l) {
        const int pb = PH_L0 + l * PH_PER_LAYER; const bool last = (l == 1);
        const float* modL = MOD + (size_t)(l * 2 + 0) * 12288; const float* modC = MOD + (size_t)(l * 2 + 1) * 12288;
        const float* xlat = args.in[0]; const float* xctx = (l == 0) ? args.in[2] : XC;
        if (IN(pb + 0)) {
            norm_phase<false>(F, xlat, xctx, MR, args.in[6] + l * DM, modL, modC, 0, Hb, nullptr, nullptr, nullptr, PARTC, l == 0 ? 0 : 11, XC, l == 0 ? nullptr : XB); SEAM(pb + 0); }
        if (IN(pb + 1)) {
            pg8::Gemm g = pg8::mk_gemm(Hb, DM, (const bf16_t*)(ws + WS_WIN) + (size_t)l * INC * DM, DM, DM);
            pg8::TileOrder S; S.init(last ? 64 : 65, 32, F.G, bx, (long)256 * DM * 2, (long)256 * DM * 2);
            if (last) { S.xpm = 64; S.xlo = 8; S.xn = 4; }
            { const bf16_t* Wl = (const bf16_t*)(ws + WS_WIN) + (size_t)l * INC * DM;
              S.sn = 2 * 65; S.sdiv = 65; S.sA0 = (long)((const char*)Wl - (const char*)Hb) + (long)(QW + KVW) * DM * 2; S.sB0 = (long)((const char*)Hb - (const char*)Wl); }
            pg8::EpiInProj E{Qb, Kb, Vb, Fb, Gb, args.in[9] + l * GW2, (bf16_t*)(ws + WS_VT)};
            pg8::gemm_phase(F.lds, g, S, E, F.wave);
            SEAM(pb + 1);
        }
        if (IN(pb + 2)) {
#ifndef NO_QKN
            qknorm_rope_phase(F, Qb, Kb, args.in[10] + l * HD, args.in[11] + l * HD, MR, !last);
#endif
#ifndef NO_F1
            { pg8::Gemm g = pg8::mk_gemm(DC, 256, Fb, FD, 256); g.rmulB = 128; g.hstepB = (long)FD * 2;
              pg8::F1Order S{F.G, bx}; pg8::EpiF1 E{ZA}; pg8::gemm_phase(F.lds, g, S, E, F.wave); }
#endif
#ifndef NO_F1C
            if (!last) { pg8::Gemm g = pg8::mk_gemm(DC, 256, Fb, FD, 256);
              pg8::F1cOrder S{F.G, bx}; pg8::EpiF1c E{ZC}; pg8::gemm_phase(F.lds, g, S, E, F.wave); }
#endif
            SEAM(pb + 2);
        }
        if (IN(pb + 3)) {
            pg8::Gemm g = pg8::mk_gemm(DN, 256, ZA, 256, 256);
            pg8::LinOrder S{F.G, bx, 512, (long)256 * 256 * 2}; pg8::EpiF2 E{YB}; pg8::gemm_phase(F.lds, g, S, E, F.wave);
            SEAM(pb + 3);
        }
        if (IN(pb + 4)) {
#ifndef NO_F3
            { pg8::Gemm g = pg8::mk_gemm(DN, 256, YB, 256, 256);
              pg8::LinOrder S{F.G, bx, 512, (long)256 * 256 * 2}; pg8::EpiF3 E{FOUR}; pg8::gemm_phase(F.lds, g, S, E, F.wave); }
#endif
#ifndef NO_F3C
            if (!last) { pg8::Gemm g = pg8::mk_gemm(D256, 512, ZC, 512, 512);
              pg8::LinOrder S{F.G, bx, 4, (long)256 * 512 * 2}; pg8::EpiF3c E{FOUR}; pg8::gemm_phase(F.lds, g, S, E, F.wave); }
#endif
            __syncthreads();
#ifndef NO_ATTN
            const int nctx = last ? 0 : NH;
            float gqm = 0.f, gkm = 0.f;
            { const float* gq = args.in[10] + l * HD; const float* gk = args.in[11] + l * HD;
              const int ln = tid_of(F.wave) & 63;
              gqm = fmaxf(fabsf(gq[ln]), fabsf(gq[ln + 64])); gkm = fmaxf(fabsf(gk[ln]), fabsf(gk[ln + 64]));
              gqm = wave_max(gqm); gkm = wave_max(gkm); }
            const float bnd = (11.313708499f * gqm * gkm * 1.03f + 0.25f) * 1.4426950408889634f;
            const bool fastsm = __builtin_amdgcn_readfirstlane(bnd <= 43.0f ? 1 : 0) != 0;
            const float negBC = 0.f;
            for (int i = 0;; ++i) {
                int qh, qb, isc;
                if (F.G == 256) { const int xcd = F.vcu >> 5, c = F.vcu & 31;
                    if (i < 4) { qh = (xcd >> 1) * 4 + (xcd & 1) * 2 + (i >> 1); qb = (i & 1) * 32 + c; isc = 0; }
                    else if (i == 4 && F.vcu < nctx) { qh = F.vcu; qb = 0; isc = 1; }
                    else break; }
                else { const int Lu = i * F.G + bx; if (Lu < 1024) { qh = Lu >> 6; qb = Lu & 63; isc = 0; } else if (Lu < 1024 + nctx) { qh = Lu - 1024; qb = 0; isc = 1; } else break; }
                const size_t row0 = isc ? (size_t)SEQ : (size_t)qb * 256;
                const at::bf16* Qp = (const at::bf16*)(Qb + row0 * QW + qh * HD);
                const size_t kro = isc ? (size_t)SEQ * KVW : 0;
                const at::bf16* Kp = (const at::bf16*)(Kb + kro + (qh >> 2) * HD); const at::bf16* Vp = (const at::bf16*)(Vb + kro + (qh >> 2) * HD);
#ifdef ATT_V3
                if (fastsm) at::attn_body_v4(Qp, Kp, (const at::bf16*)((const bf16_t*)(ws + WS_VT) + (size_t)(qh >> 2) * HD * MR + (isc ? SEQ : 0)), (at::bf16*)(Qb + row0 * QW + qh * HD), isc ? CTXL : MR, (char*)lds, F.wave, args.in[10] + l * HD, (const float*)(ws + WS_TAB + TAB_ROPE), isc ? -1 : qb * 256);
#else
                if (fastsm) at::ATT_FAST(Qp, Kp, Vp, (at::bf16*)(Qb + row0 * QW + qh * HD), isc ? CTXL : MR, ATT_FAST_ARGS negBC, F.wave);
#endif
#ifndef NO_SLOWATT
                else at::attn_dense_body(Qp, Kp, Vp, (at::bf16*)(Qb + row0 * QW + qh * HD), isc ? CTXL : MR, (char*)lds, F.wave, args.in[10] + l * HD, (const float*)(ws + WS_TAB + TAB_ROPE), isc ? -1 : qb * 256);
#endif
            }
#endif
            SEAM(pb + 4);
        }
        if (IN(pb + 5)) {
            const int nM = last ? 64 : 65;
            { pg8::Gemm g = pg8::mk_gemm(Qb, QW, (const bf16_t*)(ws + WS_WAP) + (size_t)l * DM * QW, QW, QW);
              pg8::TileOrder S; S.init(nM, 8, F.G, bx, (long)256 * QW * 2, (long)256 * QW * 2); pg8::EpiMerge<0> E{Hb, Gb}; pg8::gemm_phase(F.lds, g, S, E, F.wave); }
            { pg8::Gemm g = pg8::mk_gemm(FOUR, FD, (const bf16_t*)(ws + WS_WFP) + (size_t)l * DM * FD, FD, FD);
              pg8::TileOrder S; S.init(nM, 8, F.G, bx, (long)256 * FD * 2, (long)256 * FD * 2); pg8::EpiMerge<1> E{Hb, Gb}; pg8::gemm_phase(F.lds, g, S, E, F.wave); }
            SEAM(pb + 5);
        }
        if (IN(pb + 6)) {
            pg8::Gemm g = pg8::mk_gemm(Hb, DM, (const bf16_t*)(ws + WS_WOUT) + (size_t)l * DM * DM, DM, DM);
            pg8::TileOrder S; S.init(64, 8, F.G, bx, (long)256 * DM * 2, (long)256 * DM * 2);
            pg8::EpiRes E{xlat, l == 0 ? nullptr : XB, XB, modL + 2 * DM, xctx, XC, modC + 2 * DM};
            pg8::gemm_phase(F.lds, g, S, E, F.wave);
            if (!last) {
                pg8::Gemm g2 = g; g2.K = 256;
                pg8::SplitKOrder S2{F.G, bx, 8, 8, 64, (long)SEQ * DM * 2, (long)256 * DM * 2, (long)256 * 2};
                pg8::EpiPartial E2{PARTC, modC + 2 * DM}; pg8::gemm_phase(F.lds, g2, S2, E2, F.wave); }
            SEAM(pb + 6);
        }
        if (IN(pb + 7)) {
            if (!last) norm_phase<false>(F, xlat, xctx, MR, args.in[7] + l * DM, modL, modC, 3, Hb, nullptr, nullptr, nullptr, PARTC, 8, XC, XB);
            else norm_phase<true>(F, xlat, XC, SEQ, args.in[7] + l * DM, modL, modC, 3, Hb, args.in[18], route, rwt, nullptr, 0, nullptr, XB);
            SEAM(pb + 7);
        }
        if (!last) {
            if (IN(pb + 8)) {
                pg8::Gemm g = pg8::mk_gemm(Hb, DM, (const bf16_t*)(ws + WS_WGU), DM, DM);
                pg8::TileOrder S; S.init(65, 44, F.G, bx, (long)256 * DM * 2, (long)256 * DM * 2);
                pg8::EpiSwiglu E{Ub, DFF}; pg8::gemm_phase(F.lds, g, S, E, F.wave);
                SEAM(pb + 8);
            }
            if (IN(pb + 9)) {
                pg8::Gemm g = pg8::mk_gemm(Ub, DFF, (const bf16_t*)(ws + WS_WD), DFF, DFF);
                pg8::TileOrder S; S.init(64, 8, F.G, bx, (long)256 * DFF * 2, (long)256 * DFF * 2);
                pg8::EpiRes E{nullptr, XB, XB, modL + 5 * DM, XC, XC, modC + 5 * DM};
                pg8::gemm_phase(F.lds, g, S, E, F.wave);
                { pg8::Gemm g2 = g; g2.K = 512;
                  pg8::SplitKOrder S2{F.G, bx, 8, 11, 64, (long)SEQ * DFF * 2, (long)256 * DFF * 2, (long)512 * 2};
                  pg8::EpiPartial E2{PARTC, modC + 5 * DM}; pg8::gemm_phase(F.lds, g2, S2, E2, F.wave); }
                SEAM(pb + 9);
            }
        } else {
            if (IN(pb + 8)) { moe_gather_phase(F, Hb, HG, route, pairpos); SEAM(pb + 8); }
            if (IN(pb + 9)) {
                int rbase[8]; pg8::MoeOrder S; S.G = F.G; S.c = bx; S.nN = 22; moe_cum(F, S.cum, rbase); S.tA = (long)256 * DM * 2; S.tB = (long)256 * DM * 2; S.eB = (long)2 * DFE * DM * 2;
                pg8::Gemm g = pg8::mk_gemm(HG, DM, (const bf16_t*)(ws + WS_MGU), DM, DM);
                pg8::EpiSwiglu E{UG, DFE}; pg8::gemm_phase(F.lds, g, S, E, F.wave);
                SEAM(pb + 9);
            }
            if (IN(pb + 10)) {
                int rbase[8]; pg8::MoeOrder S; S.G = F.G; S.c = bx; S.nN = 8; moe_cum(F, S.cum, rbase); S.tA = (long)256 * DFE * 2; S.tB = (long)256 * DFE * 2; S.eB = (long)DM * DFE * 2;
                pg8::Gemm g = pg8::mk_gemm(UG, DFE, (const bf16_t*)(ws + WS_MD), DFE, DFE);
                pg8::EpiPlain E{HG, DM}; pg8::gemm_phase(F.lds, g, S, E, F.wave);
                SEAM(pb + 10);
            }
            if (IN(pb + 11)) {
                bool poison = false;
                if (!MK_SPLIT) poison = __hip_atomic_load((gu32*)((unsigned*)(F.ctl + CW_BAR) + XB_TMO), RLX_AGENT) != 0u;
                final_phase(F, args.out, XB, HG, pairpos, rwt, modL + 5 * DM, args.in[22], poison);
#ifdef PROF_MASK
                { const unsigned long long t_ = __builtin_amdgcn_s_memrealtime(); if ((PROF_MASK >> (pb + 11)) & 1ull) tacc += t_ - tph; tph = t_;
                  if (blockIdx.x == 0) { while (__builtin_amdgcn_s_memrealtime() - tph < PROF_MULT * tacc) __builtin_amdgcn_s_sleep(8); } }
#endif
            }
        }
    }
#undef IN
#undef SEAM
}

extern "C" void kernel_launch(void* const* d_in, const int* in_sizes, int n_in, void* d_out, int out_size, void* d_ws, size_t ws_size, hipStream_t stream) {
    static int grid = 0;
    if (grid == 0) {
        if (n_in != 23 || out_size != SEQ * DM || ws_size < WS_END) { fprintf(stderr, "kernel_launch: unexpected shapes (n_in %d out %d ws %zu)\n", n_in, out_size, ws_size); grid = -1; return; }
        int dev = 0, cus = 0, per_cu = 0;
        if (hipGetDevice(&dev) != hipSuccess || hipDeviceGetAttribute(&cus, hipDeviceAttributeMultiprocessorCount, dev) != hipSuccess) { grid = -1; return; }
        if (hipFuncSetAttribute((const void*)mk_fwd, hipFuncAttributeMaxDynamicSharedMemorySize, LDS_BYTES) != hipSuccess) { grid = -1; return; }
        if (hipOccupancyMaxActiveBlocksPerMultiprocessor(&per_cu, (const void*)mk_fwd, NWAVES * 64, LDS_BYTES) != hipSuccess || per_cu < 1) fprintf(stderr, "kernel_launch: occupancy query says %d\n", per_cu);
        (void)hipGetLastError();
        grid = cus;
    }
    if (grid < 0) return;
    (void)hipMemsetAsync((char*)d_ws + WS_CTL, 0, CTL_ZERO_BYTES, stream);
    Args a{};
    for (int i = 0; i < 23; ++i) a.in[i] = (const float*)d_in[i];
    a.out = (float*)d_out; a.ws = (unsigned char*)d_ws;
#if MK_SPLIT
    for (int p = 0; p < PH_END; ++p) { a.ph_lo = p; a.ph_hi = p + 1; hipLaunchKernelGGL(mk_fwd, dim3(grid), dim3(NWAVES * 64), LDS_BYTES, stream, a); }
#else
    a.ph_lo = 0; a.ph_hi = PH_END;
    hipLaunchKernelGGL(mk_fwd, dim3(grid), dim3(NWAVES * 64), LDS_BYTES, stream, a);
#endif
}
```

```cpp
#include <hip/hip_runtime.h>
#include <hip/hip_bf16.h>
#include <cstdio>
#include <cstdint>

#define GAS __attribute__((address_space(1)))
#define LAS __attribute__((address_space(3)))
typedef unsigned short bf16_t;
typedef short bf16x8 __attribute__((ext_vector_type(8)));
typedef short s16x4 __attribute__((ext_vector_type(4)));
typedef float f32x4 __attribute__((ext_vector_type(4)));
typedef float f32x2 __attribute__((ext_vector_type(2)));
typedef float f32x16 __attribute__((ext_vector_type(16)));
typedef unsigned u32x4 __attribute__((ext_vector_type(4)));
typedef unsigned u32x2 __attribute__((ext_vector_type(2)));
typedef int i32x4 __attribute__((ext_vector_type(4)));
typedef int i32x2 __attribute__((ext_vector_type(2)));
typedef GAS unsigned gu32;
#define RLX_AGENT __ATOMIC_RELAXED, __HIP_MEMORY_SCOPE_AGENT
#define LDS_WAIT() asm volatile("s_waitcnt lgkmcnt(0)" ::: "memory")
#define VM_WAIT() asm volatile("s_waitcnt vmcnt(0)" ::: "memory")

#ifndef MK_SPLIT
#define MK_SPLIT 0
#endif

constexpr int DM = 2048, SEQ = 16384, CTXL = 256, MR = SEQ + CTXL, NH = 16, NKV = 4, HD = 128;
constexpr int QW = 2048, KVW = 512, FD = 1024, GW2 = 4096, INC = 8192, DFF = 5632, NE = 8, DFE = 2816;
constexpr int PAIR_ROWS = 34816;
constexpr float EPS = 1e-6f;
constexpr int NWAVES = 8;

constexpr size_t MiB = 1u << 20;
constexpr size_t WS_CTL = 0, CTL_ZERO_BYTES = 1 * MiB;
constexpr size_t WS_WIN = 1 * MiB;
constexpr size_t WS_WAP = 65 * MiB;
constexpr size_t WS_WFP = 81 * MiB;
constexpr size_t WS_WOUT = 89 * MiB;
constexpr size_t WS_WGU = 105 * MiB;
constexpr size_t WS_WD = 149 * MiB;
constexpr size_t WS_MGU = 171 * MiB;
constexpr size_t WS_MD = 347 * MiB;
constexpr size_t WS_TAB = 435 * MiB;
constexpr size_t WS_PART = 436 * MiB;
constexpr size_t WS_MOD = 439 * MiB;
constexpr size_t WS_H = 440 * MiB;
constexpr size_t WS_Q = 505 * MiB;
constexpr size_t WS_K = 570 * MiB;
constexpr size_t WS_V = 587 * MiB;
constexpr size_t WS_F = 604 * MiB;
constexpr size_t WS_G = 637 * MiB;
constexpr size_t WS_ZA = 767 * MiB;
constexpr size_t WS_YB = 831 * MiB;
constexpr size_t WS_FOUR = 895 * MiB;
constexpr size_t WS_ZC = 928 * MiB;
constexpr size_t WS_XC = 929 * MiB;
constexpr size_t WS_ROUTE = 931 * MiB;
constexpr size_t WS_U = 505 * MiB;
constexpr size_t WS_HG = 505 * MiB;
constexpr size_t WS_UG = 641 * MiB;
constexpr size_t WS_PARTC = 932 * MiB;
constexpr size_t WS_VT = 956 * MiB;
constexpr size_t WS_XB = 974 * MiB;
constexpr size_t WS_END = 1038 * MiB;
static_assert(WS_UG + (size_t)PAIR_ROWS * DFE * 2 <= WS_ROUTE, "ws map");
static_assert(WS_U + (size_t)MR * DFF * 2 <= WS_ZA, "ws map");
constexpr size_t TAB_DC = 0;
constexpr size_t TAB_DN = 256 * 1024;
constexpr size_t TAB_D256 = 384 * 1024;
constexpr size_t TAB_ROPE = 640 * 1024;
constexpr int CW_TMO = 0, CW_CODE = 1, CW_DBG = 2, CW_CNT = 1024  , CW_BAR = 4096;

constexpr int RING_BYTES = 131072, LDSCTL_OFF = RING_BYTES, MISC_OFF = LDSCTL_OFF + 320;
constexpr int LDS_BYTES = 147456;

__device__ __forceinline__ int tid_of(int wave) { int l; asm volatile("v_mbcnt_lo_u32_b32 %0, -1, 0\n\tv_mbcnt_hi_u32_b32 %0, -1, %0" : "=v"(l)); return wave * 64 + l; }
__device__ __forceinline__ unsigned f2bf(float f) { unsigned u = __builtin_bit_cast(unsigned, f); return (u + 0x7fffu + ((u >> 16) & 1u)) >> 16; }
__device__ __forceinline__ unsigned pk2(float lo, float hi) { return f2bf(lo) | (f2bf(hi) << 16); }
__device__ __forceinline__ float bflo(unsigned w) { return __builtin_bit_cast(float, w << 16); }
__device__ __forceinline__ float bfhi(unsigned w) { return __builtin_bit_cast(float, w & 0xffff0000u); }
__device__ __forceinline__ unsigned cvt_pk_bf16(float lo, float hi) { unsigned r; asm volatile("v_cvt_pk_bf16_f32 %0, %1, %2" : "=v"(r) : "v"(lo), "v"(hi)); return r; }
template <int CTRL> __device__ __forceinline__ float dppf(float v) { return __builtin_bit_cast(float, __builtin_amdgcn_update_dpp(0, __builtin_bit_cast(int, v), CTRL, 0xF, 0xF, true)); }
__device__ __forceinline__ float xor16f(float v) { return __builtin_bit_cast(float, __builtin_amdgcn_ds_swizzle(__builtin_bit_cast(int, v), 0x401F)); }
__device__ __forceinline__ float wave_sum(float v) {
    v += dppf<0xB1>(v); v += dppf<0x4E>(v); v += dppf<0x141>(v); v += dppf<0x140>(v);
    v += xor16f(v);
    { auto rr = __builtin_amdgcn_permlane32_swap(__float_as_uint(v), __float_as_uint(v), false, false); v = __uint_as_float(rr[0]) + __uint_as_float(rr[1]); }
    return v;
}
__device__ __forceinline__ float wave_max(float v) {
    v = fmaxf(v, dppf<0xB1>(v)); v = fmaxf(v, dppf<0x4E>(v)); v = fmaxf(v, dppf<0x141>(v)); v = fmaxf(v, dppf<0x140>(v));
    v = fmaxf(v, xor16f(v));
    { auto rr = __builtin_amdgcn_permlane32_swap(__float_as_uint(v), __float_as_uint(v), false, false); v = fmaxf(__uint_as_float(rr[0]), __uint_as_float(rr[1])); }
    return v;
}
__device__ __forceinline__ float sigmoidf_(float x) { return __builtin_amdgcn_rcpf(1.0f + __builtin_amdgcn_exp2f(-1.4426950408889634f * x)); }

#define XB_TMO      128
#define XB_XCNT(j)  (256  + 64 * (j))
#define XB_XSUB(j)  (1280 + 64 * (j))
#define XB_XGEN(j)  (2304 + 64 * (j))
#define XB_TOP      3328
#define XB_TOPGEN   3392
#define XCD_BAR_WORDS 3456
#define XB_SPIN_CAP (1u << 18)
__device__ __forceinline__ unsigned xb_ld(unsigned* p)              { return __hip_atomic_load(p, __ATOMIC_RELAXED, __HIP_MEMORY_SCOPE_AGENT); }
__device__ __forceinline__ unsigned xb_add(unsigned* p, unsigned v) { return __hip_atomic_fetch_add(p, v, __ATOMIC_RELAXED, __HIP_MEMORY_SCOPE_AGENT); }
__device__ __forceinline__ unsigned xb_xcc_id() { return (unsigned)__builtin_amdgcn_s_getreg((3 << 11) | 20) & 0xFu; }
#define XB_SPIN(cond, bar) do { unsigned _sp = 0; while (cond) { __builtin_amdgcn_s_sleep(1); \
    if ((++_sp & 255u) == 0u) { if (xb_ld(&(bar)[XB_TMO])) break; if (_sp > XB_SPIN_CAP) { atomicAdd(&(bar)[XB_TMO], 1u); break; } } } } while (0)
struct XcdBarrier { unsigned* bar; unsigned x; volatile LAS unsigned* st; int wave; };
__device__ __forceinline__ XcdBarrier xcd_barrier_post(unsigned* bar, volatile LAS unsigned* st) {
    XcdBarrier b; b.bar = bar; b.x = xb_xcc_id(); b.st = st; b.wave = 0;
    if (threadIdx.x == 0) (void)xb_add(&bar[XB_XCNT(b.x)], 1u);
    return b;
}
__device__ __forceinline__ void xcd_barrier_complete(unsigned* bar, unsigned x, unsigned& nloc, unsigned& nx) {
    const unsigned G = gridDim.x * gridDim.y * gridDim.z;
    unsigned sum, cnt, mine, sp = 0u;
    for (;;) {
        sum = 0u; cnt = 0u; mine = 0u;
#pragma unroll
        for (unsigned j = 0; j < 16; ++j) { const unsigned c = xb_ld(&bar[XB_XCNT(j)]); sum += c; cnt += (c > 0u) ? 1u : 0u; mine = (j == x) ? c : mine; }
        if (sum == G) break;
        __builtin_amdgcn_s_sleep(1);
        if ((++sp & 255u) == 0u) { if (xb_ld(&bar[XB_TMO])) break; if (sp > XB_SPIN_CAP) { atomicAdd(&bar[XB_TMO], 1u); break; } }
    }
    nloc = mine > 0u ? mine : 1u; nx = cnt > 0u ? cnt : 1u;
}
__device__ __forceinline__ void xcd_barrier(const XcdBarrier& b) {
    asm volatile("s_waitcnt vmcnt(0)" ::: "memory");
    __syncthreads();
    if (tid_of(b.wave) == 0) {
        unsigned* bar = b.bar;
        __builtin_amdgcn_s_waitcnt(0);
        unsigned nloc = b.st[0], nx = b.st[1];
        if (nloc == 0u) { xcd_barrier_complete(bar, b.x, nloc, nx); b.st[0] = nloc; b.st[1] = nx; }
        const unsigned old = xb_add(&bar[XB_XSUB(b.x)], 1u);
        const unsigned gen = old / nloc;
        if (old + 1u == (gen + 1u) * nloc) {
            __builtin_amdgcn_fence(__ATOMIC_RELEASE, "agent");
            asm volatile("s_waitcnt vmcnt(0)" ::: "memory");
            const unsigned og = xb_add(&bar[XB_TOP], 1u);
            const unsigned tg = og / nx;
            if (og + 1u == (tg + 1u) * nx) xb_add(&bar[XB_TOPGEN], 1u);
            else XB_SPIN(xb_ld(&bar[XB_TOPGEN]) == tg, bar);
            __builtin_amdgcn_fence(__ATOMIC_ACQUIRE, "agent");
            xb_add(&bar[XB_XGEN(b.x)], 1u);
            asm volatile("s_waitcnt vmcnt(0)" ::: "memory");
        } else {
            XB_SPIN(xb_ld(&bar[XB_XGEN(b.x)]) == gen, bar);
            __builtin_amdgcn_fence(__ATOMIC_ACQUIRE, "agent");
            asm volatile("s_waitcnt vmcnt(0)" ::: "memory");
        }
    }
    __syncthreads();
}

namespace pg8 {
constexpr int BM = 256, BK = 64, HALF = 128, HTB = HALF * BK * 2, STAGE_BYTES = 8 * HTB, NXCD = 8, WGM = 8;
__host__ __device__ __forceinline__ int lds_byte(int r, int c) { const int st = (r >> 4) * 2 + (c >> 5), rr = r & 15, cc = c & 31, ob = rr * 64 + cc * 2; return st * 1024 + (ob ^ (((ob >> 9) & 1) << 5)); }
__host__ __device__ __forceinline__ void stage_rc(int b, int& R, int& C) { const int st = b / 1024, sb = b % 1024, swz = sb ^ (((sb >> 9) & 1) << 5); R = (st >> 1) * 16 + swz / 64; C = (st & 1) * 32 + (swz % 64) / 2; }
__host__ __device__ __forceinline__ int perm32(int rho) { const int n = rho >> 4, i = rho & 15; return 8 * (i >> 2) + 4 * n + (i & 3); }

struct Unit { int pm, pn, aux; long aoff, boff; };
struct Gemm { const bf16_t* A; const bf16_t* Bt; int lda, ldb, K, rmulB; long hstepA, hstepB; };
__device__ __forceinline__ Gemm mk_gemm(const bf16_t* A, int lda, const bf16_t* Bt, int ldb, int K) { Gemm g; g.A = A; g.Bt = Bt; g.lda = lda; g.ldb = ldb; g.K = K; g.rmulB = 1; g.hstepA = (long)HALF * lda * 2; g.hstepB = (long)HALF * ldb * 2; return g; }

template <class Epi, class Sched>
__device__ __forceinline__ void gemm_phase(LAS unsigned char* lds, const Gemm g, const Sched& S, const Epi& E, int wave_) {
    const int tid = tid_of(wave_),
              wid = __builtin_amdgcn_readfirstlane(tid >> 6), lane = tid & 63, wr = wid >> 2, wc = wid & 3, fr = lane & 15, fq = lane >> 4;
    const int K = g.K, nt = K / BK;
    unsigned voffA[2], voffB[2];
#pragma unroll
    for (int i = 0; i < 2; ++i) { int R, C; stage_rc(tid * 16 + i * 8192, R, C); const int Rb = (R & ~31) + perm32(R & 31);
        voffA[i] = (unsigned)(R * g.lda + C) * 2u; voffB[i] = (unsigned)(Rb * g.rmulB * g.ldb + C) * 2u; }
    const size_t kstep = (size_t)(BK * 2);
    const long hstepA = g.hstepA, hstepB = g.hstepB;
    const unsigned ldsw = (unsigned)wid * 1024u;
    const int aoff = lds_byte(wr * 64 + fr, fq * 8), boff = lds_byte(wc * 32 + fr, fq * 8);
#define PG8_SA(b, h) (((b) * 2 + (h)) * HTB)
#define PG8_SB(b, h) ((4 + (b) * 2 + (h)) * HTB)
#define PG8_STAGE(bufoff, gbase, voff) do { _Pragma("unroll") for (int _i = 0; _i < 2; ++_i) \
        __builtin_amdgcn_global_load_lds((const unsigned*)((const char*)(gbase) + (voff)[_i]), (LAS unsigned*)(lds + (bufoff) + ldsw + _i * 8192), 16, 0, 0); } while (0)
#define PG8_LDA(dst, b, h) do { _Pragma("unroll") for (int m = 0; m < 4; ++m) _Pragma("unroll") for (int k = 0; k < 2; ++k) dst[m][k] = *(const LAS bf16x8*)(lds + PG8_SA(b, h) + aoff + m * 2048 + k * 1024); } while (0)
#define PG8_LDB(dst, b, h) do { _Pragma("unroll") for (int n = 0; n < 2; ++n) _Pragma("unroll") for (int k = 0; k < 2; ++k) dst[n][k] = *(const LAS bf16x8*)(lds + PG8_SB(b, h) + boff + n * 2048 + k * 1024); } while (0)
#define PG8_MMA(ai, bj, At, Bt) do { __builtin_amdgcn_s_setprio(1); _Pragma("unroll") for (int m = 0; m < 4; ++m) _Pragma("unroll") for (int n = 0; n < 2; ++n) _Pragma("unroll") for (int k = 0; k < 2; ++k) \
        acc[ai][bj][m][n] = __builtin_amdgcn_mfma_f32_16x16x32_bf16(Bt[n][k], At[m][k], acc[ai][bj][m][n], 0, 0, 0); __builtin_amdgcn_s_setprio(0); } while (0)
#define PG8_WAIT_V(n) asm volatile("s_waitcnt vmcnt(" #n ")" ::: "memory")
#define PG8_WAIT_L(n) asm volatile("s_waitcnt lgkmcnt(" #n ")" ::: "memory")
#define PG8_BAR __builtin_amdgcn_s_barrier()
#define PG8_SCHED __builtin_amdgcn_sched_barrier(0)
    Unit cur, nxt; int ui = 0;
    if (!S.next(0, cur)) return;
    f32x4 acc[2][2][4][2];
#pragma unroll
    for (int a = 0; a < 2; ++a)
#pragma unroll
        for (int b = 0; b < 2; ++b)
#pragma unroll
            for (int m = 0; m < 4; ++m)
#pragma unroll
                for (int n = 0; n < 2; ++n) acc[a][b][m][n] = (f32x4){0.f, 0.f, 0.f, 0.f};
    bf16x8 At[4][2], B0[2][2], B1[2][2];
    const char* cA = (const char*)g.A + cur.aoff; const char* cB = (const char*)g.Bt + cur.boff;
    PG8_STAGE(PG8_SB(0, 0), cB, voffB); PG8_STAGE(PG8_SB(0, 1), cB + hstepB, voffB); PG8_STAGE(PG8_SA(0, 0), cA, voffA); PG8_STAGE(PG8_SA(0, 1), cA + hstepA, voffA);
    if (wr == 1) PG8_BAR;
    PG8_WAIT_V(2); PG8_BAR;
    PG8_STAGE(PG8_SB(1, 0), cB + kstep, voffB); PG8_STAGE(PG8_SA(1, 0), cA + kstep, voffA); PG8_STAGE(PG8_SB(1, 1), cB + hstepB + kstep, voffB);
    PG8_WAIT_V(6); PG8_BAR;
    for (;;) {
        const bool has_next = S.next(ui + 1, nxt);
        const char* nA = has_next ? (const char*)g.A + nxt.aoff : cA; const char* nB = has_next ? (const char*)g.Bt + nxt.boff : cB;
        for (int t = 0; t < nt; t += 2) {
            const bool last = (t == nt - 2);
            const char* a1 = cA + (size_t)(t + 1) * kstep;
            const char* a2 = last ? nA : cA + (size_t)(t + 2) * kstep; const char* b2 = last ? nB : cB + (size_t)(t + 2) * kstep;
            const char* a3 = a2 + kstep; const char* b3 = b2 + kstep;
            PG8_LDB(B0, 0, 0); PG8_LDB(B1, 0, 1); PG8_SCHED; PG8_LDA(At, 0, 0); PG8_STAGE(PG8_SA(1, 1), a1 + hstepA, voffA);
            PG8_WAIT_V(8); PG8_WAIT_L(0); PG8_BAR; PG8_MMA(0, 0, At, B0); PG8_MMA(0, 1, At, B1); PG8_BAR; PG8_SCHED;
            PG8_LDA(At, 0, 1); PG8_STAGE(PG8_SB(0, 0), b2, voffB); PG8_STAGE(PG8_SB(0, 1), b2 + hstepB, voffB); PG8_STAGE(PG8_SA(0, 0), a2, voffA);
            PG8_WAIT_V(8); PG8_WAIT_L(0); PG8_BAR; PG8_MMA(1, 0, At, B0); PG8_MMA(1, 1, At, B1); PG8_BAR; PG8_SCHED;
            PG8_LDB(B0, 1, 0); PG8_LDB(B1, 1, 1); PG8_SCHED; PG8_LDA(At, 1, 0); PG8_STAGE(PG8_SA(0, 1), a2 + hstepA, voffA);
            PG8_WAIT_V(8); PG8_WAIT_L(0); PG8_BAR; PG8_MMA(0, 0, At, B0); PG8_MMA(0, 1, At, B1); PG8_BAR; PG8_SCHED;
            PG8_LDA(At, 1, 1); PG8_STAGE(PG8_SB(1, 0), b3, voffB); PG8_STAGE(PG8_SB(1, 1), b3 + hstepB, voffB); PG8_STAGE(PG8_SA(1, 0), a3, voffA);
            PG8_WAIT_V(8); PG8_WAIT_L(0); PG8_BAR; PG8_MMA(1, 0, At, B0); PG8_MMA(1, 1, At, B1); PG8_BAR; PG8_SCHED;
        }
        if (wr == 0) PG8_BAR;
        E(acc, cur, wr, wc, fr, fq);
        if (!has_next) break;
#pragma unroll
        for (int a = 0; a < 2; ++a)
#pragma unroll
            for (int b = 0; b < 2; ++b)
#pragma unroll
                for (int m = 0; m < 4; ++m)
#pragma unroll
                    for (int n = 0; n < 2; ++n) acc[a][b][m][n] = (f32x4){0.f, 0.f, 0.f, 0.f};
        cur = nxt; cA = nA; cB = nB; ++ui;
        if (wr == 1) PG8_BAR;
    }
    PG8_WAIT_V(0);
    PG8_BAR;
#undef PG8_SA
#undef PG8_SB
#undef PG8_STAGE
#undef PG8_LDA
#undef PG8_LDB
#undef PG8_MMA
#undef PG8_WAIT_V
#undef PG8_WAIT_L
#undef PG8_BAR
#undef PG8_SCHED
}

struct TileOrder {
    int nM, nN, nwg, G, c, xpm, xlo, xn, sn, sdiv; long tA, tB, sA0, sB0;
    __device__ __forceinline__ void init(int nM_, int nN_, int G_, int c_, long tA_, long tB_) { nM = nM_; nN = nN_; nwg = nM * nN; G = G_; c = c_; tA = tA_; tB = tB_; xpm = 0; xlo = 0; xn = 0; sn = 0; sdiv = 1; sA0 = 0; sB0 = 0; }
    __device__ __forceinline__ bool next(int i, Unit& u) const {
        const long L = (long)i * G + c;
        if (L < nwg) {
            int wgid = (int)L; { const int q = nwg / NXCD, r = nwg % NXCD, xcd = wgid % NXCD, off = wgid / NXCD; wgid = (xcd < r ? xcd * (q + 1) : r * (q + 1) + (xcd - r) * q) + off; }
            const int nig = WGM * nN, gid = wgid / nig, fm = gid * WGM, gsz = (nM - fm) < WGM ? (nM - fm) : WGM;
            u.pm = fm + ((wgid % nig) % gsz); u.pn = (wgid % nig) / gsz;
        } else if (L < nwg + xn) { u.pm = xpm; u.pn = xlo + (int)(L - nwg); }
        else if (L < nwg + xn + sn) { const int k = (int)(L - nwg - xn); u.pm = k / sdiv; u.pn = 1000 + k % sdiv; u.aux = 0; u.aoff = sA0 + (long)u.pm * tB; u.boff = sB0 + (long)(k % sdiv) * tA; return true; }
        else return false;
        u.aux = 0; u.aoff = u.pm * tA; u.boff = u.pn * tB; return true;
    }
};
struct F1Order { int G, c;
    __device__ __forceinline__ bool next(int i, Unit& u) const { const int L = i * G + c; if (L >= 512) return false;
        u.pn = L & 63; u.pm = (L >> 6) & 1; u.aux = L >> 7; u.aoff = (long)u.pm * 256 * 256 * 2; u.boff = (long)u.aux * 512 + (long)(2 * u.pn) * FD * 2; return true; } };
struct F1cOrder { int G, c;
    __device__ __forceinline__ bool next(int i, Unit& u) const { const int L = i * G + c; if (L >= 8) return false;
        u.pn = 0; u.pm = L & 1; u.aux = L >> 1; u.aoff = (long)u.pm * 256 * 256 * 2; u.boff = ((long)SEQ * FD + u.aux * 256) * 2; return true; } };
struct LinOrder { int G, c, n; long tB;
    __device__ __forceinline__ bool next(int i, Unit& u) const { const int L = i * G + c; if (L >= n) return false;
        u.pn = L; u.pm = 0; u.aux = 0; u.aoff = 0; u.boff = (long)L * tB; return true; } };
struct SplitKOrder { int G, c, nN, S, pmv; long abase, tB, ksb;
    __device__ __forceinline__ bool next(int i, Unit& u) const { const int L = i * G + c; if (L >= nN * S) return false;
        u.pn = L % nN; u.aux = L / nN; u.pm = pmv; u.aoff = abase + (long)u.aux * ksb; u.boff = (long)u.pn * tB + (long)u.aux * ksb; return true; } };
struct MoeOrder { int G, c, nN; int cum[9]; long tA, tB, eB;
    __device__ __forceinline__ bool next(int i, Unit& u) const { const int L = i * G + c; const int T = cum[8]; if (L >= T * nN) return false;
        const int nwg = T * nN; int wgid = L; { const int q = nwg / NXCD, r = nwg % NXCD, xcd = wgid % NXCD, off = wgid / NXCD; wgid = (xcd < r ? xcd * (q + 1) : r * (q + 1) + (xcd - r) * q) + off; }
        const int nig = WGM * nN, gid = wgid / nig, fm = gid * WGM, gsz = (T - fm) < WGM ? (T - fm) : WGM;
        const int ti = fm + ((wgid % nig) % gsz), pn = (wgid % nig) / gsz; int e = 0;
#pragma unroll
        for (int k = 1; k < 8; ++k) e += (ti >= cum[k]) ? 1 : 0;
        u.pm = ti; u.pn = pn; u.aux = e; u.aoff = (long)ti * tA; u.boff = (long)e * eB + (long)pn * tB; return true; } };

#define EPI_ARGS const f32x4 (&acc)[2][2][4][2], const Unit& u, int wr, int wc, int fr, int fq
__device__ __forceinline__ u32x4 pack8(f32x4 v0, f32x4 v1) { u32x4 w; w.x = cvt_pk_bf16(v0[0], v0[1]); w.y = cvt_pk_bf16(v0[2], v0[3]); w.z = cvt_pk_bf16(v1[0], v1[1]); w.w = cvt_pk_bf16(v1[2], v1[3]); return w; }
__device__ __forceinline__ void unpack8(u32x4 w, f32x4& v0, f32x4& v1) { v0 = (f32x4){bflo(w.x), bfhi(w.x), bflo(w.y), bfhi(w.y)}; v1 = (f32x4){bflo(w.z), bfhi(w.z), bflo(w.w), bfhi(w.w)}; }

struct EpiInProj {
    bf16_t *Q, *Kb, *Vb, *Fb, *Gb; const float* bgate; bf16_t* Vt;
    __device__ __forceinline__ void operator()(EPI_ARGS) const {
        if (u.pn >= 1000) {
            const int row0 = u.pm * BM + wr * 64 + fr, col0 = (u.pn - 1000) * BM + wc * 32 + 8 * fq;
#pragma unroll
            for (int ai = 0; ai < 2; ++ai)
#pragma unroll
                for (int m = 0; m < 4; ++m) { bf16_t* rowp = Vt + (size_t)(row0 + ai * HALF + m * 16) * MR + col0;
#pragma unroll
                    for (int bj = 0; bj < 2; ++bj) *(u32x4*)(rowp + bj * HALF) = pack8(acc[ai][bj][m][0], acc[ai][bj][m][1]); }
            return; }
        const int pn = u.pn; bf16_t* base; int ldc, c0; bool sig = false;
        if (pn < 8) { base = Q; ldc = QW; c0 = pn * 256; }
        else if (pn < 10) { base = Kb; ldc = KVW; c0 = (pn - 8) * 256; }
        else if (pn < 12) { base = Vb; ldc = KVW; c0 = (pn - 10) * 256; }
        else if (pn < 16) { base = Fb; ldc = FD; c0 = (pn - 12) * 256; }
        else { base = Gb; ldc = GW2; c0 = (pn - 16) * 256; sig = true; }
        const int row0 = u.pm * BM + wr * 64 + fr, col0 = c0 + wc * 32 + 8 * fq;
        f32x4 bv[2][2];
#pragma unroll
        for (int bj = 0; bj < 2; ++bj)
#pragma unroll
            for (int n = 0; n < 2; ++n) bv[bj][n] = sig ? *(const f32x4*)(bgate + col0 + bj * HALF + 4 * n) : (f32x4){0.f, 0.f, 0.f, 0.f};
#pragma unroll
        for (int ai = 0; ai < 2; ++ai)
#pragma unroll
            for (int m = 0; m < 4; ++m) { bf16_t* rowp = base + (size_t)(row0 + ai * HALF + m * 16) * ldc + col0;
#pragma unroll
                for (int bj = 0; bj < 2; ++bj) { f32x4 v0 = acc[ai][bj][m][0] + bv[bj][0], v1 = acc[ai][bj][m][1] + bv[bj][1];
                    if (sig) {
#pragma unroll
                        for (int j = 0; j < 4; ++j) { v0[j] = sigmoidf_(v0[j]); v1[j] = sigmoidf_(v1[j]); } }
                    *(u32x4*)(rowp + bj * HALF) = pack8(v0, v1); } }
    }
};
struct EpiF1 {
    bf16_t* ZA;
    __device__ __forceinline__ void operator()(EPI_ARGS) const {
        const int g = u.aux, reim = u.pm;
#pragma unroll
        for (int ai = 0; ai < 2; ++ai)
#pragma unroll
            for (int m = 0; m < 4; ++m) { const int mm = ai * HALF + wr * 64 + m * 16 + fr;
#pragma unroll
                for (int bj = 0; bj < 2; ++bj) { const int a = 2 * u.pn + bj, b = wc * 32 + 8 * fq;
                    *(u32x4*)(ZA + ((size_t)((g * 256 + mm) * 128 + a) * 256 + reim * 128 + b)) = pack8(acc[ai][bj][m][0], acc[ai][bj][m][1]); } }
    }
};
struct EpiF1c {
    bf16_t* ZC;
    __device__ __forceinline__ void operator()(EPI_ARGS) const {
        const int g = u.aux, reim = u.pm;
#pragma unroll
        for (int ai = 0; ai < 2; ++ai)
#pragma unroll
            for (int m = 0; m < 4; ++m) { const int mm = ai * HALF + wr * 64 + m * 16 + fr;
#pragma unroll
                for (int bj = 0; bj < 2; ++bj) { const int n = bj * HALF + wc * 32 + 8 * fq;
                    *(u32x4*)(ZC + ((size_t)(g * 256 + mm) * 512 + reim * 256 + n)) = pack8(acc[ai][bj][m][0], acc[ai][bj][m][1]); } }
    }
};
struct EpiF2 {
    bf16_t* YB;
    __device__ __forceinline__ void operator()(EPI_ARGS) const {
#pragma unroll
        for (int m = 0; m < 4; ++m) { int ka = wr * 64 + m * 16 + fr; asm volatile("" : "+v"(ka));
#pragma unroll
            for (int bj = 0; bj < 2; ++bj) { const int gm = 2 * u.pn + bj, g = gm >> 8, mm = gm & 255, a0 = wc * 32 + 8 * fq;
                f32x4 re[2], im[2];
#pragma unroll
                for (int n = 0; n < 2; ++n)
#pragma unroll
                    for (int j = 0; j < 4; ++j) { const int a = a0 + 4 * n + j; const float t = (float)(a * ka) * (1.0f / 16384.0f);
                        const float c = __builtin_amdgcn_cosf(t), s = __builtin_amdgcn_sinf(t);
                        const float yr = acc[0][bj][m][n][j], yi = acc[1][bj][m][n][j];
                        re[n][j] = yr * c + yi * s; im[n][j] = yi * c - yr * s; }
                bf16_t* p = YB + ((size_t)((g * 128 + ka) * 256 + mm) * 256 + a0);
                *(u32x4*)p = pack8(re[0], re[1]); *(u32x4*)(p + 128) = pack8(im[0], im[1]); asm volatile("" ::: "memory"); } }
    }
};
struct EpiF3 {
    bf16_t* FOUR;
    __device__ __forceinline__ void operator()(EPI_ARGS) const {
        const int g = u.pn >> 7, ka = u.pn & 127;
#pragma unroll
        for (int m = 0; m < 4; ++m) { const int kb = wr * 64 + m * 16 + fr;
#pragma unroll
            for (int bj = 0; bj < 2; ++bj) { const int mm = bj * HALF + wc * 32 + 8 * fq;
                *(u32x4*)(FOUR + ((size_t)(128 * kb + ka) * FD + g * 256 + mm)) = pack8(acc[0][bj][m][0], acc[0][bj][m][1]); } }
    }
};
struct EpiF3c {
    bf16_t* FOUR;
    __device__ __forceinline__ void operator()(EPI_ARGS) const {
#pragma unroll
        for (int ai = 0; ai < 2; ++ai)
#pragma unroll
            for (int m = 0; m < 4; ++m) { const int k = ai * HALF + wr * 64 + m * 16 + fr;
#pragma unroll
                for (int bj = 0; bj < 2; ++bj) { const int mm = bj * HALF + wc * 32 + 8 * fq;
                    *(u32x4*)(FOUR + ((size_t)(SEQ + k) * FD + u.pn * 256 + mm)) = pack8(acc[ai][bj][m][0], acc[ai][bj][m][1]); } }
    }
};
template <int SECOND> struct EpiMerge {
    bf16_t* Y; const bf16_t* Gb;
    __device__ __forceinline__ void operator()(EPI_ARGS) const {
        const int row0 = u.pm * BM + wr * 64 + fr, col0 = u.pn * BM + wc * 32 + 8 * fq;
#pragma unroll
        for (int ai = 0; ai < 2; ++ai)
#pragma unroll
            for (int m = 0; m < 4; ++m) { const size_t row = (size_t)(row0 + ai * HALF + m * 16);
#pragma unroll
                for (int bj = 0; bj < 2; ++bj) { const int col = col0 + bj * HALF;
                    f32x4 g0, g1; unpack8(*(const u32x4*)(Gb + row * GW2 + SECOND * DM + col), g0, g1);
                    f32x4 v0 = acc[ai][bj][m][0] * g0, v1 = acc[ai][bj][m][1] * g1;
                    bf16_t* yp = Y + row * DM + col;
                    if (SECOND) { f32x4 y0, y1; unpack8(*(const u32x4*)yp, y0, y1); v0 += y0; v1 += y1; }
                    *(u32x4*)yp = pack8(v0, v1); } }
    }
};
struct EpiRes {
    const float* baseF; const bf16_t* baseB; bf16_t* outB; const float* gateL; const float* baseC; float* outC; const float* gateC;
    __device__ __forceinline__ void operator()(EPI_ARGS) const {
        const bool isc = u.pm >= SEQ / BM; const float* gate = isc ? gateC : gateL;
        const int row0 = (isc ? 0 : u.pm * BM) + wr * 64 + fr, col0 = u.pn * BM + wc * 32 + 8 * fq;
        f32x4 gv[2][2];
#pragma unroll
        for (int bj = 0; bj < 2; ++bj)
#pragma unroll
            for (int n = 0; n < 2; ++n) gv[bj][n] = *(const f32x4*)(gate + col0 + bj * HALF + 4 * n);
#pragma unroll
        for (int ai = 0; ai < 2; ++ai)
#pragma unroll
            for (int m = 0; m < 4; ++m) { const size_t off = (size_t)(row0 + ai * HALF + m * 16) * DM + col0;
#pragma unroll
                for (int bj = 0; bj < 2; ++bj) {
                    if (isc) {
#pragma unroll
                        for (int n = 0; n < 2; ++n) { const f32x4 b = *(const f32x4*)(baseC + off + bj * HALF + 4 * n); *(f32x4*)(outC + off + bj * HALF + 4 * n) = b + gv[bj][n] * acc[ai][bj][m][n]; }
                    } else {
                        f32x4 b0, b1;
                        if (baseB) unpack8(*(const u32x4*)(baseB + off + bj * HALF), b0, b1);
                        else { b0 = *(const f32x4*)(baseF + off + bj * HALF); b1 = *(const f32x4*)(baseF + off + bj * HALF + 4); }
                        *(u32x4*)(outB + off + bj * HALF) = pack8(b0 + gv[bj][0] * acc[ai][bj][m][0], b1 + gv[bj][1] * acc[ai][bj][m][1]); } }
                asm volatile("" ::: "memory"); }
    }
};
struct EpiPartial {
    float* part; const float* gate;
    __device__ __forceinline__ void operator()(EPI_ARGS) const {
        const int row0 = wr * 64 + fr, col0 = u.pn * BM + wc * 32 + 8 * fq; float* pbase = part + (size_t)u.aux * CTXL * DM;
        f32x4 gv[2][2];
#pragma unroll
        for (int bj = 0; bj < 2; ++bj)
#pragma unroll
            for (int n = 0; n < 2; ++n) gv[bj][n] = *(const f32x4*)(gate + col0 + bj * HALF + 4 * n);
#pragma unroll
        for (int ai = 0; ai < 2; ++ai)
#pragma unroll
            for (int m = 0; m < 4; ++m) { float* rowp = pbase + (size_t)(row0 + ai * HALF + m * 16) * DM + col0;
#pragma unroll
                for (int bj = 0; bj < 2; ++bj)
#pragma unroll
                    for (int n = 0; n < 2; ++n) *(f32x4*)(rowp + bj * HALF + 4 * n) = gv[bj][n] * acc[ai][bj][m][n]; }
    }
};
struct EpiSwiglu {
    bf16_t* U; int ldu;
    __device__ __forceinline__ void operator()(EPI_ARGS) const {
        const int row0 = u.pm * BM + wr * 64 + fr, col0 = u.pn * HALF + wc * 32 + 8 * fq;
#pragma unroll
        for (int ai = 0; ai < 2; ++ai)
#pragma unroll
            for (int m = 0; m < 4; ++m) { f32x4 o[2];
#pragma unroll
                for (int n = 0; n < 2; ++n)
#pragma unroll
                    for (int j = 0; j < 4; ++j) { const float gt = acc[ai][0][m][n][j], up = acc[ai][1][m][n][j]; o[n][j] = gt * sigmoidf_(gt) * up; }
                *(u32x4*)(U + (size_t)(row0 + ai * HALF + m * 16) * ldu + col0) = pack8(o[0], o[1]); }
    }
};
struct EpiPlain {
    bf16_t* O; int ldc;
    __device__ __forceinline__ void operator()(EPI_ARGS) const {
        const int row0 = u.pm * BM + wr * 64 + fr, col0 = u.pn * BM + wc * 32 + 8 * fq;
#pragma unroll
        for (int ai = 0; ai < 2; ++ai)
#pragma unroll
            for (int m = 0; m < 4; ++m) { bf16_t* rowp = O + (size_t)(row0 + ai * HALF + m * 16) * ldc + col0;
#pragma unroll
                for (int bj = 0; bj < 2; ++bj) *(u32x4*)(rowp + bj * HALF) = pack8(acc[ai][bj][m][0], acc[ai][bj][m][1]); }
    }
};
}

namespace at {
using bf16 = __hip_bfloat16;
constexpr int D = 128, NW = 8, QBLK = 32, KVBLK = 64;
constexpr float SCALE = 0.088388347648318440f;
constexpr float THR = 8.f;
constexpr int LDQ = QW, LDK = KVW, LDO = QW;
constexpr size_t SHM_V = KVBLK * D * 2, SHM_K = KVBLK * D * 2, SHM_ATTN = 2 * SHM_V + 2 * SHM_K + NW * 64 * 4;
#define KSWZ(row, colB) ((row) * 256 + ((colB) ^ (((row) & 15) << 4)))
#define SBAR() __builtin_amdgcn_sched_barrier(0)
__device__ __forceinline__ int crow(int r, int hi) { return (r & 3) + 8 * (r >> 2) + 4 * hi; }
__device__ __forceinline__ unsigned cvtpk(float lo, float hi) { unsigned r; asm volatile("v_cvt_pk_bf16_f32 %0, %1, %2" : "=v"(r) : "v"(lo), "v"(hi)); return r; }
__device__ __forceinline__ void partialSM(f32x16& p0, f32x16& p1, float& m_reg, float& mn, float& alpha) {
  constexpr float C = 1.0f;
  float pmax = p0[0]; for (int r = 1; r < 16; ++r) pmax = fmaxf(pmax, p0[r]); for (int r = 0; r < 16; ++r) pmax = fmaxf(pmax, p1[r]);
  { auto rr = __builtin_amdgcn_permlane32_swap(__float_as_uint(pmax), __float_as_uint(pmax), false, false);
    pmax = fmaxf(__uint_as_float(rr[0]), __uint_as_float(rr[1])); }
  if (__builtin_expect(__all(pmax - m_reg <= THR * 1.4426950408889634f), 1)) { mn = m_reg; alpha = 1.f; }
  else { mn = fmaxf(m_reg, pmax); alpha = __builtin_amdgcn_exp2f((m_reg - mn) * C); m_reg = mn; }
  float mnC = -mn * C;
  for (int r = 0; r < 16; ++r) p0[r] = fmaf(p0[r], C, mnC); for (int r = 0; r < 16; ++r) p1[r] = fmaf(p1[r], C, mnC);
  for (int r = 0; r < 16; ++r) p0[r] = __builtin_amdgcn_exp2f(p0[r]);
}
__device__ __forceinline__ void finishSM(f32x16& p0, f32x16& p1, float alpha, float& l_reg, bf16x8& pa0, bf16x8& pa1, bf16x8& pa2, bf16x8& pa3) {
  for (int r = 0; r < 16; ++r) p1[r] = __builtin_amdgcn_exp2f(p1[r]);
  float ps = 0; for (int r = 0; r < 16; ++r) ps += p0[r]; for (int r = 0; r < 16; ++r) ps += p1[r];
  { auto rr = __builtin_amdgcn_permlane32_swap(__float_as_uint(ps), __float_as_uint(ps), false, false);
    ps = __uint_as_float(rr[0]) + __uint_as_float(rr[1]); }
  l_reg = l_reg * alpha + ps;
#define PK4(P, BASE, OUT) do { unsigned a0 = cvtpk(P[BASE + 0], P[BASE + 1]), a1 = cvtpk(P[BASE + 2], P[BASE + 3]);   \
    unsigned b0 = cvtpk(P[BASE + 4], P[BASE + 5]), b1 = cvtpk(P[BASE + 6], P[BASE + 7]);                              \
    auto r0 = __builtin_amdgcn_permlane32_swap(a0, b0, false, false); auto r1 = __builtin_amdgcn_permlane32_swap(a1, b1, false, false); \
    u32x4 w = {r0[0], r1[0], r0[1], r1[1]}; OUT = *reinterpret_cast<bf16x8*>(&w); } while (0)
  PK4(p0, 0, pa0); PK4(p0, 8, pa1); PK4(p1, 0, pa2); PK4(p1, 8, pa3);
#undef PK4
}
__device__ __forceinline__ void qkt(f32x16& p0, f32x16& p1, const bf16* Ks, const bf16x8* qr, int r32, int hi) {
  p0 = f32x16{}; p1 = f32x16{};
  for (int d0 = 0; d0 < 8; ++d0) { int cb = (d0 * 16 + hi * 8) * 2;
    bf16x8 b0 = *reinterpret_cast<const bf16x8*>((const char*)Ks + KSWZ(r32, cb));
    bf16x8 b1 = *reinterpret_cast<const bf16x8*>((const char*)Ks + KSWZ(32 + r32, cb));
    p0 = __builtin_amdgcn_mfma_f32_32x32x16_bf16(b0, qr[d0], p0, 0, 0, 0);
    p1 = __builtin_amdgcn_mfma_f32_32x32x16_bf16(b1, qr[d0], p1, 0, 0, 0); }
}
__device__ __forceinline__ int v_st(int k, int c) { const int kk = (k & ~0xC) | ((k & 4) << 1) | ((k & 8) >> 1); return ((kk >> 3) * 4 + (c >> 5)) * 512 + ((kk & 7) * 32 + (c & 31)) * 2; }
__device__ __forceinline__ int v_rd_base(int lane) { return ((lane & 3) << 3) | (((lane >> 2) & 3) << 6) | (((lane >> 4) & 1) << 5) | (((lane >> 5) & 1) << 8); }
constexpr int v_rd_off(int d0, int ks, int half) { return d0 * 512 + ks * 4096 + half * 2048; }
template <int OFF> __device__ __forceinline__ s16x4 tr_read(int vb) {
  s16x4 r; asm volatile("ds_read_b64_tr_b16 %0, %1 offset:%2" : "=&v"(r) : "v"(vb), "i"(OFF) : "memory"); return r;
}
template <int D0> __device__ __forceinline__ void pv_one(f32x16& od, int vb, bf16x8 pa0, bf16x8 pa1, bf16x8 pa2, bf16x8 pa3) {
  const s16x4 l0 = tr_read<v_rd_off(D0, 0, 0)>(vb), h0 = tr_read<v_rd_off(D0, 0, 1)>(vb), l1 = tr_read<v_rd_off(D0, 1, 0)>(vb), h1 = tr_read<v_rd_off(D0, 1, 1)>(vb);
  const s16x4 l2 = tr_read<v_rd_off(D0, 2, 0)>(vb), h2 = tr_read<v_rd_off(D0, 2, 1)>(vb), l3 = tr_read<v_rd_off(D0, 3, 0)>(vb), h3 = tr_read<v_rd_off(D0, 3, 1)>(vb);
  asm volatile("s_waitcnt lgkmcnt(0)" ::: "memory"); SBAR();
#define PK(L, H) (bf16x8){L[0], L[1], L[2], L[3], H[0], H[1], H[2], H[3]}
  od = __builtin_amdgcn_mfma_f32_32x32x16_bf16(pa0, PK(l0, h0), od, 0, 0, 0);
  od = __builtin_amdgcn_mfma_f32_32x32x16_bf16(pa1, PK(l1, h1), od, 0, 0, 0);
  od = __builtin_amdgcn_mfma_f32_32x32x16_bf16(pa2, PK(l2, h2), od, 0, 0, 0);
  od = __builtin_amdgcn_mfma_f32_32x32x16_bf16(pa3, PK(l3, h3), od, 0, 0, 0);
#undef PK
}
__device__ __forceinline__ void pv_d0(f32x16* o, int vb, bf16x8 pa0, bf16x8 pa1, bf16x8 pa2, bf16x8 pa3) {
  pv_one<0>(o[0], vb, pa0, pa1, pa2, pa3); pv_one<1>(o[1], vb, pa0, pa1, pa2, pa3); pv_one<2>(o[2], vb, pa0, pa1, pa2, pa3); pv_one<3>(o[3], vb, pa0, pa1, pa2, pa3);
}
__device__ __forceinline__ void q_prologue(bf16x8 (&qr)[8], const float* __restrict__ qg, const float* __restrict__ rope, int tok, int hi) {
  constexpr float QC = SCALE * 1.4426950408889634f;
  float x[8][8]; float ss = 0.f;
#pragma unroll
  for (int d0 = 0; d0 < 8; ++d0)
#pragma unroll
    for (int j = 0; j < 8; ++j) { x[d0][j] = __builtin_bit_cast(float, (unsigned)(unsigned short)qr[d0][j] << 16); ss += x[d0][j] * x[d0][j]; }
  { auto rr = __builtin_amdgcn_permlane32_swap(__float_as_uint(ss), __float_as_uint(ss), false, false); ss = __uint_as_float(rr[0]) + __uint_as_float(rr[1]); }
  const float rs = QC / sqrtf(ss * (1.0f / D) + 1e-6f);
#pragma unroll
  for (int d0 = 0; d0 < 8; ++d0) { const f32x4 g0 = *(const f32x4*)(qg + 16 * d0 + 8 * hi), g1 = *(const f32x4*)(qg + 16 * d0 + 8 * hi + 4);
#pragma unroll
    for (int j = 0; j < 4; ++j) { x[d0][j] *= rs * g0[j]; x[d0][4 + j] *= rs * g1[j]; } }
  if (tok >= 0) {
#pragma unroll
    for (int a = 0; a < 2; ++a) { const int pos = a ? (tok & 63) : (tok >> 6); const float* ct = rope + (a ? 16384 : 0) + pos * 32 + 8 * hi; const float* st = ct + (a ? 2048 : 8192);
#pragma unroll
      for (int e = 0; e < 2; ++e) { const f32x4 c0 = *(const f32x4*)(ct + 16 * e), c1 = *(const f32x4*)(ct + 16 * e + 4), s0 = *(const f32x4*)(st + 16 * e), s1 = *(const f32x4*)(st + 16 * e + 4);
#pragma unroll
        for (int j = 0; j < 8; ++j) { const float c = j < 4 ? c0[j & 3] : c1[j & 3], sn = j < 4 ? s0[j & 3] : s1[j & 3]; const float lo = x[4 * a + e][j], hh = x[4 * a + 2 + e][j];
          x[4 * a + e][j] = lo * c - hh * sn; x[4 * a + 2 + e][j] = hh * c + lo * sn; } } } }
#pragma unroll
  for (int d0 = 0; d0 < 8; ++d0) { u32x4 w = {cvtpk(x[d0][0], x[d0][1]), cvtpk(x[d0][2], x[d0][3]), cvtpk(x[d0][4], x[d0][5]), cvtpk(x[d0][6], x[d0][7])}; qr[d0] = *reinterpret_cast<bf16x8*>(&w); }
}
__device__ __forceinline__ void attn_dense_body(const bf16* Qb, const bf16* __restrict__ Kh, const bf16* __restrict__ Vh, bf16* Ob, int seq, char* lds, int wave_, const float* qg, const float* rope, int tok0) {
  const int tid = tid_of(wave_), wid = tid >> 6, lane = tid & 63, r32 = lane & 31, hi = lane >> 5;
  bf16* V_lds = (bf16*)lds; bf16* K_lds = (bf16*)(lds + 2 * SHM_V);
  float* ws = (float*)(lds + 2 * SHM_V + 2 * SHM_K) + wid * 64; float* li_l = ws; float* al_l = ws + 32;
  float m_reg = -1e30f, l_reg = 0; f32x16 o[4] = {}; bf16x8 qr[8];
  const bf16* Qw = Qb + (long)(wid * QBLK + r32) * LDQ + hi * 8;
#pragma unroll
  for (int d0 = 0; d0 < 8; ++d0) qr[d0] = *reinterpret_cast<const bf16x8*>(Qw + d0 * 16);
  q_prologue(qr, qg, rope, tok0 < 0 ? -1 : tok0 + wid * QBLK + r32, hi);
  const int sr = tid >> 4, sc = (tid & 15) * 8, vst0 = v_st(sr, sc), vst1 = v_st(32 + sr, sc);
  const int vb0 = (int)(uintptr_t)V_lds + v_rd_base(lane);
  struct { bf16x8 vs0, vs1, ks0, ks1; } sr_[2];
#define SLOAD(i, k0) do { sr_[i].vs0 = *(const bf16x8*)(&Vh[(long)((k0) + sr) * LDK + sc]); sr_[i].vs1 = *(const bf16x8*)(&Vh[(long)((k0) + 32 + sr) * LDK + sc]); \
    sr_[i].ks0 = *(const bf16x8*)(&Kh[(long)((k0) + sr) * LDK + sc]); sr_[i].ks1 = *(const bf16x8*)(&Kh[(long)((k0) + 32 + sr) * LDK + sc]); } while (0)
#define SWRITE(b, i) do { *(bf16x8*)((char*)V_lds + (b) * SHM_V + vst0) = sr_[i].vs0;          \
    *(bf16x8*)((char*)V_lds + (b) * SHM_V + vst1) = sr_[i].vs1; int kc = sc * 2;               \
    *(bf16x8*)((char*)K_lds + (b) * SHM_K + KSWZ(sr, kc)) = sr_[i].ks0;                       \
    *(bf16x8*)((char*)K_lds + (b) * SHM_K + KSWZ(32 + sr, kc)) = sr_[i].ks1; } while (0)
#define SWAIT() asm volatile("s_waitcnt vmcnt(4)" ::: "memory")
#define RESC(a) do { if (__any((a) < 1.f)) { if (hi == 0) al_l[r32] = (a); asm volatile("s_waitcnt lgkmcnt(0)" ::: "memory"); \
    for (int d = 0; d < 4; ++d) for (int r = 0; r < 16; ++r) o[d][r] *= al_l[crow(r, hi)]; } } while (0)
  f32x16 pA0, pA1, pB0, pB1; float mnA, mnB, alA, alB; bf16x8 pa0, pa1, pa2, pa3; const int NT = seq / KVBLK;
  constexpr int SE = 0, SO = 1;
  SLOAD(SE, 0); asm volatile("s_waitcnt vmcnt(0)" ::: "memory"); SWRITE(0, SE); __syncthreads();
  qkt(pA0, pA1, K_lds, qr, r32, hi); partialSM(pA0, pA1, m_reg, mnA, alA);
  SLOAD(SO, KVBLK); if (2 < NT) SLOAD(SE, 2 * KVBLK);
  SWAIT(); SWRITE(1, SO); __syncthreads();
  for (int j = 1; j + 1 < NT; j += 2) {
    SBAR(); qkt(pB0, pB1, (bf16*)((char*)K_lds + SHM_K), qr, r32, hi);
    finishSM(pA0, pA1, alA, l_reg, pa0, pa1, pa2, pa3); SBAR();
    SLOAD(SO, (j + 2) * KVBLK); SBAR();
    pv_d0(o, vb0, pa0, pa1, pa2, pa3); partialSM(pB0, pB1, m_reg, mnB, alB);
    __syncthreads(); SWAIT(); SWRITE(0, SE);
    RESC(alB); __syncthreads();
    SBAR(); qkt(pA0, pA1, K_lds, qr, r32, hi);
    finishSM(pB0, pB1, alB, l_reg, pa0, pa1, pa2, pa3); SBAR();
    if (j + 3 < NT) SLOAD(SE, (j + 3) * KVBLK); SBAR();
    pv_d0(o, vb0 + (int)SHM_V, pa0, pa1, pa2, pa3); partialSM(pA0, pA1, m_reg, mnA, alA);
    __syncthreads(); SWAIT(); SWRITE(1, SO);
    RESC(alA); __syncthreads();
  }
  SBAR(); qkt(pB0, pB1, (bf16*)((char*)K_lds + SHM_K), qr, r32, hi);
  finishSM(pA0, pA1, alA, l_reg, pa0, pa1, pa2, pa3); SBAR();
  pv_d0(o, vb0, pa0, pa1, pa2, pa3); partialSM(pB0, pB1, m_reg, mnB, alB);
  __syncthreads(); RESC(alB);
  finishSM(pB0, pB1, alB, l_reg, pa0, pa1, pa2, pa3); SBAR();
  pv_d0(o, vb0 + (int)SHM_V, pa0, pa1, pa2, pa3);
  if (hi == 0) li_l[r32] = l_reg; asm volatile("s_waitcnt lgkmcnt(0)" ::: "memory");
  float rli[16];
#pragma unroll
  for (int r = 0; r < 16; ++r) rli[r] = __builtin_amdgcn_rcpf(li_l[crow(r, hi)]);
  unsigned short* Ow = (unsigned short*)Ob + (long)(wid * QBLK) * LDO;
#pragma unroll
  for (int r = 0; r < 16; ++r) { int orow = crow(r, hi);
    for (int d0 = 0; d0 < 4; ++d0) Ow[(long)orow * LDO + d0 * 32 + r32] = (unsigned short)f2bf(o[d0][r] * rli[r]); }
  __syncthreads();
#undef SLOAD
#undef SWRITE
#undef SWAIT
#undef RESC
}

__device__ __forceinline__ void expA(f32x16& p, float negBC) {
  (void)negBC;
  for (int r = 0; r < 16; ++r) p[r] = __builtin_amdgcn_exp2f(p[r]);
}
__device__ __forceinline__ void finishFX(f32x16& p0, f32x16& p1, float negBC, float& l_reg, bf16x8& pa0, bf16x8& pa1, bf16x8& pa2, bf16x8& pa3) {
  expA(p1, negBC);
  float ps = 0; for (int r = 0; r < 16; ++r) ps += p0[r]; for (int r = 0; r < 16; ++r) ps += p1[r];
  l_reg += ps;
#define PK4(P, BASE, OUT) do { unsigned a0 = cvtpk(P[BASE + 0], P[BASE + 1]), a1 = cvtpk(P[BASE + 2], P[BASE + 3]);   \
    unsigned b0 = cvtpk(P[BASE + 4], P[BASE + 5]), b1 = cvtpk(P[BASE + 6], P[BASE + 7]);                              \
    auto r0 = __builtin_amdgcn_permlane32_swap(a0, b0, false, false); auto r1 = __builtin_amdgcn_permlane32_swap(a1, b1, false, false); \
    u32x4 w = {r0[0], r1[0], r0[1], r1[1]}; OUT = *reinterpret_cast<bf16x8*>(&w); } while (0)
  PK4(p0, 0, pa0); PK4(p0, 8, pa1); PK4(p1, 0, pa2); PK4(p1, 8, pa3);
#undef PK4
}
__device__ __forceinline__ void attn_dense_body_fx(const bf16* Qb, const bf16* __restrict__ Kh, const bf16* __restrict__ Vh, bf16* Ob, int seq, char* lds, float negBC, int wave_) {
  const int tid = tid_of(wave_), wid = tid >> 6, lane = tid & 63, r32 = lane & 31, hi = lane >> 5;
  bf16* V_lds = (bf16*)lds; bf16* K_lds = (bf16*)(lds + 2 * SHM_V);
  float* ws = (float*)(lds + 2 * SHM_V + 2 * SHM_K) + wid * 64; float* li_l = ws;
  float l_reg = 0; f32x16 o[4] = {}; bf16x8 qr[8];
  const bf16* Qw = Qb + (long)(wid * QBLK + r32) * LDQ + hi * 8;
#pragma unroll
  for (int d0 = 0; d0 < 8; ++d0) qr[d0] = *reinterpret_cast<const bf16x8*>(Qw + d0 * 16);
  const int sr = tid >> 4, sc = (tid & 15) * 8, vst0 = v_st(sr, sc), vst1 = v_st(32 + sr, sc);
  const int vb0 = (int)(uintptr_t)V_lds + v_rd_base(lane);
  struct { bf16x8 vs0, vs1, ks0, ks1; } sr_[2];
#define SLOAD(i, k0) do { sr_[i].vs0 = *(const bf16x8*)(&Vh[(long)((k0) + sr) * LDK + sc]); sr_[i].vs1 = *(const bf16x8*)(&Vh[(long)((k0) + 32 + sr) * LDK + sc]); \
    sr_[i].ks0 = *(const bf16x8*)(&Kh[(long)((k0) + sr) * LDK + sc]); sr_[i].ks1 = *(const bf16x8*)(&Kh[(long)((k0) + 32 + sr) * LDK + sc]); } while (0)
#define SWRITE(b, i) do { *(bf16x8*)((char*)V_lds + (b) * SHM_V + vst0) = sr_[i].vs0;          \
    *(bf16x8*)((char*)V_lds + (b) * SHM_V + vst1) = sr_[i].vs1; int kc = sc * 2;               \
    *(bf16x8*)((char*)K_lds + (b) * SHM_K + KSWZ(sr, kc)) = sr_[i].ks0;                       \
    *(bf16x8*)((char*)K_lds + (b) * SHM_K + KSWZ(32 + sr, kc)) = sr_[i].ks1; } while (0)
#define SWAIT() asm volatile("s_waitcnt vmcnt(4)" ::: "memory")
  f32x16 pA0, pA1, pB0, pB1; bf16x8 pa0, pa1, pa2, pa3; const int NT = seq / KVBLK;
  constexpr int SE = 0, SO = 1;
  SLOAD(SE, 0); asm volatile("s_waitcnt vmcnt(0)" ::: "memory"); SWRITE(0, SE); __syncthreads();
  qkt(pA0, pA1, K_lds, qr, r32, hi); expA(pA0, negBC);
  SLOAD(SO, KVBLK); if (2 < NT) SLOAD(SE, 2 * KVBLK);
  SWAIT(); SWRITE(1, SO); __syncthreads();
  for (int j = 1; j + 1 < NT; j += 2) {
    SBAR(); qkt(pB0, pB1, (bf16*)((char*)K_lds + SHM_K), qr, r32, hi);
    finishFX(pA0, pA1, negBC, l_reg, pa0, pa1, pa2, pa3); SBAR();
    SLOAD(SO, (j + 2) * KVBLK); SBAR();
    pv_d0(o, vb0, pa0, pa1, pa2, pa3); expA(pB0, negBC);
    __syncthreads(); SWAIT(); SWRITE(0, SE);
    __syncthreads();
    SBAR(); qkt(pA0, pA1, K_lds, qr, r32, hi);
    finishFX(pB0, pB1, negBC, l_reg, pa0, pa1, pa2, pa3); SBAR();
    if (j + 3 < NT) SLOAD(SE, (j + 3) * KVBLK); SBAR();
    pv_d0(o, vb0 + (int)SHM_V, pa0, pa1, pa2, pa3); expA(pA0, negBC);
    __syncthreads(); SWAIT(); SWRITE(1, SO);
    __syncthreads();
  }
  SBAR(); qkt(pB0, pB1, (bf16*)((char*)K_lds + SHM_K), qr, r32, hi);
  finishFX(pA0, pA1, negBC, l_reg, pa0, pa1, pa2, pa3); SBAR();
  pv_d0(o, vb0, pa0, pa1, pa2, pa3); expA(pB0, negBC);
  __syncthreads();
  finishFX(pB0, pB1, negBC, l_reg, pa0, pa1, pa2, pa3); SBAR();
  pv_d0(o, vb0 + (int)SHM_V, pa0, pa1, pa2, pa3);
  { auto rr = __builtin_amdgcn_permlane32_swap(__float_as_uint(l_reg), __float_as_uint(l_reg), false, false); l_reg = __uint_as_float(rr[0]) + __uint_as_float(rr[1]); }
  if (hi == 0) li_l[r32] = l_reg; asm volatile("s_waitcnt lgkmcnt(0)" ::: "memory");
  float rli[16];
#pragma unroll
  for (int r = 0; r < 16; ++r) rli[r] = __builtin_amdgcn_rcpf(li_l[crow(r, hi)]);
  unsigned short* Ow = (unsigned short*)Ob + (long)(wid * QBLK) * LDO;
#pragma unroll
  for (int r = 0; r < 16; ++r) { int orow = crow(r, hi);
    for (int d0 = 0; d0 < 4; ++d0) Ow[(long)orow * LDO + d0 * 32 + r32] = (unsigned short)f2bf(o[d0][r] * rli[r]); }
  __syncthreads();
#undef SLOAD
#undef SWRITE
#undef SWAIT
}

template <bool FX>
__device__ __forceinline__ void attn_body_dma(const bf16* Qb, const bf16* __restrict__ Kh, const bf16* __restrict__ Vh, bf16* Ob, int seq, LAS unsigned char* ldsl, char* lds, float negBC, int wave_) {
  const int tid = tid_of(wave_), wid = __builtin_amdgcn_readfirstlane(tid >> 6), lane = tid & 63, r32 = lane & 31, hi = lane >> 5;
  constexpr int KRING = 0, VRING = 3 * 16384, SCR = 6 * 16384;
  float* ws = (float*)(lds + SCR) + wid * 64; float* li_l = ws; float* al_l = ws + 32;
  float m_reg = -1e30f, l_reg = 0; f32x16 o[4] = {}; bf16x8 qr[8];
  const bf16* Qw = Qb + (long)(wid * QBLK + r32) * LDQ + hi * 8;
#pragma unroll
  for (int d0 = 0; d0 < 8; ++d0) qr[d0] = *reinterpret_cast<const bf16x8*>(Qw + d0 * 16);
  unsigned kso[2], vso[2];
#pragma unroll
  for (int i = 0; i < 2; ++i) { const int q = i * 512 + tid;
    { const int row = q >> 4, c = (q & 15) ^ (row & 15); kso[i] = (unsigned)(row * LDK + c * 8) * 2u; }
    { const int b = q * 16, sub = b >> 9, within = b & 511, kk = (sub >> 2) * 8 + (within >> 6), cin = (within >> 1) & 31, k = (kk & ~0xC) | ((kk & 4) << 1) | ((kk & 8) >> 1), c = (sub & 3) * 32 + cin; vso[i] = (unsigned)(k * LDK + c) * 2u; } }
  const int NT = seq / KVBLK;
  const unsigned ldsw = (unsigned)wid * 1024u, ldsbase = (unsigned)(uintptr_t)ldsl;
#define GLDS16(gsrc, ldsdst) do { unsigned keep_; asm volatile("s_mov_b32 %0, m0\n\ts_mov_b32 m0, %2\n\ts_nop 0\n\tglobal_load_lds_dwordx4 %1, off\n\ts_mov_b32 m0, %0" : "=&s"(keep_) : "v"(gsrc), "s"(ldsdst) : "memory"); } while (0)
#define ISSUE_K(t, slot) do { const int tt_ = (t) < NT ? (t) : NT - 1; const char* kb_ = (const char*)Kh + (long)tt_ * (KVBLK * LDK * 2); _Pragma("unroll") for (int i_ = 0; i_ < 2; ++i_) \
    GLDS16((const void*)(kb_ + kso[i_]), ldsbase + (unsigned)(KRING + (slot) * 16384 + i_ * 8192) + ldsw); } while (0)
#define ISSUE_V(t, slot) do { const int tt_ = (t) < NT ? (t) : NT - 1; const char* vb_ = (const char*)Vh + (long)tt_ * (KVBLK * LDK * 2); _Pragma("unroll") for (int i_ = 0; i_ < 2; ++i_) \
    GLDS16((const void*)(vb_ + vso[i_]), ldsbase + (unsigned)(VRING + (slot) * 16384 + i_ * 8192) + ldsw); } while (0)
#define WAITBAR(N) asm volatile("s_waitcnt vmcnt(" #N ") lgkmcnt(0)\n\ts_barrier" ::: "memory")
#define RESC(a) do { if (__any((a) < 1.f)) { if (hi == 0) al_l[r32] = (a); asm volatile("s_waitcnt lgkmcnt(0)" ::: "memory"); \
    for (int d = 0; d < 4; ++d) for (int r = 0; r < 16; ++r) o[d][r] *= al_l[crow(r, hi)]; } } while (0)
  const int vb0 = (int)(uintptr_t)(lds + VRING) + v_rd_base(lane);
  const char* Kl = lds + KRING;
  f32x16 pA0, pA1, pB0, pB1; float mnA = 0, mnB = 0, alA = 1.f, alB = 1.f; bf16x8 pa0, pa1, pa2, pa3;
  ISSUE_K(0, 0); ISSUE_K(1, 1); ISSUE_V(0, 0); ISSUE_K(2, 2); ISSUE_V(1, 1);
  WAITBAR(8);
  qkt(pA0, pA1, (const bf16*)Kl, qr, r32, hi);
  if (FX) expA(pA0, negBC); else partialSM(pA0, pA1, m_reg, mnA, alA);
  WAITBAR(4);
  int s0 = 0, s1 = 1, s2 = 2;
  for (int j = 0; j < NT; j += 2) {
    ISSUE_K(j + 3, s0); ISSUE_V(j + 2, s2);
    SBAR(); qkt(pB0, pB1, (const bf16*)(Kl + s1 * 16384), qr, r32, hi);
    if (FX) finishFX(pA0, pA1, negBC, l_reg, pa0, pa1, pa2, pa3); else finishSM(pA0, pA1, alA, l_reg, pa0, pa1, pa2, pa3);
    SBAR();
    pv_d0(o, vb0 + s0 * 16384, pa0, pa1, pa2, pa3);
    if (FX) expA(pB0, negBC); else { partialSM(pB0, pB1, m_reg, mnB, alB); RESC(alB); }
    WAITBAR(4);
    ISSUE_K(j + 4, s1); ISSUE_V(j + 3, s0);
    const bool more = (j + 2 < NT);
    SBAR(); if (more) qkt(pA0, pA1, (const bf16*)(Kl + s2 * 16384), qr, r32, hi);
    if (FX) finishFX(pB0, pB1, negBC, l_reg, pa0, pa1, pa2, pa3); else finishSM(pB0, pB1, alB, l_reg, pa0, pa1, pa2, pa3);
    SBAR();
    pv_d0(o, vb0 + s1 * 16384, pa0, pa1, pa2, pa3);
    if (more) { if (FX) expA(pA0, negBC); else { partialSM(pA0, pA1, m_reg, mnA, alA); RESC(alA); } }
    WAITBAR(4);
    { const int t0 = s0, t1 = s1; s0 = s2; s1 = t0; s2 = t1; }
  }
  asm volatile("s_waitcnt vmcnt(0)" ::: "memory");
  if (FX) { auto rr = __builtin_amdgcn_permlane32_swap(__float_as_uint(l_reg), __float_as_uint(l_reg), false, false); l_reg = __uint_as_float(rr[0]) + __uint_as_float(rr[1]); }
  if (hi == 0) li_l[r32] = l_reg; asm volatile("s_waitcnt lgkmcnt(0)" ::: "memory");
  float rli[16];
#pragma unroll
  for (int r = 0; r < 16; ++r) rli[r] = __builtin_amdgcn_rcpf(li_l[crow(r, hi)]);
  unsigned short* Ow = (unsigned short*)Ob + (long)(wid * QBLK) * LDO;
#pragma unroll
  for (int r = 0; r < 16; ++r) { int orow = crow(r, hi);
    for (int d0 = 0; d0 < 4; ++d0) Ow[(long)orow * LDO + d0 * 32 + r32] = (unsigned short)f2bf(o[d0][r] * rli[r]); }
  asm volatile("s_waitcnt lgkmcnt(0)\n\ts_barrier" ::: "memory");
#undef GLDS16
#undef ISSUE_K
#undef ISSUE_V
#undef WAITBAR
#undef RESC
}

__device__ __forceinline__ void pk4x(const f32x16& P, int BASE, bf16x8& OUT) {
  unsigned a0 = cvtpk(P[BASE + 0], P[BASE + 1]), a1 = cvtpk(P[BASE + 2], P[BASE + 3]), b0 = cvtpk(P[BASE + 4], P[BASE + 5]), b1 = cvtpk(P[BASE + 6], P[BASE + 7]);
  auto r0 = __builtin_amdgcn_permlane32_swap(a0, b0, false, false); auto r1 = __builtin_amdgcn_permlane32_swap(a1, b1, false, false);
  u32x4 w = {r0[0], r1[0], r0[1], r1[1]}; OUT = *reinterpret_cast<bf16x8*>(&w);
}
template <int D0, int KS0> __device__ __forceinline__ void pv_half(f32x16& od, int vb, bf16x8 pa, bf16x8 pb) {
  const s16x4 l0 = tr_read<v_rd_off(D0, KS0, 0)>(vb), h0 = tr_read<v_rd_off(D0, KS0, 1)>(vb), l1 = tr_read<v_rd_off(D0, KS0 + 1, 0)>(vb), h1 = tr_read<v_rd_off(D0, KS0 + 1, 1)>(vb);
  asm volatile("s_waitcnt lgkmcnt(0)" ::: "memory"); SBAR();
#define PK(L, H) (bf16x8){L[0], L[1], L[2], L[3], H[0], H[1], H[2], H[3]}
  od = __builtin_amdgcn_mfma_f32_32x32x16_bf16(pa, PK(l0, h0), od, 0, 0, 0);
  od = __builtin_amdgcn_mfma_f32_32x32x16_bf16(pb, PK(l1, h1), od, 0, 0, 0);
#undef PK
}
__device__ __forceinline__ void attn_body_v2(const bf16* Qb, const bf16* __restrict__ Kh, const bf16* __restrict__ Vh, bf16* Ob, int seq, char* lds, float negBC, int wave_) {
  const int tid = tid_of(wave_), wid = tid >> 6, lane = tid & 63, r32 = lane & 31, hi = lane >> 5;
  bf16* V_lds = (bf16*)lds; bf16* K_lds = (bf16*)(lds + 2 * SHM_V);
  float* ws = (float*)(lds + 2 * SHM_V + 2 * SHM_K) + wid * 64; float* li_l = ws;
  float l_reg = 0; f32x16 o[4] = {}; bf16x8 qr[8];
  const bf16* Qw = Qb + (long)(wid * QBLK + r32) * LDQ + hi * 8;
#pragma unroll
  for (int d0 = 0; d0 < 8; ++d0) qr[d0] = *reinterpret_cast<const bf16x8*>(Qw + d0 * 16);
  const int sr = tid >> 4, sc = (tid & 15) * 8, vst0 = v_st(sr, sc), vst1 = v_st(32 + sr, sc);
  const int vb0 = (int)(uintptr_t)V_lds + v_rd_base(lane);
  struct { bf16x8 vs0, vs1, ks0, ks1; } sr_[2];
#define SLOAD(i, k0) do { sr_[i].vs0 = *(const bf16x8*)(&Vh[(long)((k0) + sr) * LDK + sc]); sr_[i].vs1 = *(const bf16x8*)(&Vh[(long)((k0) + 32 + sr) * LDK + sc]); \
    sr_[i].ks0 = *(const bf16x8*)(&Kh[(long)((k0) + sr) * LDK + sc]); sr_[i].ks1 = *(const bf16x8*)(&Kh[(long)((k0) + 32 + sr) * LDK + sc]); } while (0)
#define SWRITE(b, i) do { *(bf16x8*)((char*)V_lds + (b) * SHM_V + vst0) = sr_[i].vs0;          \
    *(bf16x8*)((char*)V_lds + (b) * SHM_V + vst1) = sr_[i].vs1; int kc = sc * 2;               \
    *(bf16x8*)((char*)K_lds + (b) * SHM_K + KSWZ(sr, kc)) = sr_[i].ks0;                       \
    *(bf16x8*)((char*)K_lds + (b) * SHM_K + KSWZ(32 + sr, kc)) = sr_[i].ks1; } while (0)
  const int NT = seq / KVBLK;
  f32x16 p0, p1; bf16x8 pa0, pa1, pa2, pa3;
#define TRR(dst, D0, KS, H) asm volatile("ds_read_b64_tr_b16 %0, %1 offset:%2" : "=&v"(dst) : "v"(vb_), "i"((D0) * 512 + (KS) * 4096 + (H) * 2048) : "memory")
#define RD4(x, D0, KS0) do { TRR(x##0_, D0, KS0, 0); TRR(x##1_, D0, KS0, 1); TRR(x##2_, D0, (KS0) + 1, 0); TRR(x##3_, D0, (KS0) + 1, 1); } while (0)
#define WAITL(N) asm volatile("s_waitcnt lgkmcnt(" #N ")" ::: "memory")
#define PKV(L, H) (bf16x8){L[0], L[1], L[2], L[3], H[0], H[1], H[2], H[3]}
#define MM2(od, pa, pb, x) do { od = __builtin_amdgcn_mfma_f32_32x32x16_bf16(pa, PKV(x##0_, x##1_), od, 0, 0, 0); od = __builtin_amdgcn_mfma_f32_32x32x16_bf16(pb, PKV(x##2_, x##3_), od, 0, 0, 0); } while (0)
#define TILE_COMPUTE(b) do { \
    const bf16* Ks_ = (const bf16*)((const char*)K_lds + (b) * SHM_K); const int vb_ = vb0 + (b) * (int)SHM_V; \
    p0 = f32x16{}; p1 = f32x16{}; \
    _Pragma("unroll") for (int d0 = 0; d0 < 8; ++d0) { const int cb = (d0 * 16 + hi * 8) * 2; \
      const bf16x8 b0 = *reinterpret_cast<const bf16x8*>((const char*)Ks_ + KSWZ(r32, cb)); p0 = __builtin_amdgcn_mfma_f32_32x32x16_bf16(b0, qr[d0], p0, 0, 0, 0); } \
    _Pragma("unroll") for (int d0 = 0; d0 < 8; ++d0) { const int cb = (d0 * 16 + hi * 8) * 2; \
      const bf16x8 b1 = *reinterpret_cast<const bf16x8*>((const char*)Ks_ + KSWZ(32 + r32, cb)); p1 = __builtin_amdgcn_mfma_f32_32x32x16_bf16(b1, qr[d0], p1, 0, 0, 0); } \
    { s16x4 ra0_, ra1_, ra2_, ra3_, rb0_, rb1_, rb2_, rb3_; \
      RD4(ra, 0, 0); RD4(rb, 1, 0);                                         \
      expA(p0, negBC); { float ps = 0; for (int r = 0; r < 16; ++r) ps += p0[r]; l_reg += ps; } pk4x(p0, 0, pa0); pk4x(p0, 8, pa1); \
      WAITL(4); SBAR(); MM2(o[0], pa0, pa1, ra); RD4(ra, 2, 0); WAITL(4); SBAR(); MM2(o[1], pa0, pa1, rb); RD4(rb, 3, 0); \
      WAITL(4); SBAR(); MM2(o[2], pa0, pa1, ra); WAITL(0); SBAR(); MM2(o[3], pa0, pa1, rb); \
      RD4(ra, 0, 2); RD4(rb, 1, 2);                                         \
      expA(p1, negBC); { float ps = 0; for (int r = 0; r < 16; ++r) ps += p1[r]; l_reg += ps; } pk4x(p1, 0, pa2); pk4x(p1, 8, pa3); \
      WAITL(4); SBAR(); MM2(o[0], pa2, pa3, ra); RD4(ra, 2, 2); WAITL(4); SBAR(); MM2(o[1], pa2, pa3, rb); RD4(rb, 3, 2); \
      WAITL(4); SBAR(); MM2(o[2], pa2, pa3, ra); WAITL(0); SBAR(); MM2(o[3], pa2, pa3, rb); } \
  } while (0)
  SLOAD(0, 0); asm volatile("s_waitcnt vmcnt(0)" ::: "memory"); SWRITE(0, 0);
  SLOAD(1, KVBLK); if (2 < NT) SLOAD(0, 2 * KVBLK);
  for (int j = 0; j < NT; j += 2) {
    asm volatile("s_waitcnt lgkmcnt(0)\n\ts_barrier" ::: "memory");
    if (j + 2 < NT) asm volatile("s_waitcnt vmcnt(4)" ::: "memory"); else asm volatile("s_waitcnt vmcnt(0)" ::: "memory");
    SWRITE(1, 1);
    if (j + 3 < NT) SLOAD(1, (j + 3) * KVBLK);
    SBAR(); TILE_COMPUTE(0);
    asm volatile("s_waitcnt lgkmcnt(0)\n\ts_barrier" ::: "memory");
    if (j + 2 < NT) { if (j + 3 < NT) asm volatile("s_waitcnt vmcnt(4)" ::: "memory"); else asm volatile("s_waitcnt vmcnt(0)" ::: "memory"); SWRITE(0, 0); }
    if (j + 4 < NT) SLOAD(0, (j + 4) * KVBLK);
    SBAR(); TILE_COMPUTE(1);
  }
  { auto rr = __builtin_amdgcn_permlane32_swap(__float_as_uint(l_reg), __float_as_uint(l_reg), false, false); l_reg = __uint_as_float(rr[0]) + __uint_as_float(rr[1]); }
  const int lane2 = tid_of(wave_) & 63, r32e = lane2 & 31, hie = lane2 >> 5;
  if (hie == 0) li_l[r32e] = l_reg; asm volatile("s_waitcnt lgkmcnt(0)" ::: "memory");
  float rli[16];
#pragma unroll
  for (int r = 0; r < 16; ++r) rli[r] = __builtin_amdgcn_rcpf(li_l[crow(r, hie)]);
  unsigned short* Ow = (unsigned short*)Ob + (long)(wid * QBLK) * LDO;
#pragma unroll
  for (int r = 0; r < 16; ++r) { int orow = crow(r, hie);
    for (int d0 = 0; d0 < 4; ++d0) Ow[(long)orow * LDO + d0 * 32 + r32e] = (unsigned short)f2bf(o[d0][r] * rli[r]); }
  __syncthreads();
#undef SLOAD
#undef SWRITE
#undef TILE_COMPUTE
#undef TRR
#undef RD4
#undef WAITL
#undef PKV
#undef MM2
}

#define TILE_BODY(BUFK, BUFV, WB, WS, NXT) do { \
    KRD(kf0, 0, (0) * 8192 + BUFK); \
    KRD(kf1, 1, (0) * 8192 + BUFK); \
    KRD(kf2, 2, (0) * 8192 + BUFK); \
    KRD(kf3, 3, (0) * 8192 + BUFK); \
    KRD(kf4, 4, (0) * 8192 + BUFK); \
    KRD(kf5, 5, (0) * 8192 + BUFK); \
    WMFMA_Z(4, p0, kf0, qr[0]); \
    KRD(kf0, 6, (0) * 8192 + BUFK); \
    MFMA_A(p0, kf1, qr[1]); \
    KRD(kf1, 7, (0) * 8192 + BUFK); \
    DSW0(WB, WS); \
    WMFMA_A(5, p0, kf2, qr[2]); \
    KRD(kf2, 0, (1) * 8192 + BUFK); \
    MFMA_A(p0, kf3, qr[3]); \
    KRD(kf3, 1, (1) * 8192 + BUFK); \
    DSW1(WB, WS); \
    WMFMA_A(6, p0, kf4, qr[4]); \
    KRD(kf4, 2, (1) * 8192 + BUFK); \
    MFMA_A(p0, kf5, qr[5]); \
    KRD(kf5, 3, (1) * 8192 + BUFK); \
    DSW2(WB, WS); \
    WMFMA_A(7, p0, kf0, qr[6]); \
    KRD(kf0, 4, (1) * 8192 + BUFK); \
    MFMA_A(p0, kf1, qr[7]); \
    KRD(kf1, 5, (1) * 8192 + BUFK); \
    DSW3(WB, WS); \
    WMFMA_Z(7, p1, kf2, qr[0]); \
    KRD(kf2, 6, (1) * 8192 + BUFK); \
    SLOADN(WS, NXT); \
    MFMA_A(p1, kf3, qr[1]); \
    KRD(kf3, 7, (1) * 8192 + BUFK); \
    TIE(p0); \
    EXPN(p0, 0, 4); \
    WMFMA_A(6, p1, kf4, qr[2]); \
    TIE(p0); \
    EXPN(p0, 4, 4); \
    MFMA_A(p1, kf5, qr[3]); \
    TIE(p0); \
    SUM8(p0, 0); pk4x(p0, 0, pa0); \
    WMFMA_A(3, p1, kf0, qr[4]); \
    TIE3(p0, l2, pa0); \
    EXPN(p0, 8, 4); \
    TRR(ra0_, (0) * 512 + (0) * 4096 + (0) * 2048 + BUFV); \
    TRR(ra1_, (0) * 512 + (0) * 4096 + (1) * 2048 + BUFV); \
    TRR(ra2_, (0) * 512 + (1) * 4096 + (0) * 2048 + BUFV); \
    TRR(ra3_, (0) * 512 + (1) * 4096 + (1) * 2048 + BUFV); \
    MFMA_A(p1, kf1, qr[5]); \
    TIE(p0); \
    EXPN(p0, 12, 4); \
    TRR(rb0_, (1) * 512 + (0) * 4096 + (0) * 2048 + BUFV); \
    TRR(rb1_, (1) * 512 + (0) * 4096 + (1) * 2048 + BUFV); \
    TRR(rb2_, (1) * 512 + (1) * 4096 + (0) * 2048 + BUFV); \
    TRR(rb3_, (1) * 512 + (1) * 4096 + (1) * 2048 + BUFV); \
    WMFMA_A(8, p1, kf2, qr[6]); \
    TIE(p0); \
    SUM8(p0, 8); pk4x(p0, 8, pa1); \
    MFMA_A(p1, kf3, qr[7]); \
    TIE3(p0, l2, pa1); \
    WMM2(4, o[0], pa0, pa1, ra); \
    TRR(ra0_, (2) * 512 + (0) * 4096 + (0) * 2048 + BUFV); \
    TRR(ra1_, (2) * 512 + (0) * 4096 + (1) * 2048 + BUFV); \
    TRR(ra2_, (2) * 512 + (1) * 4096 + (0) * 2048 + BUFV); \
    TRR(ra3_, (2) * 512 + (1) * 4096 + (1) * 2048 + BUFV); \
    TIE(p1); \
    EXPN(p1, 0, 8); \
    WMM2(4, o[1], pa0, pa1, rb); \
    TRR(rb0_, (3) * 512 + (0) * 4096 + (0) * 2048 + BUFV); \
    TRR(rb1_, (3) * 512 + (0) * 4096 + (1) * 2048 + BUFV); \
    TRR(rb2_, (3) * 512 + (1) * 4096 + (0) * 2048 + BUFV); \
    TRR(rb3_, (3) * 512 + (1) * 4096 + (1) * 2048 + BUFV); \
    TIE(p1); \
    SUM8(p1, 0); pk4x(p1, 0, pa2); \
    WMM2(4, o[2], pa0, pa1, ra); \
    TRR(ra0_, (0) * 512 + (2) * 4096 + (0) * 2048 + BUFV); \
    TRR(ra1_, (0) * 512 + (2) * 4096 + (1) * 2048 + BUFV); \
    TRR(ra2_, (0) * 512 + (3) * 4096 + (0) * 2048 + BUFV); \
    TRR(ra3_, (0) * 512 + (3) * 4096 + (1) * 2048 + BUFV); \
    TIE3(p1, l2, pa2); \
    EXPN(p1, 8, 8); \
    WMM2(4, o[3], pa0, pa1, rb); \
    TRR(rb0_, (1) * 512 + (2) * 4096 + (0) * 2048 + BUFV); \
    TRR(rb1_, (1) * 512 + (2) * 4096 + (1) * 2048 + BUFV); \
    TRR(rb2_, (1) * 512 + (3) * 4096 + (0) * 2048 + BUFV); \
    TRR(rb3_, (1) * 512 + (3) * 4096 + (1) * 2048 + BUFV); \
    TIE(p1); \
    SUM8(p1, 8); pk4x(p1, 8, pa3); \
    TIE3(p1, l2, pa3); \
    WMM2(4, o[0], pa2, pa3, ra); \
    TRR(ra0_, (2) * 512 + (2) * 4096 + (0) * 2048 + BUFV); \
    TRR(ra1_, (2) * 512 + (2) * 4096 + (1) * 2048 + BUFV); \
    TRR(ra2_, (2) * 512 + (3) * 4096 + (0) * 2048 + BUFV); \
    TRR(ra3_, (2) * 512 + (3) * 4096 + (1) * 2048 + BUFV); \
    WMM2(4, o[1], pa2, pa3, rb); \
    TRR(rb0_, (3) * 512 + (2) * 4096 + (0) * 2048 + BUFV); \
    TRR(rb1_, (3) * 512 + (2) * 4096 + (1) * 2048 + BUFV); \
    TRR(rb2_, (3) * 512 + (3) * 4096 + (0) * 2048 + BUFV); \
    TRR(rb3_, (3) * 512 + (3) * 4096 + (1) * 2048 + BUFV); \
    WMM2(4, o[2], pa2, pa3, ra); \
    WMM2(0, o[3], pa2, pa3, rb); \
  } while (0)

__device__ __forceinline__ void attn_body_v3(const bf16* Qb, const bf16* __restrict__ Kh, const bf16* __restrict__ Vh, bf16* Ob, int seq, char* lds, int wave_) {
  const int tid = tid_of(wave_), wid = tid >> 6, lane = tid & 63, r32 = lane & 31, hi = lane >> 5;
  bf16* V_lds = (bf16*)lds; bf16* K_lds = (bf16*)(lds + 4 * SHM_V);
  float* ws = (float*)(lds + 133120) + wid * 64; float* li_l = ws;
  f32x2 l2 = {0.f, 0.f}; f32x16 o[4] = {}; bf16x8 qr[8];
  const bf16* Qw = Qb + (long)(wid * QBLK + r32) * LDQ + hi * 8;
#pragma unroll
  for (int d0 = 0; d0 < 8; ++d0) qr[d0] = *reinterpret_cast<const bf16x8*>(Qw + d0 * 16);
  asm volatile("s_waitcnt vmcnt(0)" : "+v"(qr[0]), "+v"(qr[1]), "+v"(qr[2]), "+v"(qr[3]), "+v"(qr[4]), "+v"(qr[5]), "+v"(qr[6]), "+v"(qr[7]));
  const int sr = tid >> 4, sc = (tid & 15) * 8, vst0 = v_st(sr, sc), vst1 = v_st(32 + sr, sc);
  const int vb_ = (int)(uintptr_t)V_lds + v_rd_base(lane);
  const int kbase_ = (int)(uintptr_t)K_lds + r32 * 256 + ((hi ^ (r32 & 1)) << 4), kt_ = (r32 & 15) >> 1;
  const int kaddr0 = kbase_ + ((0 ^ kt_) << 5), kaddr1 = kbase_ + ((1 ^ kt_) << 5), kaddr2 = kbase_ + ((2 ^ kt_) << 5), kaddr3 = kbase_ + ((3 ^ kt_) << 5),
            kaddr4 = kbase_ + ((4 ^ kt_) << 5), kaddr5 = kbase_ + ((5 ^ kt_) << 5), kaddr6 = kbase_ + ((6 ^ kt_) << 5), kaddr7 = kbase_ + ((7 ^ kt_) << 5);
  const int vwa0 = (int)(uintptr_t)V_lds + vst0, vwa1 = (int)(uintptr_t)V_lds + vst1, kwa0 = (int)(uintptr_t)K_lds + KSWZ(sr, sc * 2), kwa1 = (int)(uintptr_t)K_lds + KSWZ(32 + sr, sc * 2);
  const unsigned goff0 = (unsigned)(sr * LDK + sc) * 2u, goff1 = goff0 + 32u * LDK * 2u;
  struct { bf16x8 vs0, vs1, ks0, ks1; } sr_[2];
#define GLD16S(dst, voff, sbase) asm volatile("global_load_dwordx4 %0, %1, %2" : "=&v"(dst) : "v"(voff), "s"(sbase) : "memory")
#define SLOAD(i, k0) do { const char* vb__ = (const char*)Vh + (long)(k0) * (LDK * 2); const char* kb__ = (const char*)Kh + (long)(k0) * (LDK * 2); \
    GLD16S(sr_[i].vs0, goff0, vb__); GLD16S(sr_[i].vs1, goff1, vb__); GLD16S(sr_[i].ks0, goff0, kb__); GLD16S(sr_[i].ks1, goff1, kb__); } while (0)
#define SLOADP(i) do { GLD16S(sr_[i].vs0, goff0, vnext_); GLD16S(sr_[i].vs1, goff1, vnext_); GLD16S(sr_[i].ks0, goff0, knext_); GLD16S(sr_[i].ks1, goff1, knext_); \
    vnext_ += KVBLK * LDK * 2; knext_ += KVBLK * LDK * 2; } while (0)
#define SWRITE(b, i) do { *(bf16x8*)((char*)V_lds + (b) * SHM_V + vst0) = sr_[i].vs0;          \
    *(bf16x8*)((char*)V_lds + (b) * SHM_V + vst1) = sr_[i].vs1; int kc = sc * 2;               \
    *(bf16x8*)((char*)K_lds + (b) * SHM_K + KSWZ(sr, kc)) = sr_[i].ks0;                       \
    *(bf16x8*)((char*)K_lds + (b) * SHM_K + KSWZ(32 + sr, kc)) = sr_[i].ks1; } while (0)
#define DSW0(WB, WS) asm volatile("s_waitcnt vmcnt(4)\n\tds_write_b128 %0, %1 offset:%2" :: "v"(vwa0), "v"(sr_[WS].vs0), "i"(WB) : "memory")
#define DSW1(WB, WS) asm volatile("ds_write_b128 %0, %1 offset:%2" :: "v"(vwa1), "v"(sr_[WS].vs1), "i"(WB) : "memory")
#define DSW2(WB, WS) asm volatile("ds_write_b128 %0, %1 offset:%2" :: "v"(kwa0), "v"(sr_[WS].ks0), "i"(WB) : "memory")
#define DSW3(WB, WS) asm volatile("ds_write_b128 %0, %1 offset:%2" :: "v"(kwa1), "v"(sr_[WS].ks1), "i"(WB) : "memory")
#define SLOADN(WS, T) SLOADP(WS)
#define KRD(dst, bq, imm) asm volatile("ds_read_b128 %0, %1 offset:%2" : "=&v"(dst) : "v"(kaddr##bq), "i"(imm) : "memory")
#define TRR(dst, imm) asm volatile("ds_read_b64_tr_b16 %0, %1 offset:%2" : "=&v"(dst) : "v"(vb_), "i"(imm) : "memory")
#define WAITL(N) asm volatile("s_waitcnt lgkmcnt(" #N ")" ::: "memory")
#define PKV(L, H) (bf16x8){L[0], L[1], L[2], L[3], H[0], H[1], H[2], H[3]}
#define MFMA_Z(acc, a, b) asm volatile("v_mfma_f32_32x32x16_bf16 %0, %1, %2, 0" : "=&v"(acc) : "v"(a), "v"(b))
#define MFMA_A(acc, a, b) asm volatile("v_mfma_f32_32x32x16_bf16 %0, %1, %2, %0" : "+v"(acc) : "v"(a), "v"(b))
#define WMFMA_Z(n, acc, a, b) asm volatile("s_waitcnt lgkmcnt(" #n ")\n\tv_mfma_f32_32x32x16_bf16 %0, %1, %2, 0" : "=&v"(acc) : "v"(a), "v"(b) : "memory")
#define WMFMA_A(n, acc, a, b) asm volatile("s_waitcnt lgkmcnt(" #n ")\n\tv_mfma_f32_32x32x16_bf16 %0, %1, %2, %0" : "+v"(acc) : "v"(a), "v"(b) : "memory")
#define WMM2(n, od, pa, pb, x) do { asm volatile("s_waitcnt lgkmcnt(" #n ")\n\tv_mfma_f32_32x32x16_bf16 %0, %1, %2, %0" : "+v"(od) : "v"(pa), "v"(PKV(x##0_, x##1_)) : "memory"); \
    asm volatile("v_mfma_f32_32x32x16_bf16 %0, %1, %2, %0" : "+v"(od) : "v"(pb), "v"(PKV(x##2_, x##3_))); } while (0)
#define TIE(p) asm volatile("" : "+v"(p))
#define TIE3(p, a, b) asm volatile("" : "+v"(p), "+v"(a), "+v"(b))
#define MM2(od, pa, pb, x) do { asm volatile("s_nop 1\n\tv_mfma_f32_32x32x16_bf16 %0, %1, %2, %0" : "+v"(od) : "v"(pa), "v"(PKV(x##0_, x##1_))); \
    asm volatile("v_mfma_f32_32x32x16_bf16 %0, %1, %2, %0" : "+v"(od) : "v"(pb), "v"(PKV(x##2_, x##3_))); } while (0)
#define EXPN(p, lo, n) do { _Pragma("unroll") for (int r_ = (lo); r_ < (lo) + (n); ++r_) p[r_] = __builtin_amdgcn_exp2f(p[r_]); } while (0)
#define SUM8(p, lo) do { _Pragma("unroll") for (int r_ = (lo); r_ < (lo) + 8; r_ += 2) l2 += (f32x2){p[r_], p[r_ + 1]}; } while (0)
  const int NT = seq / KVBLK;
  f32x16 p0, p1; bf16x8 pa0, pa1, pa2, pa3, kf0, kf1, kf2, kf3, kf4, kf5; s16x4 ra0_, ra1_, ra2_, ra3_, rb0_, rb1_, rb2_, rb3_;
  SLOAD(0, 0); SLOAD(1, KVBLK); asm volatile("s_waitcnt vmcnt(0)" ::: "memory"); SWRITE(0, 0); SWRITE(1, 1);
  const char* vnext_ = (const char*)Vh + 2L * KVBLK * LDK * 2; const char* knext_ = (const char*)Kh + 2L * KVBLK * LDK * 2;
  SLOADN(0, 2); SLOADN(1, 3);
  for (int j = 0; j < NT; j += 4) {
    asm volatile("s_waitcnt lgkmcnt(0)\n\ts_barrier" ::: "memory");
    TILE_BODY(0, 0, 32768, 0, j + 4);
    TILE_BODY(16384, 16384, 49152, 1, j + 5);
    asm volatile("s_waitcnt lgkmcnt(0)\n\ts_barrier" ::: "memory");
    TILE_BODY(32768, 32768, 0, 0, j + 6);
    TILE_BODY(49152, 49152, 16384, 1, j + 7);
  }
  asm volatile("s_nop 15\n\ts_nop 15" : "+v"(o[0]), "+v"(o[1]), "+v"(o[2]), "+v"(o[3]));
  float l_reg = l2.x + l2.y;
  { auto rr = __builtin_amdgcn_permlane32_swap(__float_as_uint(l_reg), __float_as_uint(l_reg), false, false); l_reg = __uint_as_float(rr[0]) + __uint_as_float(rr[1]); }
  const int lane2 = tid_of(wave_) & 63, r32e = lane2 & 31, hie = lane2 >> 5;
  if (hie == 0) li_l[r32e] = l_reg; asm volatile("s_waitcnt lgkmcnt(0)" ::: "memory");
  float rli[16];
#pragma unroll
  for (int r = 0; r < 16; ++r) rli[r] = __builtin_amdgcn_rcpf(li_l[crow(r, hie)]);
  unsigned short* Ow = (unsigned short*)Ob + (long)(wid * QBLK) * LDO;
#pragma unroll
  for (int r = 0; r < 16; ++r) { int orow = crow(r, hie);
    for (int d0 = 0; d0 < 4; ++d0) Ow[(long)orow * LDO + d0 * 32 + r32e] = (unsigned short)f2bf(o[d0][r] * rli[r]); }
  __syncthreads();
#undef SLOAD
#undef SLOADP
#undef GLD16S
#undef SWRITE
#undef DSW0
#undef DSW1
#undef DSW2
#undef DSW3
#undef SLOADN
#undef KRD
#undef TRR
#undef WAITL
#undef PKV
#undef MM2
#undef EXPN
#undef SUM8
#undef MFMA_Z
#undef MFMA_A
#undef WMFMA_Z
#undef WMFMA_A
#undef WMM2
#undef TIE
#undef TIE3
}
#undef TILE_BODY

#define TILE_BODY(BUFK, BUFV, WB, WS, NXT) do { \
    KRD(kf0, 0, (0) * 8192 + BUFK); \
    KRD(kf1, 1, (0) * 8192 + BUFK); \
    KRD(kf2, 2, (0) * 8192 + BUFK); \
    KRD(kf3, 3, (0) * 8192 + BUFK); \
    KRD(kf4, 4, (0) * 8192 + BUFK); \
    KRD(kf5, 5, (0) * 8192 + BUFK); \
    WMFMA_Z_KR(4, p0, kf0, qr[0], kf0, 6, (0) * 8192 + BUFK); \
    MFMA_A_KR(p0, kf1, qr[1], kf1, 7, (0) * 8192 + BUFK); \
    DSWK0(WB, WS); \
    WMFMA_A_KR(5, p0, kf2, qr[2], kf2, 0, (1) * 8192 + BUFK); \
    DSWK1(WB, WS); \
    MFMA_A_KR(p0, kf3, qr[3], kf3, 1, (1) * 8192 + BUFK); \
    DSWV0(WB, WS); \
    WMFMA_A_KR(7, p0, kf4, qr[4], kf4, 2, (1) * 8192 + BUFK); \
    DSWV1(WB, WS); \
    MFMA_A_KR(p0, kf5, qr[5], kf5, 3, (1) * 8192 + BUFK); \
    DSWV2(WB, WS); \
    WMFMA_A_KR(9, p0, kf0, qr[6], kf0, 4, (1) * 8192 + BUFK); \
    DSWV3(WB, WS); \
    MFMA_A_KR(p0, kf1, qr[7], kf1, 5, (1) * 8192 + BUFK); \
    WMFMA_Z_KR(8, p1, kf2, qr[0], kf2, 6, (1) * 8192 + BUFK); \
    SLOADN(WS, NXT); \
    MFMA_A_KR(p1, kf3, qr[1], kf3, 7, (1) * 8192 + BUFK); \
    TIE(p0); \
    EXPN(p0, 0, 4); \
    WMFMA_A(6, p1, kf4, qr[2]); \
    TIE(p0); \
    EXPN(p0, 4, 4); \
    MFMA_A(p1, kf5, qr[3]); \
    TIE(p0); \
    SUM8(p0, 0); PACK8(p0, 0, pb0); \
    WMFMA_A(2, p1, kf0, qr[4]); \
    TIE3(p0, l2, pb0); \
    EXPN(p0, 8, 4); \
    VRD(ra0_, 0, (0) * 4096 + BUFV); \
    VRD(ra1_, 1, (0) * 4096 + BUFV); \
    MFMA_A(p1, kf1, qr[5]); \
    TIE(p0); \
    EXPN(p0, 12, 4); \
    VRD(rb0_, 0, (1) * 4096 + BUFV); \
    VRD(rb1_, 1, (1) * 4096 + BUFV); \
    WMFMA_A(4, p1, kf2, qr[6]); \
    TIE(p0); \
    SUM8(p0, 8); PACK8(p0, 8, pb1); \
    MFMA_A(p1, kf3, qr[7]); \
    TIE3(p0, l2, pb1); \
    WMM2T(2, ot[0], ra, pb0, pb1); \
    VRD(ra0_, 0, (2) * 4096 + BUFV); \
    VRD(ra1_, 1, (2) * 4096 + BUFV); \
    TIE(p1); \
    EXPN(p1, 0, 8); \
    WMM2T(2, ot[1], rb, pb0, pb1); \
    VRD(rb0_, 0, (3) * 4096 + BUFV); \
    VRD(rb1_, 1, (3) * 4096 + BUFV); \
    TIE(p1); \
    SUM8(p1, 0); PACK8(p1, 0, pb2); \
    WMM2T(2, ot[2], ra, pb0, pb1); \
    VRD(ra0_, 2, (0) * 4096 + BUFV); \
    VRD(ra1_, 3, (0) * 4096 + BUFV); \
    TIE3(p1, l2, pb2); \
    EXPN(p1, 8, 8); \
    WMM2T(2, ot[3], rb, pb0, pb1); \
    VRD(rb0_, 2, (1) * 4096 + BUFV); \
    VRD(rb1_, 3, (1) * 4096 + BUFV); \
    TIE(p1); \
    SUM8(p1, 8); PACK8(p1, 8, pb3); \
    TIE3(p1, l2, pb3); \
    WMM2T(2, ot[0], ra, pb2, pb3); \
    VRD(ra0_, 2, (2) * 4096 + BUFV); \
    VRD(ra1_, 3, (2) * 4096 + BUFV); \
    WMM2T(2, ot[1], rb, pb2, pb3); \
    VRD(rb0_, 2, (3) * 4096 + BUFV); \
    VRD(rb1_, 3, (3) * 4096 + BUFV); \
    WMM2T(2, ot[2], ra, pb2, pb3); \
    WMM2T(0, ot[3], rb, pb2, pb3); \
  } while (0)

__device__ __forceinline__ void attn_body_v4(const bf16* Qb, const bf16* __restrict__ Kh, const bf16* __restrict__ Vth, bf16* Ob, int seq, char* lds, int wave_, const float* qg, const float* rope, int tok0) {
  constexpr int VTLD = MR;
  const int tid = tid_of(wave_), wid = tid >> 6, lane = tid & 63, r32 = lane & 31, hi = lane >> 5;
  bf16* V_lds = (bf16*)lds; bf16* K_lds = (bf16*)(lds + 4 * SHM_V);
  f32x2 l2 = {0.f, 0.f}; f32x16 ot[4] = {}; bf16x8 qr[8];
  const bf16* Qw = Qb + (long)(wid * QBLK + r32) * LDQ + hi * 8;
#pragma unroll
  for (int d0 = 0; d0 < 8; ++d0) qr[d0] = *reinterpret_cast<const bf16x8*>(Qw + d0 * 16);
  q_prologue(qr, qg, rope, tok0 < 0 ? -1 : tok0 + wid * QBLK + r32, hi);
  asm volatile("s_waitcnt vmcnt(0)" : "+v"(qr[0]), "+v"(qr[1]), "+v"(qr[2]), "+v"(qr[3]), "+v"(qr[4]), "+v"(qr[5]), "+v"(qr[6]), "+v"(qr[7]));
  const int sr = tid >> 4, sc = (tid & 15) * 8;
  const int kbase_ = (int)(uintptr_t)K_lds + r32 * 256 + ((hi ^ (r32 & 1)) << 4), kt_ = (r32 & 15) >> 1;
  const int kaddr0 = kbase_ + ((0 ^ kt_) << 5), kaddr1 = kbase_ + ((1 ^ kt_) << 5), kaddr2 = kbase_ + ((2 ^ kt_) << 5), kaddr3 = kbase_ + ((3 ^ kt_) << 5),
            kaddr4 = kbase_ + ((4 ^ kt_) << 5), kaddr5 = kbase_ + ((5 ^ kt_) << 5), kaddr6 = kbase_ + ((6 ^ kt_) << 5), kaddr7 = kbase_ + ((7 ^ kt_) << 5);
  const int vbase_ = (int)(uintptr_t)V_lds + r32 * 128, vt_ = (r32 >> 1) & 7;
  const int vaddr0 = vbase_ + (((0 + hi) ^ vt_) << 4), vaddr1 = vbase_ + (((2 + hi) ^ vt_) << 4), vaddr2 = vbase_ + (((4 + hi) ^ vt_) << 4), vaddr3 = vbase_ + (((6 + hi) ^ vt_) << 4);
  const int kwa0 = (int)(uintptr_t)K_lds + KSWZ(sr, sc * 2), kwa1 = (int)(uintptr_t)K_lds + KSWZ(32 + sr, sc * 2);
  const unsigned goff0 = (unsigned)(sr * LDK + sc) * 2u, goff1 = goff0 + 32u * LDK * 2u;
  const int vd0_ = tid >> 3, vd1_ = 64 + (tid >> 3), vcs_ = tid & 7, vg_ = vcs_ >> 1, ve_ = vcs_ & 1;
  const unsigned goffv0 = (unsigned)(vd0_ * VTLD + vcs_ * 8) * 2u, goffv1 = (unsigned)(vd1_ * VTLD + vcs_ * 8) * 2u;
  const int vwl0 = (int)(uintptr_t)V_lds + vd0_ * 128 + (((2 * vg_) ^ ((vd0_ >> 1) & 7)) << 4) + 8 * ve_, vwh0 = (int)(uintptr_t)V_lds + vd0_ * 128 + (((2 * vg_ + 1) ^ ((vd0_ >> 1) & 7)) << 4) + 8 * ve_;
  const int vwl1 = (int)(uintptr_t)V_lds + vd1_ * 128 + (((2 * vg_) ^ ((vd1_ >> 1) & 7)) << 4) + 8 * ve_, vwh1 = (int)(uintptr_t)V_lds + vd1_ * 128 + (((2 * vg_ + 1) ^ ((vd1_ >> 1) & 7)) << 4) + 8 * ve_;
  struct { bf16x8 vs0, vs1, ks0, ks1; } sr_[2];
#define GLD16S(dst, voff, sbase) asm volatile("global_load_dwordx4 %0, %1, %2" : "=&v"(dst) : "v"(voff), "s"(sbase) : "memory")
#define SLOADP(i) do { GLD16S(sr_[i].vs0, goffv0, vnext_); GLD16S(sr_[i].vs1, goffv1, vnext_); GLD16S(sr_[i].ks0, goff0, knext_); GLD16S(sr_[i].ks1, goff1, knext_); \
    vnext_ += KVBLK * 2; knext_ += KVBLK * LDK * 2; } while (0)
#define SLOADN(WS, T) SLOADP(WS)
#define LO4(x) __builtin_shufflevector(x, x, 0, 1, 2, 3)
#define HI4(x) __builtin_shufflevector(x, x, 4, 5, 6, 7)
#define DSWK0(WB, WS) asm volatile("s_waitcnt vmcnt(4)\n\tds_write_b128 %0, %1 offset:%2" :: "v"(kwa0), "v"(sr_[WS].ks0), "i"(WB) : "memory")
#define DSWK1(WB, WS) asm volatile("ds_write_b128 %0, %1 offset:%2" :: "v"(kwa1), "v"(sr_[WS].ks1), "i"(WB) : "memory")
#define DSWV0(WB, WS) asm volatile("ds_write_b64 %0, %1 offset:%2" :: "v"(vwl0), "v"(LO4(sr_[WS].vs0)), "i"(WB) : "memory")
#define DSWV1(WB, WS) asm volatile("ds_write_b64 %0, %1 offset:%2" :: "v"(vwh0), "v"(HI4(sr_[WS].vs0)), "i"(WB) : "memory")
#define DSWV2(WB, WS) asm volatile("ds_write_b64 %0, %1 offset:%2" :: "v"(vwl1), "v"(LO4(sr_[WS].vs1)), "i"(WB) : "memory")
#define DSWV3(WB, WS) asm volatile("ds_write_b64 %0, %1 offset:%2" :: "v"(vwh1), "v"(HI4(sr_[WS].vs1)), "i"(WB) : "memory")
#define DSWALL(WB, WS) do { DSWK0(WB, WS); DSWK1(WB, WS); DSWV0(WB, WS); DSWV1(WB, WS); DSWV2(WB, WS); DSWV3(WB, WS); } while (0)
#define KRD(dst, bq, imm) asm volatile("ds_read_b128 %0, %1 offset:%2" : "=&v"(dst) : "v"(kaddr##bq), "i"(imm) : "memory")
#define VRD(dst, ks, imm) asm volatile("ds_read_b128 %0, %1 offset:%2" : "=&v"(dst) : "v"(vaddr##ks), "i"(imm) : "memory")
#define MFMA_A(acc, a, b) asm volatile("v_mfma_f32_32x32x16_bf16 %0, %1, %2, %0" : "+v"(acc) : "v"(a), "v"(b))
#define WMFMA_Z(n, acc, a, b) asm volatile("s_waitcnt lgkmcnt(" #n ")\n\tv_mfma_f32_32x32x16_bf16 %0, %1, %2, 0" : "=&v"(acc) : "v"(a), "v"(b) : "memory")
#define WMFMA_A(n, acc, a, b) asm volatile("s_waitcnt lgkmcnt(" #n ")\n\tv_mfma_f32_32x32x16_bf16 %0, %1, %2, %0" : "+v"(acc) : "v"(a), "v"(b) : "memory")
#define WMFMA_Z_KR(n, acc, a, b, kfn, bq, imm) asm volatile("s_waitcnt lgkmcnt(" #n ")\n\tv_mfma_f32_32x32x16_bf16 %0, %2, %3, 0\n\tds_read_b128 %1, %4 offset:%5" : "=&v"(acc), "=&v"(kfn) : "v"(a), "v"(b), "v"(kaddr##bq), "i"(imm) : "memory")
#define WMFMA_A_KR(n, acc, a, b, kfn, bq, imm) asm volatile("s_waitcnt lgkmcnt(" #n ")\n\tv_mfma_f32_32x32x16_bf16 %0, %2, %3, %0\n\tds_read_b128 %1, %4 offset:%5" : "+v"(acc), "=&v"(kfn) : "v"(a), "v"(b), "v"(kaddr##bq), "i"(imm) : "memory")
#define MFMA_A_KR(acc, a, b, kfn, bq, imm) asm volatile("v_mfma_f32_32x32x16_bf16 %0, %2, %3, %0\n\tds_read_b128 %1, %4 offset:%5" : "+v"(acc), "=&v"(kfn) : "v"(a), "v"(b), "v"(kaddr##bq), "i"(imm) : "memory")
#define WMM2T(n, od, x, pa, pb) asm volatile("s_waitcnt lgkmcnt(" #n ")\n\tv_mfma_f32_32x32x16_bf16 %0, %1, %2, %0\n\tv_mfma_f32_32x32x16_bf16 %0, %3, %4, %0" : "+v"(od) : "v"(x##0_), "v"(pa), "v"(x##1_), "v"(pb) : "memory")
#define TIE(p) asm volatile("" : "+v"(p))
#define TIE3(p, a, b) asm volatile("" : "+v"(p), "+v"(a), "+v"(b))
#define EXPN(p, lo, n) do { _Pragma("unroll") for (int r_ = (lo); r_ < (lo) + (n); ++r_) p[r_] = __builtin_amdgcn_exp2f(p[r_]); } while (0)
#define SUM8(p, lo) do { _Pragma("unroll") for (int r_ = (lo); r_ < (lo) + 8; r_ += 2) l2 += (f32x2){p[r_], p[r_ + 1]}; } while (0)
#define PACK8(P, BASE, OUT) do { u32x4 w_ = {cvtpk(P[(BASE) + 0], P[(BASE) + 1]), cvtpk(P[(BASE) + 2], P[(BASE) + 3]), cvtpk(P[(BASE) + 4], P[(BASE) + 5]), cvtpk(P[(BASE) + 6], P[(BASE) + 7])}; OUT = *reinterpret_cast<bf16x8*>(&w_); } while (0)
  const int NT = seq / KVBLK;
  f32x16 p0, p1; bf16x8 pb0, pb1, pb2, pb3, kf0, kf1, kf2, kf3, kf4, kf5, ra0_, ra1_, rb0_, rb1_;
  const char* vnext_ = (const char*)Vth; const char* knext_ = (const char*)Kh;
  SLOADP(0); SLOADP(1); asm volatile("s_waitcnt vmcnt(0)" ::: "memory"); DSWALL(0, 0); DSWALL(16384, 1);
  SLOADP(0); SLOADP(1);
  for (int j = 0; j < NT; j += 4) {
    asm volatile("s_waitcnt lgkmcnt(0)\n\ts_barrier" ::: "memory");
    TILE_BODY(0, 0, 32768, 0, j + 4);
    TILE_BODY(16384, 16384, 49152, 1, j + 5);
    asm volatile("s_waitcnt lgkmcnt(0)\n\ts_barrier" ::: "memory");
    TILE_BODY(32768, 32768, 0, 0, j + 6);
    TILE_BODY(49152, 49152, 16384, 1, j + 7);
  }
  asm volatile("s_waitcnt vmcnt(0)" : "+v"(sr_[0].vs0), "+v"(sr_[0].vs1), "+v"(sr_[0].ks0), "+v"(sr_[0].ks1), "+v"(sr_[1].vs0), "+v"(sr_[1].vs1), "+v"(sr_[1].ks0), "+v"(sr_[1].ks1));
  asm volatile("s_nop 15\n\ts_nop 15" : "+v"(ot[0]), "+v"(ot[1]), "+v"(ot[2]), "+v"(ot[3]));
  float l_reg = l2.x + l2.y;
  { auto rr = __builtin_amdgcn_permlane32_swap(__float_as_uint(l_reg), __float_as_uint(l_reg), false, false); l_reg = __uint_as_float(rr[0]) + __uint_as_float(rr[1]); }
  const float rl = __builtin_amdgcn_rcpf(l_reg);
  const int lane2 = tid_of(wave_) & 63, r32e = lane2 & 31, hie = lane2 >> 5;
  unsigned short* Ow = (unsigned short*)Ob + (long)(wid * QBLK + r32e) * LDO + 4 * hie;
#pragma unroll
  for (int D0 = 0; D0 < 4; ++D0)
#pragma unroll
    for (int g4 = 0; g4 < 4; ++g4) { u32x2 w; w.x = cvtpk(ot[D0][4 * g4 + 0] * rl, ot[D0][4 * g4 + 1] * rl); w.y = cvtpk(ot[D0][4 * g4 + 2] * rl, ot[D0][4 * g4 + 3] * rl);
      *(u32x2*)(Ow + D0 * 32 + 8 * g4) = w; }
  __syncthreads();
#undef GLD16S
#undef SLOADP
#undef SLOADN
#undef LO4
#undef HI4
#undef DSWK0
#undef DSWK1
#undef DSWV0
#undef DSWV1
#undef DSWV2
#undef DSWV3
#undef DSWALL
#undef KRD
#undef VRD
#undef MFMA_A
#undef WMFMA_Z
#undef WMFMA_A
#undef WMFMA_Z_KR
#undef WMFMA_A_KR
#undef MFMA_A_KR
#undef WMM2T
#undef TIE
#undef TIE3
#undef EXPN
#undef SUM8
#undef PACK8
}
#undef TILE_BODY
}

#ifdef ATT_DMA
#define ATT_FAST attn_body_dma<true>
#define ATT_FAST_ARGS F.lds, (char*)lds,
#elif defined(ATT_FX1)
#define ATT_FAST attn_dense_body_fx
#define ATT_FAST_ARGS (char*)lds,
#elif defined(ATT_V2)
#define ATT_FAST attn_body_v2
#define ATT_FAST_ARGS (char*)lds,
#else
#define ATT_V3 1
#endif
struct Args { const float* in[23]; float* out; unsigned char* ws; int ph_lo, ph_hi; };

struct Frame {
    LAS unsigned char* lds; unsigned char* ldsg;
    gu32* ctl; unsigned char* ws;
    int tid, lane, wave, vcu, G, gw, NGW;
};
__device__ __forceinline__ Frame opaque(const Frame& F0) { Frame F = F0; const int t = tid_of(F0.wave); F.tid = t; F.lane = t & 63; return F; }

__device__ __forceinline__ void p0_transpose_item(const float* W, int N, bf16_t* WT, int ldt, int drow0, int k0, int n0, LAS float* scr, int lane) {
#pragma unroll 8
    for (int i = 0; i < 32; ++i) { const int kk = 2 * i + (lane >> 5); scr[kk * 33 + (lane & 31)] = W[(size_t)(k0 + kk) * N + n0 + (lane & 31)]; }
    LDS_WAIT(); asm volatile("" ::: "memory");
    const int c = lane & 7;
#pragma unroll
    for (int j = 0; j < 4; ++j) { const int n = (lane >> 3) + 8 * j; const LAS float* s = scr + (8 * c) * 33 + n;
        u32x4 o; o.x = pk2(s[0 * 33], s[1 * 33]); o.y = pk2(s[2 * 33], s[3 * 33]); o.z = pk2(s[4 * 33], s[5 * 33]); o.w = pk2(s[6 * 33], s[7 * 33]);
        *(GAS u32x4*)(WT + (size_t)(drow0 + n) * ldt + k0 + 8 * c) = o; }
    LDS_WAIT(); asm volatile("" ::: "memory");
}
__device__ __forceinline__ void p0_convert(Frame& F, const float* W, int K, int N, bf16_t* WT, int mode, int& rot) {
    LAS float* scr = (LAS float*)(F.lds + F.wave * 16384);
    const int nblk = N / 32, nitems = (K / 64) * nblk;
    int it0 = F.gw - rot; if (it0 < 0) it0 += F.NGW;
    rot = (rot + nitems) % F.NGW;
    for (int it = it0; it < nitems; it += F.NGW) { const int kb = it / nblk, nb = it % nblk, n0 = nb * 32;
        const int drow0 = mode == 0 ? n0 : ((n0 >> 7) * 256 + (n0 & 127) + (mode == 2 ? 128 : 0));
        p0_transpose_item(W, N, WT, K, drow0, kb * 64, n0, scr, F.lane); }
}
__device__ __forceinline__ float siluf_(float x) { return x / (1.0f + __expf(-x)); }

__device__ __forceinline__ void p0_prologue(const Frame& F0, const Args& A) {
    Frame F = opaque(F0);
    unsigned char* ws = F.ws;
    if (F.gw < 1536) {
        const int task = F.gw, l = task / 768, rem = task % 768, chunk = rem / 16, slab = rem % 16;
        const float* w = A.in[4] + (size_t)l * DM * 12288 + chunk * 256 + F.lane * 4;
        const float* cv = A.in[1]; const float* xv = A.in[3];
        f32x4 a0 = {0.f, 0.f, 0.f, 0.f}, a1 = {0.f, 0.f, 0.f, 0.f};
#pragma unroll 8
        for (int k = slab * 128; k < slab * 128 + 128; ++k) { const f32x4 wv = *(const f32x4*)(w + (size_t)k * 12288); const float s0 = siluf_(cv[k]), s1 = siluf_(xv[k]); a0 += wv * s0; a1 += wv * s1; }
        float* part = (float*)(ws + WS_PART);
        *(f32x4*)(part + ((size_t)((slab * 2 + l) * 2 + 0) * 12288 + chunk * 256 + F.lane * 4)) = a0;
        *(f32x4*)(part + ((size_t)((slab * 2 + l) * 2 + 1) * 12288 + chunk * 256 + F.lane * 4)) = a1;
    }
    const int gtid = F.gw * 64 + F.lane, gstride = F.NGW * 64;
    { bf16_t* DC = (bf16_t*)(ws + WS_TAB + TAB_DC);
      for (int idx = gtid; idx < 512 * 256; idx += gstride) { const int r = idx >> 8, c = idx & 255, reim = r >> 8, m = r & 255, ph = (m * c) & 255; float s, co; sincospif((float)ph * (2.0f / 256.0f), &s, &co);
          DC[idx] = (bf16_t)f2bf((reim ? -s : co) * 0.0625f); }
      bf16_t* DN = (bf16_t*)(ws + WS_TAB + TAB_DN);
      for (int idx = gtid; idx < 256 * 256; idx += gstride) { const int r = idx >> 8, cc = idx & 255, ro = r >> 7, k = r & 127, ci = cc >> 7, b = cc & 127, ph = (k * b) & 127; float s, co; sincospif((float)ph * (2.0f / 128.0f), &s, &co);
          const float v = (ro == ci) ? co : (ro == 0 ? s : -s); DN[idx] = (bf16_t)f2bf(v * 0.08838834764831845f); }
      bf16_t* D2 = (bf16_t*)(ws + WS_TAB + TAB_D256);
      for (int idx = gtid; idx < 256 * 512; idx += gstride) { const int k = idx >> 9, cc = idx & 511, ci = cc >> 8, n = cc & 255, ph = (k * n) & 255; float s, co; sincospif((float)ph * (2.0f / 256.0f), &s, &co);
          D2[idx] = (bf16_t)f2bf((ci ? s : co) * 0.0625f); }
      float* rope = (float*)(ws + WS_TAB + TAB_ROPE);
      for (int idx = gtid; idx < 320 * 32; idx += gstride) { const int p = idx >> 5, j = idx & 31; const float inv = powf(10000.0f, -(float)j / 32.0f);
          const float pos = (float)(p < 256 ? p : p - 256); const float ang = pos * inv; float s, co; sincosf(ang, &s, &co);
          if (p < 256) { rope[p * 32 + j] = co; rope[8192 + p * 32 + j] = s; } else { rope[16384 + (p - 256) * 32 + j] = co; rope[16384 + 2048 + (p - 256) * 32 + j] = s; } }
    }
    int rot = 0;
    for (int l = 0; l < 2; ++l) {
        p0_convert(F, A.in[8] + (size_t)l * DM * INC, DM, INC, (bf16_t*)(ws + WS_WIN) + (size_t)l * INC * DM, 0, rot);
        p0_convert(F, A.in[12] + (size_t)l * QW * DM, QW, DM, (bf16_t*)(ws + WS_WAP) + (size_t)l * DM * QW, 0, rot);
        p0_convert(F, A.in[13] + (size_t)l * FD * DM, FD, DM, (bf16_t*)(ws + WS_WFP) + (size_t)l * DM * FD, 0, rot);
        p0_convert(F, A.in[14] + (size_t)l * DM * DM, DM, DM, (bf16_t*)(ws + WS_WOUT) + (size_t)l * DM * DM, 0, rot);
    }
    p0_convert(F, A.in[15], DM, DFF, (bf16_t*)(ws + WS_WGU), 1, rot);
    p0_convert(F, A.in[16], DM, DFF, (bf16_t*)(ws + WS_WGU), 2, rot);
    p0_convert(F, A.in[17], DFF, DM, (bf16_t*)(ws + WS_WD), 0, rot);
    for (int e = 0; e < NE; ++e) {
        p0_convert(F, A.in[19] + (size_t)e * DM * DFE, DM, DFE, (bf16_t*)(ws + WS_MGU) + (size_t)e * 2 * DFE * DM, 1, rot);
        p0_convert(F, A.in[20] + (size_t)e * DM * DFE, DM, DFE, (bf16_t*)(ws + WS_MGU) + (size_t)e * 2 * DFE * DM, 2, rot);
        p0_convert(F, A.in[21] + (size_t)e * DFE * DM, DFE, DM, (bf16_t*)(ws + WS_MD) + (size_t)e * DM * DFE, 0, rot);
    }
}
__device__ __forceinline__ void p0b_mod(const Frame& F0, const Args& A) {
    Frame F = opaque(F0);
    const float* part = (const float*)(F.ws + WS_PART); float* mod = (float*)(F.ws + WS_MOD);
    for (int idx = F.gw * 64 + F.lane; idx < 2 * 2 * 12288; idx += F.NGW * 64) { const int l = idx / 24576, cond = (idx / 12288) & 1, col = idx % 12288;
        float s = A.in[5][l * 12288 + col];
#pragma unroll
        for (int slab = 0; slab < 16; ++slab) s += part[(size_t)((slab * 2 + l) * 2 + cond) * 12288 + col];
        mod[idx] = s; }
}

template <bool ROUTER>
__device__ __forceinline__ void norm_phase(const Frame& F0, const float* xl, const float* xc, int nrows, const float* gamma, const float* modL, const float* modC, int ksh, bf16_t* H,
                                           const float* router_w, i32x4* route, f32x2* rwt, const float* cparts = nullptr, int ncparts = 0, float* xc_out = nullptr, const bf16_t* xlb = nullptr) {
    Frame F = opaque(F0);
    LAS float* PA = (LAS float*)F.lds;
    LAS float* PB = PA + 2 * DM;
    LAS float* RW = PB + 2 * DM;
    {
        float g_[4], sl_[4], hl_[4], sc_[4], hc_[4];
#pragma unroll
        for (int q = 0; q < DM / 512; ++q) { const int i = F.tid + 512 * q; g_[q] = gamma[i]; sl_[q] = modL[(ksh + 1) * DM + i]; hl_[q] = modL[ksh * DM + i]; sc_[q] = modC[(ksh + 1) * DM + i]; hc_[q] = modC[ksh * DM + i]; }
        f32x4 w0[4], w1[4];
        if (ROUTER) {
#pragma unroll
            for (int q = 0; q < DM / 512; ++q) { const int c = F.tid + 512 * q; w0[q] = *(const f32x4*)(router_w + c * NE); w1[q] = *(const f32x4*)(router_w + c * NE + 4); } }
#pragma unroll
        for (int q = 0; q < DM / 512; ++q) { const int i = F.tid + 512 * q;
            PA[i] = g_[q] * (1.0f + sl_[q]); PB[i] = hl_[q]; PA[DM + i] = g_[q] * (1.0f + sc_[q]); PB[DM + i] = hc_[q]; }
        if (ROUTER) {
#pragma unroll
            for (int q = 0; q < DM / 512; ++q) { const int c = F.tid + 512 * q;
                RW[0 * DM + c] = w0[q].x; RW[1 * DM + c] = w0[q].y; RW[2 * DM + c] = w0[q].z; RW[3 * DM + c] = w0[q].w;
                RW[4 * DM + c] = w1[q].x; RW[5 * DM + c] = w1[q].y; RW[6 * DM + c] = w1[q].z; RW[7 * DM + c] = w1[q].w; } }
    }
    LAS unsigned* cntL = (LAS unsigned*)(RW + DM * NE); LAS unsigned* baseL = cntL + 8; LAS i32x4* RI = (LAS i32x4*)(cntL + 16); LAS f32x2* RT = (LAS f32x2*)(RI + NWAVES * 32);
    if (ROUTER && F.tid < 8) cntL[F.tid] = 0u;
    __syncthreads();
    int kslot = 0;
    auto load_main = [&](int row, f32x4 (&v)[8]) {
        const bool isc = row >= SEQ; const float* src = isc ? xc + (size_t)(row - SEQ) * DM : xl + (size_t)row * DM;
#pragma unroll
        for (int j = 0; j < 8; ++j) {
            if (!isc && xlb) { const u32x2 w = *(const u32x2*)(xlb + (size_t)row * DM + 4 * F.lane + 256 * j); v[j] = (f32x4){bflo(w.x), bfhi(w.x), bflo(w.y), bfhi(w.y)}; }
            else v[j] = *(const f32x4*)(src + 4 * F.lane + 256 * j); }
    };
    auto finish = [&](int row, f32x4 (&v)[8], bool live) {
        const bool isc = row >= SEQ;
        const LAS float* pa = PA + (isc ? DM : 0); const LAS float* pb = PB + (isc ? DM : 0);
        if (isc && ncparts > 0) {
            const float* cp = cparts + (size_t)(row - SEQ) * DM + 4 * F.lane; int s_ = 0;
            for (; s_ + 2 <= ncparts; s_ += 2) { f32x4 t0[8], t1[8];
#pragma unroll
                for (int j = 0; j < 8; ++j) { t0[j] = *(const f32x4*)(cp + (size_t)s_ * CTXL * DM + 256 * j); t1[j] = *(const f32x4*)(cp + (size_t)(s_ + 1) * CTXL * DM + 256 * j); }
#pragma unroll
                for (int j = 0; j < 8; ++j) { v[j] += t0[j]; v[j] += t1[j]; } }
            if (s_ < ncparts) { f32x4 t0[8];
#pragma unroll
                for (int j = 0; j < 8; ++j) t0[j] = *(const f32x4*)(cp + (size_t)s_ * CTXL * DM + 256 * j);
#pragma unroll
                for (int j = 0; j < 8; ++j) v[j] += t0[j]; }
            if (live) {
#pragma unroll
                for (int j = 0; j < 8; ++j) *(f32x4*)(xc_out + (size_t)(row - SEQ) * DM + 4 * F.lane + 256 * j) = v[j]; } }
        float ss = 0.f;
#pragma unroll
        for (int j = 0; j < 8; ++j) ss += (v[j].x * v[j].x + v[j].y * v[j].y) + (v[j].z * v[j].z + v[j].w * v[j].w);
        const float rstd = 1.0f / sqrtf(wave_sum(ss) * (1.0f / DM) + EPS);
        float lg[NE];
        if (ROUTER) {
#pragma unroll
            for (int e = 0; e < NE; ++e) lg[e] = 0.f; }
        bf16_t* orow = H + (size_t)row * DM;
#pragma unroll
        for (int j = 0; j < 8; ++j) { const int c0 = 4 * F.lane + 256 * j; const f32x4 a = *(const LAS f32x4*)(pa + c0), b = *(const LAS f32x4*)(pb + c0);
            const f32x4 h = v[j] * rstd * a + b;
            u32x2 o; o.x = pk2(h.x, h.y); o.y = pk2(h.z, h.w); if (live) *(u32x2*)(orow + c0) = o;
            if (ROUTER) {
#pragma unroll
                for (int e = 0; e < NE; ++e) { const f32x4 wv = *(const LAS f32x4*)(RW + e * DM + c0); lg[e] += (h.x * wv.x + h.y * wv.y) + (h.z * wv.z + h.w * wv.w); }
                asm volatile("" ::: "memory"); } }
        if (ROUTER) {
#pragma unroll
            for (int e = 0; e < NE; ++e) lg[e] = wave_sum(lg[e]);
            int i1 = 0; float v1 = lg[0];
#pragma unroll
            for (int e = 1; e < NE; ++e) if (lg[e] > v1) { v1 = lg[e]; i1 = e; }
            int i2 = -1; float v2 = -3.0e38f;
#pragma unroll
            for (int e = 0; e < NE; ++e) if (e != i1 && lg[e] > v2) { v2 = lg[e]; i2 = e; }
            const float w1 = 1.0f / (1.0f + __expf(v2 - v1)), w2 = 1.0f - w1;
            if (live && F.lane == 0) {
                if (kslot < 32) { const int r1 = (int)__hip_atomic_fetch_add(cntL + i1, 1u, __ATOMIC_RELAXED, __HIP_MEMORY_SCOPE_WORKGROUP), r2 = (int)__hip_atomic_fetch_add(cntL + i2, 1u, __ATOMIC_RELAXED, __HIP_MEMORY_SCOPE_WORKGROUP);
                    RI[F.wave * 32 + kslot] = (i32x4){i1, r1, i2, r2}; RT[F.wave * 32 + kslot] = (f32x2){w1, w2}; }
                else { const int s1 = (int)__hip_atomic_fetch_add(F.ctl + CW_CNT + 64 * i1, 1u, RLX_AGENT), s2 = (int)__hip_atomic_fetch_add(F.ctl + CW_CNT + 64 * i2, 1u, RLX_AGENT);
                    route[row] = (i32x4){i1, s1, i2, s2}; rwt[row] = (f32x2){w1, w2}; } }
        }
    };
    const int nlat = nrows < SEQ ? nrows : SEQ;
    if constexpr (!ROUTER) {
        for (int row = F.gw; row < nlat; row += 2 * F.NGW) { const int row1 = row + F.NGW; const bool has1 = row1 < nlat; const int r1 = has1 ? row1 : row;
            f32x4 va[8], vb[8];
            load_main(row, va); load_main(r1, vb);
            finish(row, va, true); finish(r1, vb, has1);
        }
    } else {
        for (int row = F.gw; row < nlat; row += F.NGW) { f32x4 va[8]; load_main(row, va); finish(row, va, true); ++kslot; }
        __syncthreads();
        if (F.tid < 8) baseL[F.tid] = __hip_atomic_fetch_add(F.ctl + CW_CNT + 64 * F.tid, cntL[F.tid], RLX_AGENT);
        __syncthreads();
        { const int nk = kslot < 32 ? kslot : 32;
          if (F.lane < nk) { const i32x4 ri = RI[F.wave * 32 + F.lane]; const int row = F.gw + F.lane * F.NGW;
              route[row] = (i32x4){ri.x, (int)baseL[ri.x] + ri.y, ri.z, (int)baseL[ri.z] + ri.w}; rwt[row] = RT[F.wave * 32 + F.lane]; } }
    }
    if (F.wave == 0) for (int row = SEQ + F.vcu; row < nrows; row += F.G) { f32x4 va[8]; load_main(row, va); finish(row, va, true); }
    __syncthreads();
}

__device__ __forceinline__ void qknorm_rope_phase(const Frame& F0, bf16_t* Q, bf16_t* Kb, const float* qg, const float* kg, int nrows, bool ctx_q) {
    Frame F = opaque(F0);
    const float* rope = (const float*)(F.ws + WS_TAB + TAB_ROPE);
    const int L = F.lane, axis = L >> 5, half = (L & 31) >> 4, j0 = 2 * (L & 15);
    constexpr float QC = 0.088388347648318440f * 1.4426950408889634f;
    const f32x2 gq = *(const f32x2*)(qg + 2 * L) * QC, gk = *(const f32x2*)(kg + 2 * L);
    for (int row = F.gw; row < nrows; row += F.NGW) {
        const bool isc = row >= SEQ;
        f32x2 cs = {1.f, 1.f}, sn = {0.f, 0.f};
        if (!isc) { const int p = axis ? (row & 63) : (row >> 6); const float* cb = rope + (axis ? 16384 : 0) + p * 32 + j0; const float* sb = cb + (axis ? 2048 : 8192);
            cs = *(const f32x2*)cb; sn = *(const f32x2*)sb; if (half == 0) { sn.x = -sn.x; sn.y = -sn.y; } }
        const int nq = 0;
        unsigned* qrow = (unsigned*)(Q + (size_t)row * QW) + L; unsigned* krow = (unsigned*)(Kb + (size_t)row * KVW) + L;
        unsigned w[NH + NKV];
#pragma unroll
        for (int h = 0; h < NH + NKV; ++h) { const unsigned* p = h < NH ? qrow + h * 64 : krow + (h - NH) * 64; w[h] = (h < NH && h >= nq) ? 0u : *p; }
#pragma unroll
        for (int h = 0; h < NH + NKV; ++h) { if (h < NH && h >= nq) continue;
            unsigned* p = h < NH ? qrow + h * 64 : krow + (h - NH) * 64; const f32x2 g = h < NH ? gq : gk;
            float x0 = bflo(w[h]), x1 = bfhi(w[h]);
            const float rs = 1.0f / sqrtf(wave_sum(x0 * x0 + x1 * x1) * (1.0f / HD) + EPS);
            x0 = x0 * rs * g.x; x1 = x1 * rs * g.y;
            const float y0 = xor16f(x0), y1 = xor16f(x1);
            *p = pk2(x0 * cs.x + y0 * sn.x, x1 * cs.y + y1 * sn.y); }
    }
}

__device__ __forceinline__ void moe_cum(Frame& F, int (&cum)[9], int (&rbase)[8]) {
    int t = 0;
#pragma unroll
    for (int e = 0; e < NE; ++e) { const unsigned c = __builtin_amdgcn_readfirstlane(__hip_atomic_load(F.ctl + CW_CNT + 64 * e, RLX_AGENT)); cum[e] = t; rbase[e] = t * 256; t += (int)((c + 255u) >> 8); }
    cum[8] = t;
}
__device__ __forceinline__ void moe_gather_phase(const Frame& F0, const bf16_t* H, bf16_t* HG, const i32x4* route, i32x2* pairpos) {
    Frame F = opaque(F0);
    int cum[9], rbase[8]; moe_cum(F, cum, rbase);
    LAS int* RB = (LAS int*)F.lds;
    if (F.tid == 0) {
#pragma unroll
        for (int e = 0; e < NE; ++e) RB[e] = rbase[e]; }
    __syncthreads();
    for (int t = F.gw; t < SEQ; t += 2 * F.NGW) { const int t1 = t + F.NGW; const bool has1 = t1 < SEQ; const int tb = has1 ? t1 : t;
        const i32x4 ra = route[t], rb = route[tb]; const int pa1 = RB[ra.x] + ra.y, pa2 = RB[ra.z] + ra.w, pb1 = RB[rb.x] + rb.y, pb2 = RB[rb.z] + rb.w;
        const u32x4* sa = (const u32x4*)(H + (size_t)t * DM) + F.lane; const u32x4* sb = (const u32x4*)(H + (size_t)tb * DM) + F.lane;
        u32x4 va[4], vb[4];
#pragma unroll
        for (int j = 0; j < 4; ++j) { va[j] = sa[64 * j]; vb[j] = sb[64 * j]; }
        u32x4* da1 = (u32x4*)(HG + (size_t)pa1 * DM) + F.lane; u32x4* da2 = (u32x4*)(HG + (size_t)pa2 * DM) + F.lane;
        u32x4* db1 = (u32x4*)(HG + (size_t)pb1 * DM) + F.lane; u32x4* db2 = (u32x4*)(HG + (size_t)pb2 * DM) + F.lane;
#pragma unroll
        for (int j = 0; j < 4; ++j) { da1[64 * j] = va[j]; da2[64 * j] = va[j]; if (has1) { db1[64 * j] = vb[j]; db2[64 * j] = vb[j]; } }
        if (F.lane == 0) { pairpos[t] = (i32x2){pa1, pa2}; if (has1) pairpos[t1] = (i32x2){pb1, pb2}; } }
    __syncthreads();
}

__device__ __forceinline__ void final_phase(const Frame& F0, float* out, const bf16_t* XBp, const bf16_t* OP, const i32x2* pairpos, const f32x2* rwt, const float* ga2, const float* fg, bool poison) {
    Frame F = opaque(F0);
    for (int row = F.gw; row < SEQ; row += 2 * F.NGW) { const int row1 = row + F.NGW; const bool has1 = row1 < SEQ; const int r1 = has1 ? row1 : row;
        const i32x2 ppa = pairpos[row], ppb = pairpos[r1]; const f32x2 wa = rwt[row], wb = rwt[r1];
        u32x2 xa[8], xb[8], a1[8], a2[8], b1[8], b2[8];
#pragma unroll
        for (int j = 0; j < 8; ++j) { const int c0 = 4 * F.lane + 256 * j;
            xa[j] = *(const u32x2*)(XBp + (size_t)row * DM + c0); a1[j] = *(const u32x2*)(OP + (size_t)ppa.x * DM + c0); a2[j] = *(const u32x2*)(OP + (size_t)ppa.y * DM + c0);
            xb[j] = *(const u32x2*)(XBp + (size_t)r1 * DM + c0); b1[j] = *(const u32x2*)(OP + (size_t)ppb.x * DM + c0); b2[j] = *(const u32x2*)(OP + (size_t)ppb.y * DM + c0); }
        f32x4 va[8], vb[8]; float sa = 0.f, sb = 0.f;
#pragma unroll
        for (int j = 0; j < 8; ++j) { const int c0 = 4 * F.lane + 256 * j; const f32x4 g = *(const f32x4*)(ga2 + c0);
            { const f32x4 x = (f32x4){bflo(xa[j].x), bfhi(xa[j].x), bflo(xa[j].y), bfhi(xa[j].y)};
              const f32x4 m = (f32x4){bflo(a1[j].x), bfhi(a1[j].x), bflo(a1[j].y), bfhi(a1[j].y)} * wa.x + (f32x4){bflo(a2[j].x), bfhi(a2[j].x), bflo(a2[j].y), bfhi(a2[j].y)} * wa.y;
              va[j] = x + g * m; sa += (va[j].x * va[j].x + va[j].y * va[j].y) + (va[j].z * va[j].z + va[j].w * va[j].w); }
            { const f32x4 x = (f32x4){bflo(xb[j].x), bfhi(xb[j].x), bflo(xb[j].y), bfhi(xb[j].y)};
              const f32x4 m = (f32x4){bflo(b1[j].x), bfhi(b1[j].x), bflo(b1[j].y), bfhi(b1[j].y)} * wb.x + (f32x4){bflo(b2[j].x), bfhi(b2[j].x), bflo(b2[j].y), bfhi(b2[j].y)} * wb.y;
              vb[j] = x + g * m; sb += (vb[j].x * vb[j].x + vb[j].y * vb[j].y) + (vb[j].z * vb[j].z + vb[j].w * vb[j].w); } }
        const float ra = 1.0f / sqrtf(wave_sum(sa) * (1.0f / DM) + EPS), rb = 1.0f / sqrtf(wave_sum(sb) * (1.0f / DM) + EPS);
        float* xr = out + (size_t)row * DM; float* xr1 = out + (size_t)r1 * DM;
#pragma unroll
        for (int j = 0; j < 8; ++j) { const int c0 = 4 * F.lane + 256 * j; const f32x4 fgv = *(const f32x4*)(fg + c0); f32x4 oa = va[j] * ra * fgv, ob = vb[j] * rb * fgv;
            if (poison) { const float q = __builtin_nanf(""); oa = (f32x4){q, q, q, q}; ob = oa; }
            *(f32x4*)(xr + c0) = oa; if (has1) *(f32x4*)(xr1 + c0) = ob; } }
}

constexpr int PH_P0 = 0, PH_P0B = 1, PH_L0 = 2, PH_PER_LAYER = 12, PH_END = PH_L0 + 2 * PH_PER_LAYER;

__global__ void __launch_bounds__(NWAVES * 64, 2) mk_fwd(Args args) {
    extern __shared__ __attribute__((aligned(16))) unsigned char lds[];
    Frame F;
    F.lds = (LAS unsigned char*)lds; F.ldsg = lds;
    volatile LAS unsigned* MISC = (volatile LAS unsigned*)(F.lds + MISC_OFF);
    F.tid = threadIdx.x; F.lane = F.tid & 63; F.wave = __builtin_amdgcn_readfirstlane(F.tid >> 6);
    F.G = gridDim.x; { const int bx = blockIdx.x; F.vcu = (F.G % 8 == 0) ? (bx % 8) * (F.G / 8) + bx / 8 : bx; }
    F.gw = F.vcu * NWAVES + F.wave; F.NGW = F.G * NWAVES;
    F.ws = args.ws; F.ctl = (gu32*)(args.ws + WS_CTL);
    for (int u = F.tid; u < (LDS_BYTES - LDSCTL_OFF) / 4; u += NWAVES * 64) ((LAS unsigned*)(F.lds + LDSCTL_OFF))[u] = 0u;
    __syncthreads();
    const int lo = args.ph_lo, hi = args.ph_hi;
    XcdBarrier bar; bar.bar = (unsigned*)(F.ctl + CW_BAR); bar.x = 0; bar.st = nullptr; bar.wave = 0;
    if (!MK_SPLIT) bar = xcd_barrier_post((unsigned*)(F.ctl + CW_BAR), MISC + 8);
    bar.wave = F.wave;
#ifndef PH_MASK
#define PH_MASK 0xFFFFFFFFu
#endif
#define PHT(k) ((k) < PH_L0 ? (k) : 2 + ((k) - PH_L0) % PH_PER_LAYER)
#define IN(k) (((PH_MASK >> PHT(k)) & 1u) && lo <= (k) && (k) < hi)
#ifdef PROF_MASK
    unsigned long long tacc = 0, tph = __builtin_amdgcn_s_memrealtime();
#define SEAM(k) do { if (!MK_SPLIT) xcd_barrier(bar); { const unsigned long long t_ = __builtin_amdgcn_s_memrealtime(); if ((PROF_MASK >> (k)) & 1ull) tacc += t_ - tph; tph = t_; } } while (0)
#else
#define SEAM(k) do { if (!MK_SPLIT) xcd_barrier(bar); } while (0)
#endif
    unsigned char* ws = args.ws;
    bf16_t* Hb = (bf16_t*)(ws + WS_H); bf16_t* Qb = (bf16_t*)(ws + WS_Q); bf16_t* Kb = (bf16_t*)(ws + WS_K); bf16_t* Vb = (bf16_t*)(ws + WS_V);
    bf16_t* Fb = (bf16_t*)(ws + WS_F); bf16_t* Gb = (bf16_t*)(ws + WS_G); bf16_t* ZA = (bf16_t*)(ws + WS_ZA); bf16_t* YB = (bf16_t*)(ws + WS_YB);
    bf16_t* FOUR = (bf16_t*)(ws + WS_FOUR); bf16_t* ZC = (bf16_t*)(ws + WS_ZC); float* XC = (float*)(ws + WS_XC); bf16_t* XB = (bf16_t*)(ws + WS_XB);
    bf16_t* Ub = (bf16_t*)(ws + WS_U); bf16_t* HG = (bf16_t*)(ws + WS_HG); bf16_t* UG = (bf16_t*)(ws + WS_UG);
    i32x4* route = (i32x4*)(ws + WS_ROUTE); f32x2* rwt = (f32x2*)(ws + WS_ROUTE + 256 * 1024); i32x2* pairpos = (i32x2*)(ws + WS_ROUTE + 512 * 1024);
    const bf16_t* DC = (const bf16_t*)(ws + WS_TAB + TAB_DC); const bf16_t* DN = (const bf16_t*)(ws + WS_TAB + TAB_DN); const bf16_t* D256 = (const bf16_t*)(ws + WS_TAB + TAB_D256);
    const float* MOD = (const float*)(ws + WS_MOD); float* PARTC = (float*)(ws + WS_PARTC);
    const int bx = (int)blockIdx.x;

    if (IN(PH_P0)) { p0_prologue(F, args); __syncthreads(); SEAM(PH_P0); }
    if (IN(PH_P0B)) { p0b_mod(F, args); SEAM(PH_P0B); }

#pragma unroll 1
    for (int l = 0; l < 2; ++l) {
        const int pb = PH_L0 + l * PH_PER_LAYER; const bool last = (l == 1);
        const float* modL = MOD + (size_t)(l * 2 + 0) * 12288; const float* modC = MOD + (size_t)(l * 2 + 1) * 12288;
        const float* xlat = args.in[0]; const float* xctx = (l == 0) ? args.in[2] : XC;
        if (IN(pb + 0)) {
            norm_phase<false>(F, xlat, xctx, MR, args.in[6] + l * DM, modL, modC, 0, Hb, nullptr, nullptr, nullptr, PARTC, l == 0 ? 0 : 11, XC, l == 0 ? nullptr : XB); SEAM(pb + 0); }
        if (IN(pb + 1)) {
            pg8::Gemm g = pg8::mk_gemm(Hb, DM, (const bf16_t*)(ws + WS_WIN) + (size_t)l * INC * DM, DM, DM);
            pg8::TileOrder S; S.init(last ? 64 : 65, 32, F.G, bx, (long)256 * DM * 2, (long)256 * DM * 2);
            if (last) { S.xpm = 64; S.xlo = 8; S.xn = 4; }
            { const bf16_t* Wl = (const bf16_t*)(ws + WS_WIN) + (size_t)l * INC * DM;
              S.sn = 2 * 65; S.sdiv = 65; S.sA0 = (long)((const char*)Wl - (const char*)Hb) + (long)(QW + KVW) * DM * 2; S.sB0 = (long)((const char*)Hb - (const char*)Wl); }
            pg8::EpiInProj E{Qb, Kb, Vb, Fb, Gb, args.in[9] + l * GW2, (bf16_t*)(ws + WS_VT)};
            pg8::gemm_phase(F.lds, g, S, E, F.wave);
            SEAM(pb + 1);
        }
        if (IN(pb + 2)) {
#ifndef NO_QKN
            qknorm_rope_phase(F, Qb, Kb, args.in[10] + l * HD, args.in[11] + l * HD, MR, !last);
#endif
#ifndef NO_F1
            { pg8::Gemm g = pg8::mk_gemm(DC, 256, Fb, FD, 256); g.rmulB = 128; g.hstepB = (long)FD * 2;
              pg8::F1Order S{F.G, bx}; pg8::EpiF1 E{ZA}; pg8::gemm_phase(F.lds, g, S, E, F.wave); }
#endif
#ifndef NO_F1C
            if (!last) { pg8::Gemm g = pg8::mk_gemm(DC, 256, Fb, FD, 256);
              pg8::F1cOrder S{F.G, bx}; pg8::EpiF1c E{ZC}; pg8::gemm_phase(F.lds, g, S, E, F.wave); }
#endif
            SEAM(pb + 2);
        }
        if (IN(pb + 3)) {
            pg8::Gemm g = pg8::mk_gemm(DN, 256, ZA, 256, 256);
            pg8::LinOrder S{F.G, bx, 512, (long)256 * 256 * 2}; pg8::EpiF2 E{YB}; pg8::gemm_phase(F.lds, g, S, E, F.wave);
            SEAM(pb + 3);
        }
        if (IN(pb + 4)) {
#ifndef NO_F3
            { pg8::Gemm g = pg8::mk_gemm(DN, 256, YB, 256, 256);
              pg8::LinOrder S{F.G, bx, 512, (long)256 * 256 * 2}; pg8::EpiF3 E{FOUR}; pg8::gemm_phase(F.lds, g, S, E, F.wave); }
#endif
#ifndef NO_F3C
            if (!last) { pg8::Gemm g = pg8::mk_gemm(D256, 512, ZC, 512, 512);
              pg8::LinOrder S{F.G, bx, 4, (long)256 * 512 * 2}; pg8::EpiF3c E{FOUR}; pg8::gemm_phase(F.lds, g, S, E, F.wave); }
#endif
            __syncthreads();
#ifndef NO_ATTN
            const int nctx = last ? 0 : NH;
            float gqm = 0.f, gkm = 0.f;
            { const float* gq = args.in[10] + l * HD; const float* gk = args.in[11] + l * HD;
              const int ln = tid_of(F.wave) & 63;
              gqm = fmaxf(fabsf(gq[ln]), fabsf(gq[ln + 64])); gkm = fmaxf(fabsf(gk[ln]), fabsf(gk[ln + 64]));
              gqm = wave_max(gqm); gkm = wave_max(gkm); }
            const float bnd = (11.313708499f * gqm * gkm * 1.03f + 0.25f) * 1.4426950408889634f;
            const bool fastsm = __builtin_amdgcn_readfirstlane(bnd <= 43.0f ? 1 : 0) != 0;
            const float negBC = 0.f;
            for (int i = 0;; ++i) {
                int qh, qb, isc;
                if (F.G == 256) { const int xcd = F.vcu >> 5, c = F.vcu & 31;
                    if (i < 4) { qh = (xcd >> 1) * 4 + (xcd & 1) * 2 + (i >> 1); qb = (i & 1) * 32 + c; isc = 0; }
                    else if (i == 4 && F.vcu < nctx) { qh = F.vcu; qb = 0; isc = 1; }
                    else break; }
                else { const int Lu = i * F.G + bx; if (Lu < 1024) { qh = Lu >> 6; qb = Lu & 63; isc = 0; } else if (Lu < 1024 + nctx) { qh = Lu - 1024; qb = 0; isc = 1; } else break; }
                const size_t row0 = isc ? (size_t)SEQ : (size_t)qb * 256;
                const at::bf16* Qp = (const at::bf16*)(Qb + row0 * QW + qh * HD);
                const size_t kro = isc ? (size_t)SEQ * KVW : 0;
                const at::bf16* Kp = (const at::bf16*)(Kb + kro + (qh >> 2) * HD); const at::bf16* Vp = (const at::bf16*)(Vb + kro + (qh >> 2) * HD);
#ifdef ATT_V3
                if (fastsm) at::attn_body_v4(Qp, Kp, (const at::bf16*)((const bf16_t*)(ws + WS_VT) + (size_t)(qh >> 2) * HD * MR + (isc ? SEQ : 0)), (at::bf16*)(Qb + row0 * QW + qh * HD), isc ? CTXL : MR, (char*)lds, F.wave, args.in[10] + l * HD, (const float*)(ws + WS_TAB + TAB_ROPE), isc ? -1 : qb * 256);
#else
                if (fastsm) at::ATT_FAST(Qp, Kp, Vp, (at::bf16*)(Qb + row0 * QW + qh * HD), isc ? CTXL : MR, ATT_FAST_ARGS negBC, F.wave);
#endif
#ifndef NO_SLOWATT
                else at::attn_dense_body(Qp, Kp, Vp, (at::bf16*)(Qb + row0 * QW + qh * HD), isc ? CTXL : MR, (char*)lds, F.wave, args.in[10] + l * HD, (const float*)(ws + WS_TAB + TAB_ROPE), isc ? -1 : qb * 256);
#endif
            }
#endif
            SEAM(pb + 4);
        }
        if (IN(pb + 5)) {
            const int nM = last ? 64 : 65;
            { pg8::Gemm g = pg8::mk_gemm(Qb, QW, (const bf16_t*)(ws + WS_WAP) + (size_t)l * DM * QW, QW, QW);
              pg8::TileOrder S; S.init(nM, 8, F.G, bx, (long)256 * QW * 2, (long)256 * QW * 2); pg8::EpiMerge<0> E{Hb, Gb}; pg8::gemm_phase(F.lds, g, S, E, F.wave); }
            { pg8::Gemm g = pg8::mk_gemm(FOUR, FD, (const bf16_t*)(ws + WS_WFP) + (size_t)l * DM * FD, FD, FD);
              pg8::TileOrder S; S.init(nM, 8, F.G, bx, (long)256 * FD * 2, (long)256 * FD * 2); pg8::EpiMerge<1> E{Hb, Gb}; pg8::gemm_phase(F.lds, g, S, E, F.wave); }
            SEAM(pb + 5);
        }
        if (IN(pb + 6)) {
            pg8::Gemm g = pg8::mk_gemm(Hb, DM, (const bf16_t*)(ws + WS_WOUT) + (size_t)l * DM * DM, DM, DM);
            pg8::TileOrder S; S.init(64, 8, F.G, bx, (long)256 * DM * 2, (long)256 * DM * 2);
            pg8::EpiRes E{xlat, l == 0 ? nullptr : XB, XB, modL + 2 * DM, xctx, XC, modC + 2 * DM};
            pg8::gemm_phase(F.lds, g, S, E, F.wave);
            if (!last) {
                pg8::Gemm g2 = g; g2.K = 256;
                pg8::SplitKOrder S2{F.G, bx, 8, 8, 64, (long)SEQ * DM * 2, (long)256 * DM * 2, (long)256 * 2};
                pg8::EpiPartial E2{PARTC, modC + 2 * DM}; pg8::gemm_phase(F.lds, g2, S2, E2, F.wave); }
            SEAM(pb + 6);
        }
        if (IN(pb + 7)) {
            if (!last) norm_phase<false>(F, xlat, xctx, MR, args.in[7] + l * DM, modL, modC, 3, Hb, nullptr, nullptr, nullptr, PARTC, 8, XC, XB);
            else norm_phase<true>(F, xlat, XC, SEQ, args.in[7] + l * DM, modL, modC, 3, Hb, args.in[18], route, rwt, nullptr, 0, nullptr, XB);
            SEAM(pb + 7);
        }
        if (!last) {
            if (IN(pb + 8)) {
                pg8::Gemm g = pg8::mk_gemm(Hb, DM, (const bf16_t*)(ws + WS_WGU), DM, DM);
                pg8::TileOrder S; S.init(65, 44, F.G, bx, (long)256 * DM * 2, (long)256 * DM * 2);
                pg8::EpiSwiglu E{Ub, DFF}; pg8::gemm_phase(F.lds, g, S, E, F.wave);
                SEAM(pb + 8);
            }
            if (IN(pb + 9)) {
                pg8::Gemm g = pg8::mk_gemm(Ub, DFF, (const bf16_t*)(ws + WS_WD), DFF, DFF);
                pg8::TileOrder S; S.init(64, 8, F.G, bx, (long)256 * DFF * 2, (long)256 * DFF * 2);
                pg8::EpiRes E{nullptr, XB, XB, modL + 5 * DM, XC, XC, modC + 5 * DM};
                pg8::gemm_phase(F.lds, g, S, E, F.wave);
                { pg8::Gemm g2 = g; g2.K = 512;
                  pg8::SplitKOrder S2{F.G, bx, 8, 11, 64, (long)SEQ * DFF * 2, (long)256 * DFF * 2, (long)512 * 2};
                  pg8::EpiPartial E2{PARTC, modC + 5 * DM}; pg8::gemm_phase(F.lds, g2, S2, E2, F.wave); }
                SEAM(pb + 9);
            }
        } else {
            if (IN(pb + 8)) { moe_gather_phase(F, Hb, HG, route, pairpos); SEAM(pb + 8); }
            if (IN(pb + 9)) {
                int rbase[8]; pg8::MoeOrder S; S.G = F.G; S.c = bx; S.nN = 22; moe_cum(F, S.cum, rbase); S.tA = (long)256 * DM * 2; S.tB = (long)256 * DM * 2; S.eB = (long)2 * DFE * DM * 2;
                pg8::Gemm g = pg8::mk_gemm(HG, DM, (const bf16_t*)(ws + WS_MGU), DM, DM);
                pg8::EpiSwiglu E{UG, DFE}; pg8::gemm_phase(F.lds, g, S, E, F.wave);
                SEAM(pb + 9);
            }
            if (IN(pb + 10)) {
                int rbase[8]; pg8::MoeOrder S; S.G = F.G; S.c = bx; S.nN = 8; moe_cum(F, S.cum, rbase); S.tA = (long)256 * DFE * 2; S.tB = (long)256 * DFE * 2; S.eB = (long)DM * DFE * 2;
                pg8::Gemm g = pg8::mk_gemm(UG, DFE, (const bf16_t*)(ws + WS_MD), DFE, DFE);
                pg8::EpiPlain E{HG, DM}; pg8::gemm_phase(F.lds, g, S, E, F.wave);
                SEAM(pb + 10);
            }
            if (IN(pb + 11)) {
                bool poison = false;
                if (!MK_SPLIT) poison = __hip_atomic_load((gu32*)((unsigned*)(F.ctl + CW_BAR) + XB_TMO), RLX_AGENT) != 0u;
                final_phase(F, args.out, XB, HG, pairpos, rwt, modL + 5 * DM, args.in[22], poison);
#ifdef PROF_MASK
                { const unsigned long long t_ = __builtin_amdgcn_s_memrealtime(); if ((PROF_MASK >> (pb + 11)) & 1ull) tacc += t_ - tph; tph = t_;
                  if (blockIdx.x == 0) { while (__builtin_amdgcn_s_memrealtime() - tph < PROF_MULT * tacc) __builtin_amdgcn_s_sleep(8); } }
#endif
            }
        }
    }
#undef IN
#undef SEAM
}

extern "C" void kernel_launch(void* const* d_in, const int* in_sizes, int n_in, void* d_out, int out_size, void* d_ws, size_t ws_size, hipStream_t stream) {
    static int grid = 0;
    if (grid == 0) {
        if (n_in != 23 || out_size != SEQ * DM || ws_size < WS_END) { fprintf(stderr, "kernel_launch: unexpected shapes (n_in %d out %d ws %zu)\n", n_in, out_size, ws_size); grid = -1; return; }
        int dev = 0, cus = 0, per_cu = 0;
        if (hipGetDevice(&dev) != hipSuccess || hipDeviceGetAttribute(&cus, hipDeviceAttributeMultiprocessorCount, dev) != hipSuccess) { grid = -1; return; }
        if (hipFuncSetAttribute((const void*)mk_fwd, hipFuncAttributeMaxDynamicSharedMemorySize, LDS_BYTES) != hipSuccess) { grid = -1; return; }
        if (hipOccupancyMaxActiveBlocksPerMultiprocessor(&per_cu, (const void*)mk_fwd, NWAVES * 64, LDS_BYTES) != hipSuccess || per_cu < 1) fprintf(stderr, "kernel_launch: occupancy query says %d\n", per_cu);
        (void)hipGetLastError();
        grid = cus;
    }
    if (grid < 0) return;
    (void)hipMemsetAsync((char*)d_ws + WS_CTL, 0, CTL_ZERO_BYTES, stream);
    Args a{};
    for (int i = 0; i < 23; ++i) a.in[i] = (const float*)d_in[i];
    a.out = (float*)d_out; a.ws = (unsigned char*)d_ws;
#if MK_SPLIT
    for (int p = 0; p < PH_END; ++p) { a.ph_lo = p; a.ph_hi = p + 1; hipLaunchKernelGGL(mk_fwd, dim3(grid), dim3(NWAVES * 64), LDS_BYTES, stream, a); }
#else
    a.ph_lo = 0; a.ph_hi = PH_END;
    hipLaunchKernelGGL(mk_fwd, dim3(grid), dim3(NWAVES * 64), LDS_BYTES, stream, a);
#endif
}
```

```cpp
#include <hip/hip_runtime.h>
#include <hip/hip_bf16.h>
#include <cstdio>
#include <cstdint>

#define GAS __attribute__((address_space(1)))
#define LAS __attribute__((address_space(3)))
typedef unsigned short bf16_t;
typedef short bf16x8 __attribute__((ext_vector_type(8)));
typedef short s16x4 __attribute__((ext_vector_type(4)));
typedef float f32x4 __attribute__((ext_vector_type(4)));
typedef float f32x2 __attribute__((ext_vector_type(2)));
typedef float f32x16 __attribute__((ext_vector_type(16)));
typedef unsigned u32x4 __attribute__((ext_vector_type(4)));
typedef unsigned u32x2 __attribute__((ext_vector_type(2)));
typedef int i32x4 __attribute__((ext_vector_type(4)));
typedef int i32x2 __attribute__((ext_vector_type(2)));
typedef GAS unsigned gu32;
#define RLX_AGENT __ATOMIC_RELAXED, __HIP_MEMORY_SCOPE_AGENT
#define LDS_WAIT() asm volatile("s_waitcnt lgkmcnt(0)" ::: "memory")
#define VM_WAIT() asm volatile("s_waitcnt vmcnt(0)" ::: "memory")

#ifndef MK_SPLIT
#define MK_SPLIT 0
#endif

constexpr int DM = 2048, SEQ = 16384, CTXL = 256, MR = SEQ + CTXL, NH = 16, NKV = 4, HD = 128;
constexpr int QW = 2048, KVW = 512, FD = 1024, GW2 = 4096, INC = 8192, DFF = 5632, NE = 8, DFE = 2816;
constexpr int PAIR_ROWS = 34816;
constexpr float EPS = 1e-6f;
constexpr int NWAVES = 8;

constexpr size_t MiB = 1u << 20;
constexpr size_t WS_CTL = 0, CTL_ZERO_BYTES = 1 * MiB;
constexpr size_t WS_WIN = 1 * MiB;
constexpr size_t WS_WAP = 65 * MiB;
constexpr size_t WS_WFP = 81 * MiB;
constexpr size_t WS_WOUT = 89 * MiB;
constexpr size_t WS_WGU = 105 * MiB;
constexpr size_t WS_WD = 149 * MiB;
constexpr size_t WS_MGU = 171 * MiB;
constexpr size_t WS_MD = 347 * MiB;
constexpr size_t WS_TAB = 435 * MiB;
constexpr size_t WS_PART = 436 * MiB;
constexpr size_t WS_MOD = 439 * MiB;
constexpr size_t WS_H = 440 * MiB;
constexpr size_t WS_Q = 505 * MiB;
constexpr size_t WS_K = 570 * MiB;
constexpr size_t WS_V = 587 * MiB;
constexpr size_t WS_F = 604 * MiB;
constexpr size_t WS_G = 637 * MiB;
constexpr size_t WS_ZA = 767 * MiB;
constexpr size_t WS_YB = 831 * MiB;
constexpr size_t WS_FOUR = 895 * MiB;
constexpr size_t WS_ZC = 928 * MiB;
constexpr size_t WS_XC = 929 * MiB;
constexpr size_t WS_ROUTE = 931 * MiB;
constexpr size_t WS_U = 505 * MiB;
constexpr size_t WS_HG = 505 * MiB;
constexpr size_t WS_UG = 641 * MiB;
constexpr size_t WS_PARTC = 932 * MiB;
constexpr size_t WS_VT = 956 * MiB;
constexpr size_t WS_XB = 974 * MiB;
constexpr size_t WS_END = 1038 * MiB;
static_assert(WS_UG + (size_t)PAIR_ROWS * DFE * 2 <= WS_ROUTE, "ws map");
static_assert(WS_U + (size_t)MR * DFF * 2 <= WS_ZA, "ws map");
constexpr size_t TAB_DC = 0;
constexpr size_t TAB_DN = 256 * 1024;
constexpr size_t TAB_D256 = 384 * 1024;
constexpr size_t TAB_ROPE = 640 * 1024;
constexpr int CW_TMO = 0, CW_CODE = 1, CW_DBG = 2, CW_CNT = 1024  , CW_BAR = 4096;

constexpr int RING_BYTES = 131072, LDSCTL_OFF = RING_BYTES, MISC_OFF = LDSCTL_OFF + 320;
constexpr int LDS_BYTES = 147456;

__device__ __forceinline__ int tid_of(int wave) { int l; asm volatile("v_mbcnt_lo_u32_b32 %0, -1, 0\n\tv_mbcnt_hi_u32_b32 %0, -1, %0" : "=v"(l)); return wave * 64 + l; }
__device__ __forceinline__ unsigned f2bf(float f) { unsigned u = __builtin_bit_cast(unsigned, f); return (u + 0x7fffu + ((u >> 16) & 1u)) >> 16; }
__device__ __forceinline__ unsigned pk2(float lo, float hi) { return f2bf(lo) | (f2bf(hi) << 16); }
__device__ __forceinline__ float bflo(unsigned w) { return __builtin_bit_cast(float, w << 16); }
__device__ __forceinline__ float bfhi(unsigned w) { return __builtin_bit_cast(float, w & 0xffff0000u); }
__device__ __forceinline__ unsigned cvt_pk_bf16(float lo, float hi) { unsigned r; asm volatile("v_cvt_pk_bf16_f32 %0, %1, %2" : "=v"(r) : "v"(lo), "v"(hi)); return r; }
template <int CTRL> __device__ __forceinline__ float dppf(float v) { return __builtin_bit_cast(float, __builtin_amdgcn_update_dpp(0, __builtin_bit_cast(int, v), CTRL, 0xF, 0xF, true)); }
__device__ __forceinline__ float xor16f(float v) { return __builtin_bit_cast(float, __builtin_amdgcn_ds_swizzle(__builtin_bit_cast(int, v), 0x401F)); }
__device__ __forceinline__ float wave_sum(float v) {
    v += dppf<0xB1>(v); v += dppf<0x4E>(v); v += dppf<0x141>(v); v += dppf<0x140>(v);
    v += xor16f(v);
    { auto rr = __builtin_amdgcn_permlane32_swap(__float_as_uint(v), __float_as_uint(v), false, false); v = __uint_as_float(rr[0]) + __uint_as_float(rr[1]); }
    return v;
}
__device__ __forceinline__ float wave_max(float v) {
    v = fmaxf(v, dppf<0xB1>(v)); v = fmaxf(v, dppf<0x4E>(v)); v = fmaxf(v, dppf<0x141>(v)); v = fmaxf(v, dppf<0x140>(v));
    v = fmaxf(v, xor16f(v));
    { auto rr = __builtin_amdgcn_permlane32_swap(__float_as_uint(v), __float_as_uint(v), false, false); v = fmaxf(__uint_as_float(rr[0]), __uint_as_float(rr[1])); }
    return v;
}
__device__ __forceinline__ float sigmoidf_(float x) { return __builtin_amdgcn_rcpf(1.0f + __builtin_amdgcn_exp2f(-1.4426950408889634f * x)); }

#define XB_TMO      128
#define XB_XCNT(j)  (256  + 64 * (j))
#define XB_XSUB(j)  (1280 + 64 * (j))
#define XB_XGEN(j)  (2304 + 64 * (j))
#define XB_TOP      3328
#define XB_TOPGEN   3392
#define XCD_BAR_WORDS 3456
#define XB_SPIN_CAP (1u << 18)
__device__ __forceinline__ unsigned xb_ld(unsigned* p)              { return __hip_atomic_load(p, __ATOMIC_RELAXED, __HIP_MEMORY_SCOPE_AGENT); }
__device__ __forceinline__ unsigned xb_add(unsigned* p, unsigned v) { return __hip_atomic_fetch_add(p, v, __ATOMIC_RELAXED, __HIP_MEMORY_SCOPE_AGENT); }
__device__ __forceinline__ unsigned xb_xcc_id() { return (unsigned)__builtin_amdgcn_s_getreg((3 << 11) | 20) & 0xFu; }
#define XB_SPIN(cond, bar) do { unsigned _sp = 0; while (cond) { __builtin_amdgcn_s_sleep(1); \
    if ((++_sp & 255u) == 0u) { if (xb_ld(&(bar)[XB_TMO])) break; if (_sp > XB_SPIN_CAP) { atomicAdd(&(bar)[XB_TMO], 1u); break; } } } } while (0)
struct XcdBarrier { unsigned* bar; unsigned x; volatile LAS unsigned* st; int wave; };
__device__ __forceinline__ XcdBarrier xcd_barrier_post(unsigned* bar, volatile LAS unsigned* st) {
    XcdBarrier b; b.bar = bar; b.x = xb_xcc_id(); b.st = st; b.wave = 0;
    if (threadIdx.x == 0) (void)xb_add(&bar[XB_XCNT(b.x)], 1u);
    return b;
}
__device__ __forceinline__ void xcd_barrier_complete(unsigned* bar, unsigned x, unsigned& nloc, unsigned& nx) {
    const unsigned G = gridDim.x * gridDim.y * gridDim.z;
    unsigned sum, cnt, mine, sp = 0u;
    for (;;) {
        sum = 0u; cnt = 0u; mine = 0u;
#pragma unroll
        for (unsigned j = 0; j < 16; ++j) { const unsigned c = xb_ld(&bar[XB_XCNT(j)]); sum += c; cnt += (c > 0u) ? 1u : 0u; mine = (j == x) ? c : mine; }
        if (sum == G) break;
        __builtin_amdgcn_s_sleep(1);
        if ((++sp & 255u) == 0u) { if (xb_ld(&bar[XB_TMO])) break; if (sp > XB_SPIN_CAP) { atomicAdd(&bar[XB_TMO], 1u); break; } }
    }
    nloc = mine > 0u ? mine : 1u; nx = cnt > 0u ? cnt : 1u;
}
__device__ __forceinline__ void xcd_barrier(const XcdBarrier& b) {
    asm volatile("s_waitcnt vmcnt(0)" ::: "memory");
    __syncthreads();
    if (tid_of(b.wave) == 0) {
        unsigned* bar = b.bar;
        __builtin_amdgcn_s_waitcnt(0);
        unsigned nloc = b.st[0], nx = b.st[1];
        if (nloc == 0u) { xcd_barrier_complete(bar, b.x, nloc, nx); b.st[0] = nloc; b.st[1] = nx; }
        const unsigned old = xb_add(&bar[XB_XSUB(b.x)], 1u);
        const unsigned gen = old / nloc;
        if (old + 1u == (gen + 1u) * nloc) {
            __builtin_amdgcn_fence(__ATOMIC_RELEASE, "agent");
            asm volatile("s_waitcnt vmcnt(0)" ::: "memory");
            const unsigned og = xb_add(&bar[XB_TOP], 1u);
            const unsigned tg = og / nx;
            if (og + 1u == (tg + 1u) * nx) xb_add(&bar[XB_TOPGEN], 1u);
            else XB_SPIN(xb_ld(&bar[XB_TOPGEN]) == tg, bar);
            __builtin_amdgcn_fence(__ATOMIC_ACQUIRE, "agent");
            xb_add(&bar[XB_XGEN(b.x)], 1u);
            asm volatile("s_waitcnt vmcnt(0)" ::: "memory");
        } else {
            XB_SPIN(xb_ld(&bar[XB_XGEN(b.x)]) == gen, bar);
            __builtin_amdgcn_fence(__ATOMIC_ACQUIRE, "agent");
            asm volatile("s_waitcnt vmcnt(0)" ::: "memory");
        }
    }
    __syncthreads();
}

namespace pg8 {
constexpr int BM = 256, BK = 64, HALF = 128, HTB = HALF * BK * 2, STAGE_BYTES = 8 * HTB, NXCD = 8, WGM = 8;
__host__ __device__ __forceinline__ int lds_byte(int r, int c) { const int st = (r >> 4) * 2 + (c >> 5), rr = r & 15, cc = c & 31, ob = rr * 64 + cc * 2; return st * 1024 + (ob ^ (((ob >> 9) & 1) << 5)); }
__host__ __device__ __forceinline__ void stage_rc(int b, int& R, int& C) { const int st = b / 1024, sb = b % 1024, swz = sb ^ (((sb >> 9) & 1) << 5); R = (st >> 1) * 16 + swz / 64; C = (st & 1) * 32 + (swz % 64) / 2; }
__host__ __device__ __forceinline__ int perm32(int rho) { const int n = rho >> 4, i = rho & 15; return 8 * (i >> 2) + 4 * n + (i & 3); }

struct Unit { int pm, pn, aux; long aoff, boff; };
struct Gemm { const bf16_t* A; const bf16_t* Bt; int lda, ldb, K, rmulB; long hstepA, hstepB; };
__device__ __forceinline__ Gemm mk_gemm(const bf16_t* A, int lda, const bf16_t* Bt, int ldb, int K) { Gemm g; g.A = A; g.Bt = Bt; g.lda = lda; g.ldb = ldb; g.K = K; g.rmulB = 1; g.hstepA = (long)HALF * lda * 2; g.hstepB = (long)HALF * ldb * 2; return g; }

template <class Epi, class Sched>
__device__ __forceinline__ void gemm_phase(LAS unsigned char* lds, const Gemm g, const Sched& S, const Epi& E, int wave_) {
    const int tid = tid_of(wave_),
              wid = __builtin_amdgcn_readfirstlane(tid >> 6), lane = tid & 63, wr = wid >> 2, wc = wid & 3, fr = lane & 15, fq = lane >> 4;
    const int K = g.K, nt = K / BK;
    unsigned voffA[2], voffB[2];
#pragma unroll
    for (int i = 0; i < 2; ++i) { int R, C; stage_rc(tid * 16 + i * 8192, R, C); const int Rb = (R & ~31) + perm32(R & 31);
        voffA[i] = (unsigned)(R * g.lda + C) * 2u; voffB[i] = (unsigned)(Rb * g.rmulB * g.ldb + C) * 2u; }
    const size_t kstep = (size_t)(BK * 2);
    const long hstepA = g.hstepA, hstepB = g.hstepB;
    const unsigned ldsw = (unsigned)wid * 1024u;
    const int aoff = lds_byte(wr * 64 + fr, fq * 8), boff = lds_byte(wc * 32 + fr, fq * 8);
#define PG8_SA(b, h) (((b) * 2 + (h)) * HTB)
#define PG8_SB(b, h) ((4 + (b) * 2 + (h)) * HTB)
#define PG8_STAGE(bufoff, gbase, voff) do { _Pragma("unroll") for (int _i = 0; _i < 2; ++_i) \
        __builtin_amdgcn_global_load_lds((const unsigned*)((const char*)(gbase) + (voff)[_i]), (LAS unsigned*)(lds + (bufoff) + ldsw + _i * 8192), 16, 0, 0); } while (0)
#define PG8_LDA(dst, b, h) do { _Pragma("unroll") for (int m = 0; m < 4; ++m) _Pragma("unroll") for (int k = 0; k < 2; ++k) dst[m][k] = *(const LAS bf16x8*)(lds + PG8_SA(b, h) + aoff + m * 2048 + k * 1024); } while (0)
#define PG8_LDB(dst, b, h) do { _Pragma("unroll") for (int n = 0; n < 2; ++n) _Pragma("unroll") for (int k = 0; k < 2; ++k) dst[n][k] = *(const LAS bf16x8*)(lds + PG8_SB(b, h) + boff + n * 2048 + k * 1024); } while (0)
#define PG8_MMA(ai, bj, At, Bt) do { __builtin_amdgcn_s_setprio(1); _Pragma("unroll") for (int m = 0; m < 4; ++m) _Pragma("unroll") for (int n = 0; n < 2; ++n) _Pragma("unroll") for (int k = 0; k < 2; ++k) \
        acc[ai][bj][m][n] = __builtin_amdgcn_mfma_f32_16x16x32_bf16(Bt[n][k], At[m][k], acc[ai][bj][m][n], 0, 0, 0); __builtin_amdgcn_s_setprio(0); } while (0)
#define PG8_WAIT_V(n) asm volatile("s_waitcnt vmcnt(" #n ")" ::: "memory")
#define PG8_WAIT_L(n) asm volatile("s_waitcnt lgkmcnt(" #n ")" ::: "memory")
#define PG8_BAR __builtin_amdgcn_s_barrier()
#define PG8_SCHED __builtin_amdgcn_sched_barrier(0)
    Unit cur, nxt; int ui = 0;
    if (!S.next(0, cur)) return;
    f32x4 acc[2][2][4][2];
#pragma unroll
    for (int a = 0; a < 2; ++a)
#pragma unroll
        for (int b = 0; b < 2; ++b)
#pragma unroll
            for (int m = 0; m < 4; ++m)
#pragma unroll
                for (int n = 0; n < 2; ++n) acc[a][b][m][n] = (f32x4){0.f, 0.f, 0.f, 0.f};
    bf16x8 At[4][2], B0[2][2], B1[2][2];
    const char* cA = (const char*)g.A + cur.aoff; const char* cB = (const char*)g.Bt + cur.boff;
    PG8_STAGE(PG8_SB(0, 0), cB, voffB); PG8_STAGE(PG8_SB(0, 1), cB + hstepB, voffB); PG8_STAGE(PG8_SA(0, 0), cA, voffA); PG8_STAGE(PG8_SA(0, 1), cA + hstepA, voffA);
    if (wr == 1) PG8_BAR;
    PG8_WAIT_V(2); PG8_BAR;
    PG8_STAGE(PG8_SB(1, 0), cB + kstep, voffB); PG8_STAGE(PG8_SA(1, 0), cA + kstep, voffA); PG8_STAGE(PG8_SB(1, 1), cB + hstepB + kstep, voffB);
    PG8_WAIT_V(6); PG8_BAR;
    for (;;) {
        const bool has_next = S.next(ui + 1, nxt);
        const char* nA = has_next ? (const char*)g.A + nxt.aoff : cA; const char* nB = has_next ? (const char*)g.Bt + nxt.boff : cB;
        for (int t = 0; t < nt; t += 2) {
            const bool last = (t == nt - 2);
            const char* a1 = cA + (size_t)(t + 1) * kstep;
            const char* a2 = last ? nA : cA + (size_t)(t + 2) * kstep; const char* b2 = last ? nB : cB + (size_t)(t + 2) * kstep;
            const char* a3 = a2 + kstep; const char* b3 = b2 + kstep;
            PG8_LDB(B0, 0, 0); PG8_LDB(B1, 0, 1); PG8_SCHED; PG8_LDA(At, 0, 0); PG8_STAGE(PG8_SA(1, 1), a1 + hstepA, voffA);
            PG8_WAIT_V(8); PG8_WAIT_L(0); PG8_BAR; PG8_MMA(0, 0, At, B0); PG8_MMA(0, 1, At, B1); PG8_BAR; PG8_SCHED;
            PG8_LDA(At, 0, 1); PG8_STAGE(PG8_SB(0, 0), b2, voffB); PG8_STAGE(PG8_SB(0, 1), b2 + hstepB, voffB); PG8_STAGE(PG8_SA(0, 0), a2, voffA);
            PG8_WAIT_V(8); PG8_WAIT_L(0); PG8_BAR; PG8_MMA(1, 0, At, B0); PG8_MMA(1, 1, At, B1); PG8_BAR; PG8_SCHED;
            PG8_LDB(B0, 1, 0); PG8_LDB(B1, 1, 1); PG8_SCHED; PG8_LDA(At, 1, 0); PG8_STAGE(PG8_SA(0, 1), a2 + hstepA, voffA);
            PG8_WAIT_V(8); PG8_WAIT_L(0); PG8_BAR; PG8_MMA(0, 0, At, B0); PG8_MMA(0, 1, At, B1); PG8_BAR; PG8_SCHED;
            PG8_LDA(At, 1, 1); PG8_STAGE(PG8_SB(1, 0), b3, voffB); PG8_STAGE(PG8_SB(1, 1), b3 + hstepB, voffB); PG8_STAGE(PG8_SA(1, 0), a3, voffA);
            PG8_WAIT_V(8); PG8_WAIT_L(0); PG8_BAR; PG8_MMA(1, 0, At, B0); PG8_MMA(1, 1, At, B1); PG8_BAR; PG8_SCHED;
        }
        if (wr == 0) PG8_BAR;
        E(acc, cur, wr, wc, fr, fq);
        if (!has_next) break;
#pragma unroll
        for (int a = 0; a < 2; ++a)
#pragma unroll
            for (int b = 0; b < 2; ++b)
#pragma unroll
                for (int m = 0; m < 4; ++m)
#pragma unroll
                    for (int n = 0; n < 2; ++n) acc[a][b][m][n] = (f32x4){0.f, 0.f, 0.f, 0.f};
        cur = nxt; cA = nA; cB = nB; ++ui;
        if (wr == 1) PG8_BAR;
    }
    PG8_WAIT_V(0);
    PG8_BAR;
#undef PG8_SA
#undef PG8_SB
#undef PG8_STAGE
#undef PG8_LDA
#undef PG8_LDB
#undef PG8_MMA
#undef PG8_WAIT_V
#undef PG8_WAIT_L
#undef PG8_BAR
#undef PG8_SCHED
}

struct TileOrder {
    int nM, nN, nwg, G, c, xpm, xlo, xn, sn, sdiv; long tA, tB, sA0, sB0;
    __device__ __forceinline__ void init(int nM_, int nN_, int G_, int c_, long tA_, long tB_) { nM = nM_; nN = nN_; nwg = nM * nN; G = G_; c = c_; tA = tA_; tB = tB_; xpm = 0; xlo = 0; xn = 0; sn = 0; sdiv = 1; sA0 = 0; sB0 = 0; }
    __device__ __forceinline__ bool next(int i, Unit& u) const {
        const long L = (long)i * G + c;
        if (L < nwg) {
            int wgid = (int)L; { const int q = nwg / NXCD, r = nwg % NXCD, xcd = wgid % NXCD, off = wgid / NXCD; wgid = (xcd < r ? xcd * (q + 1) : r * (q + 1) + (xcd - r) * q) + off; }
            const int nig = WGM * nN, gid = wgid / nig, fm = gid * WGM, gsz = (nM - fm) < WGM ? (nM - fm) : WGM;
            u.pm = fm + ((wgid % nig) % gsz); u.pn = (wgid % nig) / gsz;
        } else if (L < nwg + xn) { u.pm = xpm; u.pn = xlo + (int)(L - nwg); }
        else if (L < nwg + xn + sn) { const int k = (int)(L - nwg - xn); u.pm = k / sdiv; u.pn = 1000 + k % sdiv; u.aux = 0; u.aoff = sA0 + (long)u.pm * tB; u.boff = sB0 + (long)(k % sdiv) * tA; return true; }
        else return false;
        u.aux = 0; u.aoff = u.pm * tA; u.boff = u.pn * tB; return true;
    }
};
struct F1Order { int G, c;
    __device__ __forceinline__ bool next(int i, Unit& u) const { const int L = i * G + c; if (L >= 512) return false;
        u.pn = L & 63; u.pm = (L >> 6) & 1; u.aux = L >> 7; u.aoff = (long)u.pm * 256 * 256 * 2; u.boff = (long)u.aux * 512 + (long)(2 * u.pn) * FD * 2; return true; } };
struct F1cOrder { int G, c;
    __device__ __forceinline__ bool next(int i, Unit& u) const { const int L = i * G + c; if (L >= 8) return false;
        u.pn = 0; u.pm = L & 1; u.aux = L >> 1; u.aoff = (long)u.pm * 256 * 256 * 2; u.boff = ((long)SEQ * FD + u.aux * 256) * 2; return true; } };
struct LinOrder { int G, c, n; long tB;
    __device__ __forceinline__ bool next(int i, Unit& u) const { const int L = i * G + c; if (L >= n) return false;
        u.pn = L; u.pm = 0; u.aux = 0; u.aoff = 0; u.boff = (long)L * tB; return true; } };
struct SplitKOrder { int G, c, nN, S, pmv; long abase, tB, ksb;
    __device__ __forceinline__ bool next(int i, Unit& u) const { const int L = i * G + c; if (L >= nN * S) return false;
        u.pn = L % nN; u.aux = L / nN; u.pm = pmv; u.aoff = abase + (long)u.aux * ksb; u.boff = (long)u.pn * tB + (long)u.aux * ksb; return true; } };
struct MoeOrder { int G, c, nN; int cum[9]; long tA, tB, eB;
    __device__ __forceinline__ bool next(int i, Unit& u) const { const int L = i * G + c; const int T = cum[8]; if (L >= T * nN) return false;
        const int nwg = T * nN; int wgid = L; { const int q = nwg / NXCD, r = nwg % NXCD, xcd = wgid % NXCD, off = wgid / NXCD; wgid = (xcd < r ? xcd * (q + 1) : r * (q + 1) + (xcd - r) * q) + off; }
        constexpr int MWG = 4;
        const int nig = MWG * nN, gid = wgid / nig, fm = gid * MWG, gsz = (T - fm) < MWG ? (T - fm) : MWG;
        const int ti = fm + ((wgid % nig) % gsz), pn = (wgid % nig) / gsz; int e = 0;
#pragma unroll
        for (int k = 1; k < 8; ++k) e += (ti >= cum[k]) ? 1 : 0;
        u.pm = ti; u.pn = pn; u.aux = e; u.aoff = (long)ti * tA; u.boff = (long)e * eB + (long)pn * tB; return true; } };

#define EPI_ARGS const f32x4 (&acc)[2][2][4][2], const Unit& u, int wr, int wc, int fr, int fq
__device__ __forceinline__ u32x4 pack8(f32x4 v0, f32x4 v1) { u32x4 w; w.x = cvt_pk_bf16(v0[0], v0[1]); w.y = cvt_pk_bf16(v0[2], v0[3]); w.z = cvt_pk_bf16(v1[0], v1[1]); w.w = cvt_pk_bf16(v1[2], v1[3]); return w; }
__device__ __forceinline__ void unpack8(u32x4 w, f32x4& v0, f32x4& v1) { v0 = (f32x4){bflo(w.x), bfhi(w.x), bflo(w.y), bfhi(w.y)}; v1 = (f32x4){bflo(w.z), bfhi(w.z), bflo(w.w), bfhi(w.w)}; }

struct EpiInProj {
    bf16_t *Q, *Kb, *Vb, *Fb, *Gb; const float* bgate; bf16_t* Vt;
    __device__ __forceinline__ void operator()(EPI_ARGS) const {
        if (u.pn >= 1000) {
            const int row0 = u.pm * BM + wr * 64 + fr, col0 = (u.pn - 1000) * BM + wc * 32 + 8 * fq;
#pragma unroll
            for (int ai = 0; ai < 2; ++ai)
#pragma unroll
                for (int m = 0; m < 4; ++m) { bf16_t* rowp = Vt + (size_t)(row0 + ai * HALF + m * 16) * MR + col0;
#pragma unroll
                    for (int bj = 0; bj < 2; ++bj) *(u32x4*)(rowp + bj * HALF) = pack8(acc[ai][bj][m][0], acc[ai][bj][m][1]); }
            return; }
        const int pn = u.pn; bf16_t* base; int ldc, c0; bool sig = false;
        if (pn < 8) { base = Q; ldc = QW; c0 = pn * 256; }
        else if (pn < 10) { base = Kb; ldc = KVW; c0 = (pn - 8) * 256; }
        else if (pn < 12) { base = Vb; ldc = KVW; c0 = (pn - 10) * 256; }
        else if (pn < 16) { base = Fb; ldc = FD; c0 = (pn - 12) * 256; }
        else { base = Gb; ldc = GW2; c0 = (pn - 16) * 256; sig = true; }
        const int row0 = u.pm * BM + wr * 64 + fr, col0 = c0 + wc * 32 + 8 * fq;
        f32x4 bv[2][2];
#pragma unroll
        for (int bj = 0; bj < 2; ++bj)
#pragma unroll
            for (int n = 0; n < 2; ++n) bv[bj][n] = sig ? *(const f32x4*)(bgate + col0 + bj * HALF + 4 * n) : (f32x4){0.f, 0.f, 0.f, 0.f};
#pragma unroll
        for (int ai = 0; ai < 2; ++ai)
#pragma unroll
            for (int m = 0; m < 4; ++m) { bf16_t* rowp = base + (size_t)(row0 + ai * HALF + m * 16) * ldc + col0;
#pragma unroll
                for (int bj = 0; bj < 2; ++bj) { f32x4 v0 = acc[ai][bj][m][0] + bv[bj][0], v1 = acc[ai][bj][m][1] + bv[bj][1];
                    if (sig) {
#pragma unroll
                        for (int j = 0; j < 4; ++j) { v0[j] = sigmoidf_(v0[j]); v1[j] = sigmoidf_(v1[j]); } }
                    *(u32x4*)(rowp + bj * HALF) = pack8(v0, v1); } }
    }
};
struct EpiF1 {
    bf16_t* ZA;
    __device__ __forceinline__ void operator()(EPI_ARGS) const {
        const int g = u.aux, reim = u.pm;
#pragma unroll
        for (int ai = 0; ai < 2; ++ai)
#pragma unroll
            for (int m = 0; m < 4; ++m) { const int mm = ai * HALF + wr * 64 + m * 16 + fr;
#pragma unroll
                for (int bj = 0; bj < 2; ++bj) { const int a = 2 * u.pn + bj, b = wc * 32 + 8 * fq;
                    *(u32x4*)(ZA + ((size_t)((g * 256 + mm) * 128 + a) * 256 + reim * 128 + b)) = pack8(acc[ai][bj][m][0], acc[ai][bj][m][1]); } }
    }
};
struct EpiF1c {
    bf16_t* ZC;
    __device__ __forceinline__ void operator()(EPI_ARGS) const {
        const int g = u.aux, reim = u.pm;
#pragma unroll
        for (int ai = 0; ai < 2; ++ai)
#pragma unroll
            for (int m = 0; m < 4; ++m) { const int mm = ai * HALF + wr * 64 + m * 16 + fr;
#pragma unroll
                for (int bj = 0; bj < 2; ++bj) { const int n = bj * HALF + wc * 32 + 8 * fq;
                    *(u32x4*)(ZC + ((size_t)(g * 256 + mm) * 512 + reim * 256 + n)) = pack8(acc[ai][bj][m][0], acc[ai][bj][m][1]); } }
    }
};
struct EpiF2 {
    bf16_t* YB;
    __device__ __forceinline__ void operator()(EPI_ARGS) const {
#pragma unroll
        for (int m = 0; m < 4; ++m) { int ka = wr * 64 + m * 16 + fr; asm volatile("" : "+v"(ka));
#pragma unroll
            for (int bj = 0; bj < 2; ++bj) { const int gm = 2 * u.pn + bj, g = gm >> 8, mm = gm & 255, a0 = wc * 32 + 8 * fq;
                f32x4 re[2], im[2];
#pragma unroll
                for (int n = 0; n < 2; ++n)
#pragma unroll
                    for (int j = 0; j < 4; ++j) { const int a = a0 + 4 * n + j; const float t = (float)(a * ka) * (1.0f / 16384.0f);
                        const float c = __builtin_amdgcn_cosf(t), s = __builtin_amdgcn_sinf(t);
                        const float yr = acc[0][bj][m][n][j], yi = acc[1][bj][m][n][j];
                        re[n][j] = yr * c + yi * s; im[n][j] = yi * c - yr * s; }
                bf16_t* p = YB + ((size_t)((g * 128 + ka) * 256 + mm) * 256 + a0);
                *(u32x4*)p = pack8(re[0], re[1]); *(u32x4*)(p + 128) = pack8(im[0], im[1]); asm volatile("" ::: "memory"); } }
    }
};
struct EpiF3 {
    bf16_t* FOUR;
    __device__ __forceinline__ void operator()(EPI_ARGS) const {
        const int g = u.pn >> 7, ka = u.pn & 127;
#pragma unroll
        for (int m = 0; m < 4; ++m) { const int kb = wr * 64 + m * 16 + fr;
#pragma unroll
            for (int bj = 0; bj < 2; ++bj) { const int mm = bj * HALF + wc * 32 + 8 * fq;
                *(u32x4*)(FOUR + ((size_t)(128 * kb + ka) * FD + g * 256 + mm)) = pack8(acc[0][bj][m][0], acc[0][bj][m][1]); } }
    }
};
struct EpiF3c {
    bf16_t* FOUR;
    __device__ __forceinline__ void operator()(EPI_ARGS) const {
#pragma unroll
        for (int ai = 0; ai < 2; ++ai)
#pragma unroll
            for (int m = 0; m < 4; ++m) { const int k = ai * HALF + wr * 64 + m * 16 + fr;
#pragma unroll
                for (int bj = 0; bj < 2; ++bj) { const int mm = bj * HALF + wc * 32 + 8 * fq;
                    *(u32x4*)(FOUR + ((size_t)(SEQ + k) * FD + u.pn * 256 + mm)) = pack8(acc[ai][bj][m][0], acc[ai][bj][m][1]); } }
    }
};
template <int SECOND> struct EpiMerge {
    bf16_t* Y; const bf16_t* Gb;
    __device__ __forceinline__ void operator()(EPI_ARGS) const {
        const int row0 = u.pm * BM + wr * 64 + fr, col0 = u.pn * BM + wc * 32 + 8 * fq;
#pragma unroll
        for (int ai = 0; ai < 2; ++ai)
#pragma unroll
            for (int m = 0; m < 4; ++m) { const size_t row = (size_t)(row0 + ai * HALF + m * 16);
#pragma unroll
                for (int bj = 0; bj < 2; ++bj) { const int col = col0 + bj * HALF;
                    f32x4 g0, g1; unpack8(*(const u32x4*)(Gb + row * GW2 + SECOND * DM + col), g0, g1);
                    f32x4 v0 = acc[ai][bj][m][0] * g0, v1 = acc[ai][bj][m][1] * g1;
                    bf16_t* yp = Y + row * DM + col;
                    if (SECOND) { f32x4 y0, y1; unpack8(*(const u32x4*)yp, y0, y1); v0 += y0; v1 += y1; }
                    *(u32x4*)yp = pack8(v0, v1); } }
    }
};
struct EpiRes {
    const float* baseF; const bf16_t* baseB; bf16_t* outB; const float* gateL; const float* baseC; float* outC; const float* gateC;
    __device__ __forceinline__ void operator()(EPI_ARGS) const {
        const bool isc = u.pm >= SEQ / BM; const float* gate = isc ? gateC : gateL;
        const int row0 = (isc ? 0 : u.pm * BM) + wr * 64 + fr, col0 = u.pn * BM + wc * 32 + 8 * fq;
        f32x4 gv[2][2];
#pragma unroll
        for (int bj = 0; bj < 2; ++bj)
#pragma unroll
            for (int n = 0; n < 2; ++n) gv[bj][n] = *(const f32x4*)(gate + col0 + bj * HALF + 4 * n);
#pragma unroll
        for (int ai = 0; ai < 2; ++ai)
#pragma unroll
            for (int m = 0; m < 4; ++m) { const size_t off = (size_t)(row0 + ai * HALF + m * 16) * DM + col0;
#pragma unroll
                for (int bj = 0; bj < 2; ++bj) {
                    if (isc) {
#pragma unroll
                        for (int n = 0; n < 2; ++n) { const f32x4 b = *(const f32x4*)(baseC + off + bj * HALF + 4 * n); *(f32x4*)(outC + off + bj * HALF + 4 * n) = b + gv[bj][n] * acc[ai][bj][m][n]; }
                    } else {
                        f32x4 b0, b1;
                        if (baseB) unpack8(*(const u32x4*)(baseB + off + bj * HALF), b0, b1);
                        else { b0 = *(const f32x4*)(baseF + off + bj * HALF); b1 = *(const f32x4*)(baseF + off + bj * HALF + 4); }
                        *(u32x4*)(outB + off + bj * HALF) = pack8(b0 + gv[bj][0] * acc[ai][bj][m][0], b1 + gv[bj][1] * acc[ai][bj][m][1]); } }
                asm volatile("" ::: "memory"); }
    }
};
struct EpiPartial {
    float* part; const float* gate;
    __device__ __forceinline__ void operator()(EPI_ARGS) const {
        const int row0 = wr * 64 + fr, col0 = u.pn * BM + wc * 32 + 8 * fq; float* pbase = part + (size_t)u.aux * CTXL * DM;
        f32x4 gv[2][2];
#pragma unroll
        for (int bj = 0; bj < 2; ++bj)
#pragma unroll
            for (int n = 0; n < 2; ++n) gv[bj][n] = gate ? *(const f32x4*)(gate + col0 + bj * HALF + 4 * n) : (f32x4){1.f, 1.f, 1.f, 1.f};
#pragma unroll
        for (int ai = 0; ai < 2; ++ai)
#pragma unroll
            for (int m = 0; m < 4; ++m) { float* rowp = pbase + (size_t)(row0 + ai * HALF + m * 16) * DM + col0;
#pragma unroll
                for (int bj = 0; bj < 2; ++bj)
#pragma unroll
                    for (int n = 0; n < 2; ++n) *(f32x4*)(rowp + bj * HALF + 4 * n) = gv[bj][n] * acc[ai][bj][m][n]; }
    }
};
struct EpiSwiglu {
    bf16_t* U; int ldu;
    __device__ __forceinline__ void operator()(EPI_ARGS) const {
        const int row0 = u.pm * BM + wr * 64 + fr, col0 = u.pn * HALF + wc * 32 + 8 * fq;
#pragma unroll
        for (int ai = 0; ai < 2; ++ai)
#pragma unroll
            for (int m = 0; m < 4; ++m) { f32x4 o[2];
#pragma unroll
                for (int n = 0; n < 2; ++n)
#pragma unroll
                    for (int j = 0; j < 4; ++j) { const float gt = acc[ai][0][m][n][j], up = acc[ai][1][m][n][j]; o[n][j] = gt * sigmoidf_(gt) * up; }
                *(u32x4*)(U + (size_t)(row0 + ai * HALF + m * 16) * ldu + col0) = pack8(o[0], o[1]); }
    }
};
struct EpiPlain {
    bf16_t* O; int ldc;
    __device__ __forceinline__ void operator()(EPI_ARGS) const {
        const int row0 = u.pm * BM + wr * 64 + fr, col0 = u.pn * BM + wc * 32 + 8 * fq;
#pragma unroll
        for (int ai = 0; ai < 2; ++ai)
#pragma unroll
            for (int m = 0; m < 4; ++m) { bf16_t* rowp = O + (size_t)(row0 + ai * HALF + m * 16) * ldc + col0;
#pragma unroll
                for (int bj = 0; bj < 2; ++bj) *(u32x4*)(rowp + bj * HALF) = pack8(acc[ai][bj][m][0], acc[ai][bj][m][1]); }
    }
};
}

namespace at {
using bf16 = __hip_bfloat16;
constexpr int D = 128, NW = 8, QBLK = 32, KVBLK = 64;
constexpr float SCALE = 0.088388347648318440f;
constexpr float THR = 8.f;
constexpr int LDQ = QW, LDK = KVW, LDO = QW;
constexpr size_t SHM_V = KVBLK * D * 2, SHM_K = KVBLK * D * 2, SHM_ATTN = 2 * SHM_V + 2 * SHM_K + NW * 64 * 4;
#define KSWZ(row, colB) ((row) * 256 + ((colB) ^ (((row) & 15) << 4)))
#define SBAR() __builtin_amdgcn_sched_barrier(0)
__device__ __forceinline__ int crow(int r, int hi) { return (r & 3) + 8 * (r >> 2) + 4 * hi; }
__device__ __forceinline__ unsigned cvtpk(float lo, float hi) { unsigned r; asm volatile("v_cvt_pk_bf16_f32 %0, %1, %2" : "=v"(r) : "v"(lo), "v"(hi)); return r; }
__device__ __forceinline__ void partialSM(f32x16& p0, f32x16& p1, float& m_reg, float& mn, float& alpha) {
  constexpr float C = 1.0f;
  float pmax = p0[0]; for (int r = 1; r < 16; ++r) pmax = fmaxf(pmax, p0[r]); for (int r = 0; r < 16; ++r) pmax = fmaxf(pmax, p1[r]);
  { auto rr = __builtin_amdgcn_permlane32_swap(__float_as_uint(pmax), __float_as_uint(pmax), false, false);
    pmax = fmaxf(__uint_as_float(rr[0]), __uint_as_float(rr[1])); }
  if (__builtin_expect(__all(pmax - m_reg <= THR * 1.4426950408889634f), 1)) { mn = m_reg; alpha = 1.f; }
  else { mn = fmaxf(m_reg, pmax); alpha = __builtin_amdgcn_exp2f((m_reg - mn) * C); m_reg = mn; }
  float mnC = -mn * C;
  for (int r = 0; r < 16; ++r) p0[r] = fmaf(p0[r], C, mnC); for (int r = 0; r < 16; ++r) p1[r] = fmaf(p1[r], C, mnC);
  for (int r = 0; r < 16; ++r) p0[r] = __builtin_amdgcn_exp2f(p0[r]);
}
__device__ __forceinline__ void finishSM(f32x16& p0, f32x16& p1, float alpha, float& l_reg, bf16x8& pa0, bf16x8& pa1, bf16x8& pa2, bf16x8& pa3) {
  for (int r = 0; r < 16; ++r) p1[r] = __builtin_amdgcn_exp2f(p1[r]);
  float ps = 0; for (int r = 0; r < 16; ++r) ps += p0[r]; for (int r = 0; r < 16; ++r) ps += p1[r];
  { auto rr = __builtin_amdgcn_permlane32_swap(__float_as_uint(ps), __float_as_uint(ps), false, false);
    ps = __uint_as_float(rr[0]) + __uint_as_float(rr[1]); }
  l_reg = l_reg * alpha + ps;
#define PK4(P, BASE, OUT) do { unsigned a0 = cvtpk(P[BASE + 0], P[BASE + 1]), a1 = cvtpk(P[BASE + 2], P[BASE + 3]);   \
    unsigned b0 = cvtpk(P[BASE + 4], P[BASE + 5]), b1 = cvtpk(P[BASE + 6], P[BASE + 7]);                              \
    auto r0 = __builtin_amdgcn_permlane32_swap(a0, b0, false, false); auto r1 = __builtin_amdgcn_permlane32_swap(a1, b1, false, false); \
    u32x4 w = {r0[0], r1[0], r0[1], r1[1]}; OUT = *reinterpret_cast<bf16x8*>(&w); } while (0)
  PK4(p0, 0, pa0); PK4(p0, 8, pa1); PK4(p1, 0, pa2); PK4(p1, 8, pa3);
#undef PK4
}
__device__ __forceinline__ void qkt(f32x16& p0, f32x16& p1, const bf16* Ks, const bf16x8* qr, int r32, int hi) {
  p0 = f32x16{}; p1 = f32x16{};
  for (int d0 = 0; d0 < 8; ++d0) { int cb = (d0 * 16 + hi * 8) * 2;
    bf16x8 b0 = *reinterpret_cast<const bf16x8*>((const char*)Ks + KSWZ(r32, cb));
    bf16x8 b1 = *reinterpret_cast<const bf16x8*>((const char*)Ks + KSWZ(32 + r32, cb));
    p0 = __builtin_amdgcn_mfma_f32_32x32x16_bf16(b0, qr[d0], p0, 0, 0, 0);
    p1 = __builtin_amdgcn_mfma_f32_32x32x16_bf16(b1, qr[d0], p1, 0, 0, 0); }
}
__device__ __forceinline__ int v_st(int k, int c) { const int kk = (k & ~0xC) | ((k & 4) << 1) | ((k & 8) >> 1); return ((kk >> 3) * 4 + (c >> 5)) * 512 + ((kk & 7) * 32 + (c & 31)) * 2; }
__device__ __forceinline__ int v_rd_base(int lane) { return ((lane & 3) << 3) | (((lane >> 2) & 3) << 6) | (((lane >> 4) & 1) << 5) | (((lane >> 5) & 1) << 8); }
constexpr int v_rd_off(int d0, int ks, int half) { return d0 * 512 + ks * 4096 + half * 2048; }
template <int OFF> __device__ __forceinline__ s16x4 tr_read(int vb) {
  s16x4 r; asm volatile("ds_read_b64_tr_b16 %0, %1 offset:%2" : "=&v"(r) : "v"(vb), "i"(OFF) : "memory"); return r;
}
template <int D0> __device__ __forceinline__ void pv_one(f32x16& od, int vb, bf16x8 pa0, bf16x8 pa1, bf16x8 pa2, bf16x8 pa3) {
  const s16x4 l0 = tr_read<v_rd_off(D0, 0, 0)>(vb), h0 = tr_read<v_rd_off(D0, 0, 1)>(vb), l1 = tr_read<v_rd_off(D0, 1, 0)>(vb), h1 = tr_read<v_rd_off(D0, 1, 1)>(vb);
  const s16x4 l2 = tr_read<v_rd_off(D0, 2, 0)>(vb), h2 = tr_read<v_rd_off(D0, 2, 1)>(vb), l3 = tr_read<v_rd_off(D0, 3, 0)>(vb), h3 = tr_read<v_rd_off(D0, 3, 1)>(vb);
  asm volatile("s_waitcnt lgkmcnt(0)" ::: "memory"); SBAR();
#define PK(L, H) (bf16x8){L[0], L[1], L[2], L[3], H[0], H[1], H[2], H[3]}
  od = __builtin_amdgcn_mfma_f32_32x32x16_bf16(pa0, PK(l0, h0), od, 0, 0, 0);
  od = __builtin_amdgcn_mfma_f32_32x32x16_bf16(pa1, PK(l1, h1), od, 0, 0, 0);
  od = __builtin_amdgcn_mfma_f32_32x32x16_bf16(pa2, PK(l2, h2), od, 0, 0, 0);
  od = __builtin_amdgcn_mfma_f32_32x32x16_bf16(pa3, PK(l3, h3), od, 0, 0, 0);
#undef PK
}
__device__ __forceinline__ void pv_d0(f32x16* o, int vb, bf16x8 pa0, bf16x8 pa1, bf16x8 pa2, bf16x8 pa3) {
  pv_one<0>(o[0], vb, pa0, pa1, pa2, pa3); pv_one<1>(o[1], vb, pa0, pa1, pa2, pa3); pv_one<2>(o[2], vb, pa0, pa1, pa2, pa3); pv_one<3>(o[3], vb, pa0, pa1, pa2, pa3);
}
__device__ __forceinline__ void q_prologue(bf16x8 (&qr)[8], const float* __restrict__ qg, const float* __restrict__ rope, int tok, int hi) {
  constexpr float QC = SCALE * 1.4426950408889634f;
  float x[8][8]; float ss = 0.f;
#pragma unroll
  for (int d0 = 0; d0 < 8; ++d0)
#pragma unroll
    for (int j = 0; j < 8; ++j) { x[d0][j] = __builtin_bit_cast(float, (unsigned)(unsigned short)qr[d0][j] << 16); ss += x[d0][j] * x[d0][j]; }
  { auto rr = __builtin_amdgcn_permlane32_swap(__float_as_uint(ss), __float_as_uint(ss), false, false); ss = __uint_as_float(rr[0]) + __uint_as_float(rr[1]); }
  const float rs = QC / sqrtf(ss * (1.0f / D) + 1e-6f);
#pragma unroll
  for (int d0 = 0; d0 < 8; ++d0) { const f32x4 g0 = *(const f32x4*)(qg + 16 * d0 + 8 * hi), g1 = *(const f32x4*)(qg + 16 * d0 + 8 * hi + 4);
#pragma unroll
    for (int j = 0; j < 4; ++j) { x[d0][j] *= rs * g0[j]; x[d0][4 + j] *= rs * g1[j]; } }
  if (tok >= 0) {
#pragma unroll
    for (int a = 0; a < 2; ++a) { const int pos = a ? (tok & 63) : (tok >> 6); const float* ct = rope + (a ? 16384 : 0) + pos * 32 + 8 * hi; const float* st = ct + (a ? 2048 : 8192);
#pragma unroll
      for (int e = 0; e < 2; ++e) { const f32x4 c0 = *(const f32x4*)(ct + 16 * e), c1 = *(const f32x4*)(ct + 16 * e + 4), s0 = *(const f32x4*)(st + 16 * e), s1 = *(const f32x4*)(st + 16 * e + 4);
#pragma unroll
        for (int j = 0; j < 8; ++j) { const float c = j < 4 ? c0[j & 3] : c1[j & 3], sn = j < 4 ? s0[j & 3] : s1[j & 3]; const float lo = x[4 * a + e][j], hh = x[4 * a + 2 + e][j];
          x[4 * a + e][j] = lo * c - hh * sn; x[4 * a + 2 + e][j] = hh * c + lo * sn; } } } }
#pragma unroll
  for (int d0 = 0; d0 < 8; ++d0) { u32x4 w = {cvtpk(x[d0][0], x[d0][1]), cvtpk(x[d0][2], x[d0][3]), cvtpk(x[d0][4], x[d0][5]), cvtpk(x[d0][6], x[d0][7])}; qr[d0] = *reinterpret_cast<bf16x8*>(&w); }
}
__device__ __forceinline__ void attn_dense_body(const bf16* Qb, const bf16* __restrict__ Kh, const bf16* __restrict__ Vh, bf16* Ob, int seq, char* lds, int wave_, const float* qg, const float* rope, int tok0) {
  const int tid = tid_of(wave_), wid = tid >> 6, lane = tid & 63, r32 = lane & 31, hi = lane >> 5;
  bf16* V_lds = (bf16*)lds; bf16* K_lds = (bf16*)(lds + 2 * SHM_V);
  float* ws = (float*)(lds + 2 * SHM_V + 2 * SHM_K) + wid * 64; float* li_l = ws; float* al_l = ws + 32;
  float m_reg = -1e30f, l_reg = 0; f32x16 o[4] = {}; bf16x8 qr[8];
  const bf16* Qw = Qb + (long)(wid * QBLK + r32) * LDQ + hi * 8;
#pragma unroll
  for (int d0 = 0; d0 < 8; ++d0) qr[d0] = *reinterpret_cast<const bf16x8*>(Qw + d0 * 16);
  q_prologue(qr, qg, rope, tok0 < 0 ? -1 : tok0 + wid * QBLK + r32, hi);
  const int sr = tid >> 4, sc = (tid & 15) * 8, vst0 = v_st(sr, sc), vst1 = v_st(32 + sr, sc);
  const int vb0 = (int)(uintptr_t)V_lds + v_rd_base(lane);
  struct { bf16x8 vs0, vs1, ks0, ks1; } sr_[2];
#define SLOAD(i, k0) do { sr_[i].vs0 = *(const bf16x8*)(&Vh[(long)((k0) + sr) * LDK + sc]); sr_[i].vs1 = *(const bf16x8*)(&Vh[(long)((k0) + 32 + sr) * LDK + sc]); \
    sr_[i].ks0 = *(const bf16x8*)(&Kh[(long)((k0) + sr) * LDK + sc]); sr_[i].ks1 = *(const bf16x8*)(&Kh[(long)((k0) + 32 + sr) * LDK + sc]); } while (0)
#define SWRITE(b, i) do { *(bf16x8*)((char*)V_lds + (b) * SHM_V + vst0) = sr_[i].vs0;          \
    *(bf16x8*)((char*)V_lds + (b) * SHM_V + vst1) = sr_[i].vs1; int kc = sc * 2;               \
    *(bf16x8*)((char*)K_lds + (b) * SHM_K + KSWZ(sr, kc)) = sr_[i].ks0;                       \
    *(bf16x8*)((char*)K_lds + (b) * SHM_K + KSWZ(32 + sr, kc)) = sr_[i].ks1; } while (0)
#define SWAIT() asm volatile("s_waitcnt vmcnt(4)" ::: "memory")
#define RESC(a) do { if (__any((a) < 1.f)) { if (hi == 0) al_l[r32] = (a); asm volatile("s_waitcnt lgkmcnt(0)" ::: "memory"); \
    for (int d = 0; d < 4; ++d) for (int r = 0; r < 16; ++r) o[d][r] *= al_l[crow(r, hi)]; } } while (0)
  f32x16 pA0, pA1, pB0, pB1; float mnA, mnB, alA, alB; bf16x8 pa0, pa1, pa2, pa3; const int NT = seq / KVBLK;
  constexpr int SE = 0, SO = 1;
  SLOAD(SE, 0); asm volatile("s_waitcnt vmcnt(0)" ::: "memory"); SWRITE(0, SE); __syncthreads();
  qkt(pA0, pA1, K_lds, qr, r32, hi); partialSM(pA0, pA1, m_reg, mnA, alA);
  SLOAD(SO, KVBLK); if (2 < NT) SLOAD(SE, 2 * KVBLK);
  SWAIT(); SWRITE(1, SO); __syncthreads();
  for (int j = 1; j + 1 < NT; j += 2) {
    SBAR(); qkt(pB0, pB1, (bf16*)((char*)K_lds + SHM_K), qr, r32, hi);
    finishSM(pA0, pA1, alA, l_reg, pa0, pa1, pa2, pa3); SBAR();
    SLOAD(SO, (j + 2) * KVBLK); SBAR();
    pv_d0(o, vb0, pa0, pa1, pa2, pa3); partialSM(pB0, pB1, m_reg, mnB, alB);
    __syncthreads(); SWAIT(); SWRITE(0, SE);
    RESC(alB); __syncthreads();
    SBAR(); qkt(pA0, pA1, K_lds, qr, r32, hi);
    finishSM(pB0, pB1, alB, l_reg, pa0, pa1, pa2, pa3); SBAR();
    if (j + 3 < NT) SLOAD(SE, (j + 3) * KVBLK); SBAR();
    pv_d0(o, vb0 + (int)SHM_V, pa0, pa1, pa2, pa3); partialSM(pA0, pA1, m_reg, mnA, alA);
    __syncthreads(); SWAIT(); SWRITE(1, SO);
    RESC(alA); __syncthreads();
  }
  SBAR(); qkt(pB0, pB1, (bf16*)((char*)K_lds + SHM_K), qr, r32, hi);
  finishSM(pA0, pA1, alA, l_reg, pa0, pa1, pa2, pa3); SBAR();
  pv_d0(o, vb0, pa0, pa1, pa2, pa3); partialSM(pB0, pB1, m_reg, mnB, alB);
  __syncthreads(); RESC(alB);
  finishSM(pB0, pB1, alB, l_reg, pa0, pa1, pa2, pa3); SBAR();
  pv_d0(o, vb0 + (int)SHM_V, pa0, pa1, pa2, pa3);
  if (hi == 0) li_l[r32] = l_reg; asm volatile("s_waitcnt lgkmcnt(0)" ::: "memory");
  float rli[16];
#pragma unroll
  for (int r = 0; r < 16; ++r) rli[r] = __builtin_amdgcn_rcpf(li_l[crow(r, hi)]);
  unsigned short* Ow = (unsigned short*)Ob + (long)(wid * QBLK) * LDO;
#pragma unroll
  for (int r = 0; r < 16; ++r) { int orow = crow(r, hi);
    for (int d0 = 0; d0 < 4; ++d0) Ow[(long)orow * LDO + d0 * 32 + r32] = (unsigned short)f2bf(o[d0][r] * rli[r]); }
  __syncthreads();
#undef SLOAD
#undef SWRITE
#undef SWAIT
#undef RESC
}

__device__ __forceinline__ void expA(f32x16& p, float negBC) {
  (void)negBC;
  for (int r = 0; r < 16; ++r) p[r] = __builtin_amdgcn_exp2f(p[r]);
}
__device__ __forceinline__ void finishFX(f32x16& p0, f32x16& p1, float negBC, float& l_reg, bf16x8& pa0, bf16x8& pa1, bf16x8& pa2, bf16x8& pa3) {
  expA(p1, negBC);
  float ps = 0; for (int r = 0; r < 16; ++r) ps += p0[r]; for (int r = 0; r < 16; ++r) ps += p1[r];
  l_reg += ps;
#define PK4(P, BASE, OUT) do { unsigned a0 = cvtpk(P[BASE + 0], P[BASE + 1]), a1 = cvtpk(P[BASE + 2], P[BASE + 3]);   \
    unsigned b0 = cvtpk(P[BASE + 4], P[BASE + 5]), b1 = cvtpk(P[BASE + 6], P[BASE + 7]);                              \
    auto r0 = __builtin_amdgcn_permlane32_swap(a0, b0, false, false); auto r1 = __builtin_amdgcn_permlane32_swap(a1, b1, false, false); \
    u32x4 w = {r0[0], r1[0], r0[1], r1[1]}; OUT = *reinterpret_cast<bf16x8*>(&w); } while (0)
  PK4(p0, 0, pa0); PK4(p0, 8, pa1); PK4(p1, 0, pa2); PK4(p1, 8, pa3);
#undef PK4
}
__device__ __forceinline__ void attn_dense_body_fx(const bf16* Qb, const bf16* __restrict__ Kh, const bf16* __restrict__ Vh, bf16* Ob, int seq, char* lds, float negBC, int wave_) {
  const int tid = tid_of(wave_), wid = tid >> 6, lane = tid & 63, r32 = lane & 31, hi = lane >> 5;
  bf16* V_lds = (bf16*)lds; bf16* K_lds = (bf16*)(lds + 2 * SHM_V);
  float* ws = (float*)(lds + 2 * SHM_V + 2 * SHM_K) + wid * 64; float* li_l = ws;
  float l_reg = 0; f32x16 o[4] = {}; bf16x8 qr[8];
  const bf16* Qw = Qb + (long)(wid * QBLK + r32) * LDQ + hi * 8;
#pragma unroll
  for (int d0 = 0; d0 < 8; ++d0) qr[d0] = *reinterpret_cast<const bf16x8*>(Qw + d0 * 16);
  const int sr = tid >> 4, sc = (tid & 15) * 8, vst0 = v_st(sr, sc), vst1 = v_st(32 + sr, sc);
  const int vb0 = (int)(uintptr_t)V_lds + v_rd_base(lane);
  struct { bf16x8 vs0, vs1, ks0, ks1; } sr_[2];
#define SLOAD(i, k0) do { sr_[i].vs0 = *(const bf16x8*)(&Vh[(long)((k0) + sr) * LDK + sc]); sr_[i].vs1 = *(const bf16x8*)(&Vh[(long)((k0) + 32 + sr) * LDK + sc]); \
    sr_[i].ks0 = *(const bf16x8*)(&Kh[(long)((k0) + sr) * LDK + sc]); sr_[i].ks1 = *(const bf16x8*)(&Kh[(long)((k0) + 32 + sr) * LDK + sc]); } while (0)
#define SWRITE(b, i) do { *(bf16x8*)((char*)V_lds + (b) * SHM_V + vst0) = sr_[i].vs0;          \
    *(bf16x8*)((char*)V_lds + (b) * SHM_V + vst1) = sr_[i].vs1; int kc = sc * 2;               \
    *(bf16x8*)((char*)K_lds + (b) * SHM_K + KSWZ(sr, kc)) = sr_[i].ks0;                       \
    *(bf16x8*)((char*)K_lds + (b) * SHM_K + KSWZ(32 + sr, kc)) = sr_[i].ks1; } while (0)
#define SWAIT() asm volatile("s_waitcnt vmcnt(4)" ::: "memory")
  f32x16 pA0, pA1, pB0, pB1; bf16x8 pa0, pa1, pa2, pa3; const int NT = seq / KVBLK;
  constexpr int SE = 0, SO = 1;
  SLOAD(SE, 0); asm volatile("s_waitcnt vmcnt(0)" ::: "memory"); SWRITE(0, SE); __syncthreads();
  qkt(pA0, pA1, K_lds, qr, r32, hi); expA(pA0, negBC);
  SLOAD(SO, KVBLK); if (2 < NT) SLOAD(SE, 2 * KVBLK);
  SWAIT(); SWRITE(1, SO); __syncthreads();
  for (int j = 1; j + 1 < NT; j += 2) {
    SBAR(); qkt(pB0, pB1, (bf16*)((char*)K_lds + SHM_K), qr, r32, hi);
    finishFX(pA0, pA1, negBC, l_reg, pa0, pa1, pa2, pa3); SBAR();
    SLOAD(SO, (j + 2) * KVBLK); SBAR();
    pv_d0(o, vb0, pa0, pa1, pa2, pa3); expA(pB0, negBC);
    __syncthreads(); SWAIT(); SWRITE(0, SE);
    __syncthreads();
    SBAR(); qkt(pA0, pA1, K_lds, qr, r32, hi);
    finishFX(pB0, pB1, negBC, l_reg, pa0, pa1, pa2, pa3); SBAR();
    if (j + 3 < NT) SLOAD(SE, (j + 3) * KVBLK); SBAR();
    pv_d0(o, vb0 + (int)SHM_V, pa0, pa1, pa2, pa3); expA(pA0, negBC);
    __syncthreads(); SWAIT(); SWRITE(1, SO);
    __syncthreads();
  }
  SBAR(); qkt(pB0, pB1, (bf16*)((char*)K_lds + SHM_K), qr, r32, hi);
  finishFX(pA0, pA1, negBC, l_reg, pa0, pa1, pa2, pa3); SBAR();
  pv_d0(o, vb0, pa0, pa1, pa2, pa3); expA(pB0, negBC);
  __syncthreads();
  finishFX(pB0, pB1, negBC, l_reg, pa0, pa1, pa2, pa3); SBAR();
  pv_d0(o, vb0 + (int)SHM_V, pa0, pa1, pa2, pa3);
  { auto rr = __builtin_amdgcn_permlane32_swap(__float_as_uint(l_reg), __float_as_uint(l_reg), false, false); l_reg = __uint_as_float(rr[0]) + __uint_as_float(rr[1]); }
  if (hi == 0) li_l[r32] = l_reg; asm volatile("s_waitcnt lgkmcnt(0)" ::: "memory");
  float rli[16];
#pragma unroll
  for (int r = 0; r < 16; ++r) rli[r] = __builtin_amdgcn_rcpf(li_l[crow(r, hi)]);
  unsigned short* Ow = (unsigned short*)Ob + (long)(wid * QBLK) * LDO;
#pragma unroll
  for (int r = 0; r < 16; ++r) { int orow = crow(r, hi);
    for (int d0 = 0; d0 < 4; ++d0) Ow[(long)orow * LDO + d0 * 32 + r32] = (unsigned short)f2bf(o[d0][r] * rli[r]); }
  __syncthreads();
#undef SLOAD
#undef SWRITE
#undef SWAIT
}

template <bool FX>
__device__ __forceinline__ void attn_body_dma(const bf16* Qb, const bf16* __restrict__ Kh, const bf16* __restrict__ Vh, bf16* Ob, int seq, LAS unsigned char* ldsl, char* lds, float negBC, int wave_) {
  const int tid = tid_of(wave_), wid = __builtin_amdgcn_readfirstlane(tid >> 6), lane = tid & 63, r32 = lane & 31, hi = lane >> 5;
  constexpr int KRING = 0, VRING = 3 * 16384, SCR = 6 * 16384;
  float* ws = (float*)(lds + SCR) + wid * 64; float* li_l = ws; float* al_l = ws + 32;
  float m_reg = -1e30f, l_reg = 0; f32x16 o[4] = {}; bf16x8 qr[8];
  const bf16* Qw = Qb + (long)(wid * QBLK + r32) * LDQ + hi * 8;
#pragma unroll
  for (int d0 = 0; d0 < 8; ++d0) qr[d0] = *reinterpret_cast<const bf16x8*>(Qw + d0 * 16);
  unsigned kso[2], vso[2];
#pragma unroll
  for (int i = 0; i < 2; ++i) { const int q = i * 512 + tid;
    { const int row = q >> 4, c = (q & 15) ^ (row & 15); kso[i] = (unsigned)(row * LDK + c * 8) * 2u; }
    { const int b = q * 16, sub = b >> 9, within = b & 511, kk = (sub >> 2) * 8 + (within >> 6), cin = (within >> 1) & 31, k = (kk & ~0xC) | ((kk & 4) << 1) | ((kk & 8) >> 1), c = (sub & 3) * 32 + cin; vso[i] = (unsigned)(k * LDK + c) * 2u; } }
  const int NT = seq / KVBLK;
  const unsigned ldsw = (unsigned)wid * 1024u, ldsbase = (unsigned)(uintptr_t)ldsl;
#define GLDS16(gsrc, ldsdst) do { unsigned keep_; asm volatile("s_mov_b32 %0, m0\n\ts_mov_b32 m0, %2\n\ts_nop 0\n\tglobal_load_lds_dwordx4 %1, off\n\ts_mov_b32 m0, %0" : "=&s"(keep_) : "v"(gsrc), "s"(ldsdst) : "memory"); } while (0)
#define ISSUE_K(t, slot) do { const int tt_ = (t) < NT ? (t) : NT - 1; const char* kb_ = (const char*)Kh + (long)tt_ * (KVBLK * LDK * 2); _Pragma("unroll") for (int i_ = 0; i_ < 2; ++i_) \
    GLDS16((const void*)(kb_ + kso[i_]), ldsbase + (unsigned)(KRING + (slot) * 16384 + i_ * 8192) + ldsw); } while (0)
#define ISSUE_V(t, slot) do { const int tt_ = (t) < NT ? (t) : NT - 1; const char* vb_ = (const char*)Vh + (long)tt_ * (KVBLK * LDK * 2); _Pragma("unroll") for (int i_ = 0; i_ < 2; ++i_) \
    GLDS16((const void*)(vb_ + vso[i_]), ldsbase + (unsigned)(VRING + (slot) * 16384 + i_ * 8192) + ldsw); } while (0)
#define WAITBAR(N) asm volatile("s_waitcnt vmcnt(" #N ") lgkmcnt(0)\n\ts_barrier" ::: "memory")
#define RESC(a) do { if (__any((a) < 1.f)) { if (hi == 0) al_l[r32] = (a); asm volatile("s_waitcnt lgkmcnt(0)" ::: "memory"); \
    for (int d = 0; d < 4; ++d) for (int r = 0; r < 16; ++r) o[d][r] *= al_l[crow(r, hi)]; } } while (0)
  const int vb0 = (int)(uintptr_t)(lds + VRING) + v_rd_base(lane);
  const char* Kl = lds + KRING;
  f32x16 pA0, pA1, pB0, pB1; float mnA = 0, mnB = 0, alA = 1.f, alB = 1.f; bf16x8 pa0, pa1, pa2, pa3;
  ISSUE_K(0, 0); ISSUE_K(1, 1); ISSUE_V(0, 0); ISSUE_K(2, 2); ISSUE_V(1, 1);
  WAITBAR(8);
  qkt(pA0, pA1, (const bf16*)Kl, qr, r32, hi);
  if (FX) expA(pA0, negBC); else partialSM(pA0, pA1, m_reg, mnA, alA);
  WAITBAR(4);
  int s0 = 0, s1 = 1, s2 = 2;
  for (int j = 0; j < NT; j += 2) {
    ISSUE_K(j + 3, s0); ISSUE_V(j + 2, s2);
    SBAR(); qkt(pB0, pB1, (const bf16*)(Kl + s1 * 16384), qr, r32, hi);
    if (FX) finishFX(pA0, pA1, negBC, l_reg, pa0, pa1, pa2, pa3); else finishSM(pA0, pA1, alA, l_reg, pa0, pa1, pa2, pa3);
    SBAR();
    pv_d0(o, vb0 + s0 * 16384, pa0, pa1, pa2, pa3);
    if (FX) expA(pB0, negBC); else { partialSM(pB0, pB1, m_reg, mnB, alB); RESC(alB); }
    WAITBAR(4);
    ISSUE_K(j + 4, s1); ISSUE_V(j + 3, s0);
    const bool more = (j + 2 < NT);
    SBAR(); if (more) qkt(pA0, pA1, (const bf16*)(Kl + s2 * 16384), qr, r32, hi);
    if (FX) finishFX(pB0, pB1, negBC, l_reg, pa0, pa1, pa2, pa3); else finishSM(pB0, pB1, alB, l_reg, pa0, pa1, pa2, pa3);
    SBAR();
    pv_d0(o, vb0 + s1 * 16384, pa0, pa1, pa2, pa3);
    if (more) { if (FX) expA(pA0, negBC); else { partialSM(pA0, pA1, m_reg, mnA, alA); RESC(alA); } }
    WAITBAR(4);
    { const int t0 = s0, t1 = s1; s0 = s2; s1 = t0; s2 = t1; }
  }
  asm volatile("s_waitcnt vmcnt(0)" ::: "memory");
  if (FX) { auto rr = __builtin_amdgcn_permlane32_swap(__float_as_uint(l_reg), __float_as_uint(l_reg), false, false); l_reg = __uint_as_float(rr[0]) + __uint_as_float(rr[1]); }
  if (hi == 0) li_l[r32] = l_reg; asm volatile("s_waitcnt lgkmcnt(0)" ::: "memory");
  float rli[16];
#pragma unroll
  for (int r = 0; r < 16; ++r) rli[r] = __builtin_amdgcn_rcpf(li_l[crow(r, hi)]);
  unsigned short* Ow = (unsigned short*)Ob + (long)(wid * QBLK) * LDO;
#pragma unroll
  for (int r = 0; r < 16; ++r) { int orow = crow(r, hi);
    for (int d0 = 0; d0 < 4; ++d0) Ow[(long)orow * LDO + d0 * 32 + r32] = (unsigned short)f2bf(o[d0][r] * rli[r]); }
  asm volatile("s_waitcnt lgkmcnt(0)\n\ts_barrier" ::: "memory");
#undef GLDS16
#undef ISSUE_K
#undef ISSUE_V
#undef WAITBAR
#undef RESC
}

__device__ __forceinline__ void pk4x(const f32x16& P, int BASE, bf16x8& OUT) {
  unsigned a0 = cvtpk(P[BASE + 0], P[BASE + 1]), a1 = cvtpk(P[BASE + 2], P[BASE + 3]), b0 = cvtpk(P[BASE + 4], P[BASE + 5]), b1 = cvtpk(P[BASE + 6], P[BASE + 7]);
  auto r0 = __builtin_amdgcn_permlane32_swap(a0, b0, false, false); auto r1 = __builtin_amdgcn_permlane32_swap(a1, b1, false, false);
  u32x4 w = {r0[0], r1[0], r0[1], r1[1]}; OUT = *reinterpret_cast<bf16x8*>(&w);
}
template <int D0, int KS0> __device__ __forceinline__ void pv_half(f32x16& od, int vb, bf16x8 pa, bf16x8 pb) {
  const s16x4 l0 = tr_read<v_rd_off(D0, KS0, 0)>(vb), h0 = tr_read<v_rd_off(D0, KS0, 1)>(vb), l1 = tr_read<v_rd_off(D0, KS0 + 1, 0)>(vb), h1 = tr_read<v_rd_off(D0, KS0 + 1, 1)>(vb);
  asm volatile("s_waitcnt lgkmcnt(0)" ::: "memory"); SBAR();
#define PK(L, H) (bf16x8){L[0], L[1], L[2], L[3], H[0], H[1], H[2], H[3]}
  od = __builtin_amdgcn_mfma_f32_32x32x16_bf16(pa, PK(l0, h0), od, 0, 0, 0);
  od = __builtin_amdgcn_mfma_f32_32x32x16_bf16(pb, PK(l1, h1), od, 0, 0, 0);
#undef PK
}
__device__ __forceinline__ void attn_body_v2(const bf16* Qb, const bf16* __restrict__ Kh, const bf16* __restrict__ Vh, bf16* Ob, int seq, char* lds, float negBC, int wave_) {
  const int tid = tid_of(wave_), wid = tid >> 6, lane = tid & 63, r32 = lane & 31, hi = lane >> 5;
  bf16* V_lds = (bf16*)lds; bf16* K_lds = (bf16*)(lds + 2 * SHM_V);
  float* ws = (float*)(lds + 2 * SHM_V + 2 * SHM_K) + wid * 64; float* li_l = ws;
  float l_reg = 0; f32x16 o[4] = {}; bf16x8 qr[8];
  const bf16* Qw = Qb + (long)(wid * QBLK + r32) * LDQ + hi * 8;
#pragma unroll
  for (int d0 = 0; d0 < 8; ++d0) qr[d0] = *reinterpret_cast<const bf16x8*>(Qw + d0 * 16);
  const int sr = tid >> 4, sc = (tid & 15) * 8, vst0 = v_st(sr, sc), vst1 = v_st(32 + sr, sc);
  const int vb0 = (int)(uintptr_t)V_lds + v_rd_base(lane);
  struct { bf16x8 vs0, vs1, ks0, ks1; } sr_[2];
#define SLOAD(i, k0) do { sr_[i].vs0 = *(const bf16x8*)(&Vh[(long)((k0) + sr) * LDK + sc]); sr_[i].vs1 = *(const bf16x8*)(&Vh[(long)((k0) + 32 + sr) * LDK + sc]); \
    sr_[i].ks0 = *(const bf16x8*)(&Kh[(long)((k0) + sr) * LDK + sc]); sr_[i].ks1 = *(const bf16x8*)(&Kh[(long)((k0) + 32 + sr) * LDK + sc]); } while (0)
#define SWRITE(b, i) do { *(bf16x8*)((char*)V_lds + (b) * SHM_V + vst0) = sr_[i].vs0;          \
    *(bf16x8*)((char*)V_lds + (b) * SHM_V + vst1) = sr_[i].vs1; int kc = sc * 2;               \
    *(bf16x8*)((char*)K_lds + (b) * SHM_K + KSWZ(sr, kc)) = sr_[i].ks0;                       \
    *(bf16x8*)((char*)K_lds + (b) * SHM_K + KSWZ(32 + sr, kc)) = sr_[i].ks1; } while (0)
  const int NT = seq / KVBLK;
  f32x16 p0, p1; bf16x8 pa0, pa1, pa2, pa3;
#define TRR(dst, D0, KS, H) asm volatile("ds_read_b64_tr_b16 %0, %1 offset:%2" : "=&v"(dst) : "v"(vb_), "i"((D0) * 512 + (KS) * 4096 + (H) * 2048) : "memory")
#define RD4(x, D0, KS0) do { TRR(x##0_, D0, KS0, 0); TRR(x##1_, D0, KS0, 1); TRR(x##2_, D0, (KS0) + 1, 0); TRR(x##3_, D0, (KS0) + 1, 1); } while (0)
#define WAITL(N) asm volatile("s_waitcnt lgkmcnt(" #N ")" ::: "memory")
#define PKV(L, H) (bf16x8){L[0], L[1], L[2], L[3], H[0], H[1], H[2], H[3]}
#define MM2(od, pa, pb, x) do { od = __builtin_amdgcn_mfma_f32_32x32x16_bf16(pa, PKV(x##0_, x##1_), od, 0, 0, 0); od = __builtin_amdgcn_mfma_f32_32x32x16_bf16(pb, PKV(x##2_, x##3_), od, 0, 0, 0); } while (0)
#define TILE_COMPUTE(b) do { \
    const bf16* Ks_ = (const bf16*)((const char*)K_lds + (b) * SHM_K); const int vb_ = vb0 + (b) * (int)SHM_V; \
    p0 = f32x16{}; p1 = f32x16{}; \
    _Pragma("unroll") for (int d0 = 0; d0 < 8; ++d0) { const int cb = (d0 * 16 + hi * 8) * 2; \
      const bf16x8 b0 = *reinterpret_cast<const bf16x8*>((const char*)Ks_ + KSWZ(r32, cb)); p0 = __builtin_amdgcn_mfma_f32_32x32x16_bf16(b0, qr[d0], p0, 0, 0, 0); } \
    _Pragma("unroll") for (int d0 = 0; d0 < 8; ++d0) { const int cb = (d0 * 16 + hi * 8) * 2; \
      const bf16x8 b1 = *reinterpret_cast<const bf16x8*>((const char*)Ks_ + KSWZ(32 + r32, cb)); p1 = __builtin_amdgcn_mfma_f32_32x32x16_bf16(b1, qr[d0], p1, 0, 0, 0); } \
    { s16x4 ra0_, ra1_, ra2_, ra3_, rb0_, rb1_, rb2_, rb3_; \
      RD4(ra, 0, 0); RD4(rb, 1, 0);                                         \
      expA(p0, negBC); { float ps = 0; for (int r = 0; r < 16; ++r) ps += p0[r]; l_reg += ps; } pk4x(p0, 0, pa0); pk4x(p0, 8, pa1); \
      WAITL(4); SBAR(); MM2(o[0], pa0, pa1, ra); RD4(ra, 2, 0); WAITL(4); SBAR(); MM2(o[1], pa0, pa1, rb); RD4(rb, 3, 0); \
      WAITL(4); SBAR(); MM2(o[2], pa0, pa1, ra); WAITL(0); SBAR(); MM2(o[3], pa0, pa1, rb); \
      RD4(ra, 0, 2); RD4(rb, 1, 2);                                         \
      expA(p1, negBC); { float ps = 0; for (int r = 0; r < 16; ++r) ps += p1[r]; l_reg += ps; } pk4x(p1, 0, pa2); pk4x(p1, 8, pa3); \
      WAITL(4); SBAR(); MM2(o[0], pa2, pa3, ra); RD4(ra, 2, 2); WAITL(4); SBAR(); MM2(o[1], pa2, pa3, rb); RD4(rb, 3, 2); \
      WAITL(4); SBAR(); MM2(o[2], pa2, pa3, ra); WAITL(0); SBAR(); MM2(o[3], pa2, pa3, rb); } \
  } while (0)
  SLOAD(0, 0); asm volatile("s_waitcnt vmcnt(0)" ::: "memory"); SWRITE(0, 0);
  SLOAD(1, KVBLK); if (2 < NT) SLOAD(0, 2 * KVBLK);
  for (int j = 0; j < NT; j += 2) {
    asm volatile("s_waitcnt lgkmcnt(0)\n\ts_barrier" ::: "memory");
    if (j + 2 < NT) asm volatile("s_waitcnt vmcnt(4)" ::: "memory"); else asm volatile("s_waitcnt vmcnt(0)" ::: "memory");
    SWRITE(1, 1);
    if (j + 3 < NT) SLOAD(1, (j + 3) * KVBLK);
    SBAR(); TILE_COMPUTE(0);
    asm volatile("s_waitcnt lgkmcnt(0)\n\ts_barrier" ::: "memory");
    if (j + 2 < NT) { if (j + 3 < NT) asm volatile("s_waitcnt vmcnt(4)" ::: "memory"); else asm volatile("s_waitcnt vmcnt(0)" ::: "memory"); SWRITE(0, 0); }
    if (j + 4 < NT) SLOAD(0, (j + 4) * KVBLK);
    SBAR(); TILE_COMPUTE(1);
  }
  { auto rr = __builtin_amdgcn_permlane32_swap(__float_as_uint(l_reg), __float_as_uint(l_reg), false, false); l_reg = __uint_as_float(rr[0]) + __uint_as_float(rr[1]); }
  const int lane2 = tid_of(wave_) & 63, r32e = lane2 & 31, hie = lane2 >> 5;
  if (hie == 0) li_l[r32e] = l_reg; asm volatile("s_waitcnt lgkmcnt(0)" ::: "memory");
  float rli[16];
#pragma unroll
  for (int r = 0; r < 16; ++r) rli[r] = __builtin_amdgcn_rcpf(li_l[crow(r, hie)]);
  unsigned short* Ow = (unsigned short*)Ob + (long)(wid * QBLK) * LDO;
#pragma unroll
  for (int r = 0; r < 16; ++r) { int orow = crow(r, hie);
    for (int d0 = 0; d0 < 4; ++d0) Ow[(long)orow * LDO + d0 * 32 + r32e] = (unsigned short)f2bf(o[d0][r] * rli[r]); }
  __syncthreads();
#undef SLOAD
#undef SWRITE
#undef TILE_COMPUTE
#undef TRR
#undef RD4
#undef WAITL
#undef PKV
#undef MM2
}

#define TILE_BODY(BUFK, BUFV, WB, WS, NXT) do { \
    KRD(kf0, 0, (0) * 8192 + BUFK); \
    KRD(kf1, 1, (0) * 8192 + BUFK); \
    KRD(kf2, 2, (0) * 8192 + BUFK); \
    KRD(kf3, 3, (0) * 8192 + BUFK); \
    KRD(kf4, 4, (0) * 8192 + BUFK); \
    KRD(kf5, 5, (0) * 8192 + BUFK); \
    WMFMA_Z(4, p0, kf0, qr[0]); \
    KRD(kf0, 6, (0) * 8192 + BUFK); \
    MFMA_A(p0, kf1, qr[1]); \
    KRD(kf1, 7, (0) * 8192 + BUFK); \
    DSW0(WB, WS); \
    WMFMA_A(5, p0, kf2, qr[2]); \
    KRD(kf2, 0, (1) * 8192 + BUFK); \
    MFMA_A(p0, kf3, qr[3]); \
    KRD(kf3, 1, (1) * 8192 + BUFK); \
    DSW1(WB, WS); \
    WMFMA_A(6, p0, kf4, qr[4]); \
    KRD(kf4, 2, (1) * 8192 + BUFK); \
    MFMA_A(p0, kf5, qr[5]); \
    KRD(kf5, 3, (1) * 8192 + BUFK); \
    DSW2(WB, WS); \
    WMFMA_A(7, p0, kf0, qr[6]); \
    KRD(kf0, 4, (1) * 8192 + BUFK); \
    MFMA_A(p0, kf1, qr[7]); \
    KRD(kf1, 5, (1) * 8192 + BUFK); \
    DSW3(WB, WS); \
    WMFMA_Z(7, p1, kf2, qr[0]); \
    KRD(kf2, 6, (1) * 8192 + BUFK); \
    SLOADN(WS, NXT); \
    MFMA_A(p1, kf3, qr[1]); \
    KRD(kf3, 7, (1) * 8192 + BUFK); \
    TIE(p0); \
    EXPN(p0, 0, 4); \
    WMFMA_A(6, p1, kf4, qr[2]); \
    TIE(p0); \
    EXPN(p0, 4, 4); \
    MFMA_A(p1, kf5, qr[3]); \
    TIE(p0); \
    SUM8(p0, 0); pk4x(p0, 0, pa0); \
    WMFMA_A(3, p1, kf0, qr[4]); \
    TIE3(p0, l2, pa0); \
    EXPN(p0, 8, 4); \
    TRR(ra0_, (0) * 512 + (0) * 4096 + (0) * 2048 + BUFV); \
    TRR(ra1_, (0) * 512 + (0) * 4096 + (1) * 2048 + BUFV); \
    TRR(ra2_, (0) * 512 + (1) * 4096 + (0) * 2048 + BUFV); \
    TRR(ra3_, (0) * 512 + (1) * 4096 + (1) * 2048 + BUFV); \
    MFMA_A(p1, kf1, qr[5]); \
    TIE(p0); \
    EXPN(p0, 12, 4); \
    TRR(rb0_, (1) * 512 + (0) * 4096 + (0) * 2048 + BUFV); \
    TRR(rb1_, (1) * 512 + (0) * 4096 + (1) * 2048 + BUFV); \
    TRR(rb2_, (1) * 512 + (1) * 4096 + (0) * 2048 + BUFV); \
    TRR(rb3_, (1) * 512 + (1) * 4096 + (1) * 2048 + BUFV); \
    WMFMA_A(8, p1, kf2, qr[6]); \
    TIE(p0); \
    SUM8(p0, 8); pk4x(p0, 8, pa1); \
    MFMA_A(p1, kf3, qr[7]); \
    TIE3(p0, l2, pa1); \
    WMM2(4, o[0], pa0, pa1, ra); \
    TRR(ra0_, (2) * 512 + (0) * 4096 + (0) * 2048 + BUFV); \
    TRR(ra1_, (2) * 512 + (0) * 4096 + (1) * 2048 + BUFV); \
    TRR(ra2_, (2) * 512 + (1) * 4096 + (0) * 2048 + BUFV); \
    TRR(ra3_, (2) * 512 + (1) * 4096 + (1) * 2048 + BUFV); \
    TIE(p1); \
    EXPN(p1, 0, 8); \
    WMM2(4, o[1], pa0, pa1, rb); \
    TRR(rb0_, (3) * 512 + (0) * 4096 + (0) * 2048 + BUFV); \
    TRR(rb1_, (3) * 512 + (0) * 4096 + (1) * 2048 + BUFV); \
    TRR(rb2_, (3) * 512 + (1) * 4096 + (0) * 2048 + BUFV); \
    TRR(rb3_, (3) * 512 + (1) * 4096 + (1) * 2048 + BUFV); \
    TIE(p1); \
    SUM8(p1, 0); pk4x(p1, 0, pa2); \
    WMM2(4, o[2], pa0, pa1, ra); \
    TRR(ra0_, (0) * 512 + (2) * 4096 + (0) * 2048 + BUFV); \
    TRR(ra1_, (0) * 512 + (2) * 4096 + (1) * 2048 + BUFV); \
    TRR(ra2_, (0) * 512 + (3) * 4096 + (0) * 2048 + BUFV); \
    TRR(ra3_, (0) * 512 + (3) * 4096 + (1) * 2048 + BUFV); \
    TIE3(p1, l2, pa2); \
    EXPN(p1, 8, 8); \
    WMM2(4, o[3], pa0, pa1, rb); \
    TRR(rb0_, (1) * 512 + (2) * 4096 + (0) * 2048 + BUFV); \
    TRR(rb1_, (1) * 512 + (2) * 4096 + (1) * 2048 + BUFV); \
    TRR(rb2_, (1) * 512 + (3) * 4096 + (0) * 2048 + BUFV); \
    TRR(rb3_, (1) * 512 + (3) * 4096 + (1) * 2048 + BUFV); \
    TIE(p1); \
    SUM8(p1, 8); pk4x(p1, 8, pa3); \
    TIE3(p1, l2, pa3); \
    WMM2(4, o[0], pa2, pa3, ra); \
    TRR(ra0_, (2) * 512 + (2) * 4096 + (0) * 2048 + BUFV); \
    TRR(ra1_, (2) * 512 + (2) * 4096 + (1) * 2048 + BUFV); \
    TRR(ra2_, (2) * 512 + (3) * 4096 + (0) * 2048 + BUFV); \
    TRR(ra3_, (2) * 512 + (3) * 4096 + (1) * 2048 + BUFV); \
    WMM2(4, o[1], pa2, pa3, rb); \
    TRR(rb0_, (3) * 512 + (2) * 4096 + (0) * 2048 + BUFV); \
    TRR(rb1_, (3) * 512 + (2) * 4096 + (1) * 2048 + BUFV); \
    TRR(rb2_, (3) * 512 + (3) * 4096 + (0) * 2048 + BUFV); \
    TRR(rb3_, (3) * 512 + (3) * 4096 + (1) * 2048 + BUFV); \
    WMM2(4, o[2], pa2, pa3, ra); \
    WMM2(0, o[3], pa2, pa3, rb); \
  } while (0)

__device__ __forceinline__ void attn_body_v3(const bf16* Qb, const bf16* __restrict__ Kh, const bf16* __restrict__ Vh, bf16* Ob, int seq, char* lds, int wave_) {
  const int tid = tid_of(wave_), wid = tid >> 6, lane = tid & 63, r32 = lane & 31, hi = lane >> 5;
  bf16* V_lds = (bf16*)lds; bf16* K_lds = (bf16*)(lds + 4 * SHM_V);
  float* ws = (float*)(lds + 133120) + wid * 64; float* li_l = ws;
  f32x2 l2 = {0.f, 0.f}; f32x16 o[4] = {}; bf16x8 qr[8];
  const bf16* Qw = Qb + (long)(wid * QBLK + r32) * LDQ + hi * 8;
#pragma unroll
  for (int d0 = 0; d0 < 8; ++d0) qr[d0] = *reinterpret_cast<const bf16x8*>(Qw + d0 * 16);
  asm volatile("s_waitcnt vmcnt(0)" : "+v"(qr[0]), "+v"(qr[1]), "+v"(qr[2]), "+v"(qr[3]), "+v"(qr[4]), "+v"(qr[5]), "+v"(qr[6]), "+v"(qr[7]));
  const int sr = tid >> 4, sc = (tid & 15) * 8, vst0 = v_st(sr, sc), vst1 = v_st(32 + sr, sc);
  const int vb_ = (int)(uintptr_t)V_lds + v_rd_base(lane);
  const int kbase_ = (int)(uintptr_t)K_lds + r32 * 256 + ((hi ^ (r32 & 1)) << 4), kt_ = (r32 & 15) >> 1;
  const int kaddr0 = kbase_ + ((0 ^ kt_) << 5), kaddr1 = kbase_ + ((1 ^ kt_) << 5), kaddr2 = kbase_ + ((2 ^ kt_) << 5), kaddr3 = kbase_ + ((3 ^ kt_) << 5),
            kaddr4 = kbase_ + ((4 ^ kt_) << 5), kaddr5 = kbase_ + ((5 ^ kt_) << 5), kaddr6 = kbase_ + ((6 ^ kt_) << 5), kaddr7 = kbase_ + ((7 ^ kt_) << 5);
  const int vwa0 = (int)(uintptr_t)V_lds + vst0, vwa1 = (int)(uintptr_t)V_lds + vst1, kwa0 = (int)(uintptr_t)K_lds + KSWZ(sr, sc * 2), kwa1 = (int)(uintptr_t)K_lds + KSWZ(32 + sr, sc * 2);
  const unsigned goff0 = (unsigned)(sr * LDK + sc) * 2u, goff1 = goff0 + 32u * LDK * 2u;
  struct { bf16x8 vs0, vs1, ks0, ks1; } sr_[2];
#define GLD16S(dst, voff, sbase) asm volatile("global_load_dwordx4 %0, %1, %2" : "=&v"(dst) : "v"(voff), "s"(sbase) : "memory")
#define SLOAD(i, k0) do { const char* vb__ = (const char*)Vh + (long)(k0) * (LDK * 2); const char* kb__ = (const char*)Kh + (long)(k0) * (LDK * 2); \
    GLD16S(sr_[i].vs0, goff0, vb__); GLD16S(sr_[i].vs1, goff1, vb__); GLD16S(sr_[i].ks0, goff0, kb__); GLD16S(sr_[i].ks1, goff1, kb__); } while (0)
#define SLOADP(i) do { GLD16S(sr_[i].vs0, goff0, vnext_); GLD16S(sr_[i].vs1, goff1, vnext_); GLD16S(sr_[i].ks0, goff0, knext_); GLD16S(sr_[i].ks1, goff1, knext_); \
    vnext_ += KVBLK * LDK * 2; knext_ += KVBLK * LDK * 2; } while (0)
#define SWRITE(b, i) do { *(bf16x8*)((char*)V_lds + (b) * SHM_V + vst0) = sr_[i].vs0;          \
    *(bf16x8*)((char*)V_lds + (b) * SHM_V + vst1) = sr_[i].vs1; int kc = sc * 2;               \
    *(bf16x8*)((char*)K_lds + (b) * SHM_K + KSWZ(sr, kc)) = sr_[i].ks0;                       \
    *(bf16x8*)((char*)K_lds + (b) * SHM_K + KSWZ(32 + sr, kc)) = sr_[i].ks1; } while (0)
#define DSW0(WB, WS) asm volatile("s_waitcnt vmcnt(4)\n\tds_write_b128 %0, %1 offset:%2" :: "v"(vwa0), "v"(sr_[WS].vs0), "i"(WB) : "memory")
#define DSW1(WB, WS) asm volatile("ds_write_b128 %0, %1 offset:%2" :: "v"(vwa1), "v"(sr_[WS].vs1), "i"(WB) : "memory")
#define DSW2(WB, WS) asm volatile("ds_write_b128 %0, %1 offset:%2" :: "v"(kwa0), "v"(sr_[WS].ks0), "i"(WB) : "memory")
#define DSW3(WB, WS) asm volatile("ds_write_b128 %0, %1 offset:%2" :: "v"(kwa1), "v"(sr_[WS].ks1), "i"(WB) : "memory")
#define SLOADN(WS, T) SLOADP(WS)
#define KRD(dst, bq, imm) asm volatile("ds_read_b128 %0, %1 offset:%2" : "=&v"(dst) : "v"(kaddr##bq), "i"(imm) : "memory")
#define TRR(dst, imm) asm volatile("ds_read_b64_tr_b16 %0, %1 offset:%2" : "=&v"(dst) : "v"(vb_), "i"(imm) : "memory")
#define WAITL(N) asm volatile("s_waitcnt lgkmcnt(" #N ")" ::: "memory")
#define PKV(L, H) (bf16x8){L[0], L[1], L[2], L[3], H[0], H[1], H[2], H[3]}
#define MFMA_Z(acc, a, b) asm volatile("v_mfma_f32_32x32x16_bf16 %0, %1, %2, 0" : "=&v"(acc) : "v"(a), "v"(b))
#define MFMA_A(acc, a, b) asm volatile("v_mfma_f32_32x32x16_bf16 %0, %1, %2, %0" : "+v"(acc) : "v"(a), "v"(b))
#define WMFMA_Z(n, acc, a, b) asm volatile("s_waitcnt lgkmcnt(" #n ")\n\tv_mfma_f32_32x32x16_bf16 %0, %1, %2, 0" : "=&v"(acc) : "v"(a), "v"(b) : "memory")
#define WMFMA_A(n, acc, a, b) asm volatile("s_waitcnt lgkmcnt(" #n ")\n\tv_mfma_f32_32x32x16_bf16 %0, %1, %2, %0" : "+v"(acc) : "v"(a), "v"(b) : "memory")
#define WMM2(n, od, pa, pb, x) do { asm volatile("s_waitcnt lgkmcnt(" #n ")\n\tv_mfma_f32_32x32x16_bf16 %0, %1, %2, %0" : "+v"(od) : "v"(pa), "v"(PKV(x##0_, x##1_)) : "memory"); \
    asm volatile("v_mfma_f32_32x32x16_bf16 %0, %1, %2, %0" : "+v"(od) : "v"(pb), "v"(PKV(x##2_, x##3_))); } while (0)
#define TIE(p) asm volatile("" : "+v"(p))
#define TIE3(p, a, b) asm volatile("" : "+v"(p), "+v"(a), "+v"(b))
#define MM2(od, pa, pb, x) do { asm volatile("s_nop 1\n\tv_mfma_f32_32x32x16_bf16 %0, %1, %2, %0" : "+v"(od) : "v"(pa), "v"(PKV(x##0_, x##1_))); \
    asm volatile("v_mfma_f32_32x32x16_bf16 %0, %1, %2, %0" : "+v"(od) : "v"(pb), "v"(PKV(x##2_, x##3_))); } while (0)
#define EXPN(p, lo, n) do { _Pragma("unroll") for (int r_ = (lo); r_ < (lo) + (n); ++r_) p[r_] = __builtin_amdgcn_exp2f(p[r_]); } while (0)
#define SUM8(p, lo) do { _Pragma("unroll") for (int r_ = (lo); r_ < (lo) + 8; r_ += 2) l2 += (f32x2){p[r_], p[r_ + 1]}; } while (0)
  const int NT = seq / KVBLK;
  f32x16 p0, p1; bf16x8 pa0, pa1, pa2, pa3, kf0, kf1, kf2, kf3, kf4, kf5; s16x4 ra0_, ra1_, ra2_, ra3_, rb0_, rb1_, rb2_, rb3_;
  SLOAD(0, 0); SLOAD(1, KVBLK); asm volatile("s_waitcnt vmcnt(0)" ::: "memory"); SWRITE(0, 0); SWRITE(1, 1);
  const char* vnext_ = (const char*)Vh + 2L * KVBLK * LDK * 2; const char* knext_ = (const char*)Kh + 2L * KVBLK * LDK * 2;
  SLOADN(0, 2); SLOADN(1, 3);
  for (int j = 0; j < NT; j += 4) {
    asm volatile("s_waitcnt lgkmcnt(0)\n\ts_barrier" ::: "memory");
    TILE_BODY(0, 0, 32768, 0, j + 4);
    TILE_BODY(16384, 16384, 49152, 1, j + 5);
    asm volatile("s_waitcnt lgkmcnt(0)\n\ts_barrier" ::: "memory");
    TILE_BODY(32768, 32768, 0, 0, j + 6);
    TILE_BODY(49152, 49152, 16384, 1, j + 7);
  }
  asm volatile("s_nop 15\n\ts_nop 15" : "+v"(o[0]), "+v"(o[1]), "+v"(o[2]), "+v"(o[3]));
  float l_reg = l2.x + l2.y;
  { auto rr = __builtin_amdgcn_permlane32_swap(__float_as_uint(l_reg), __float_as_uint(l_reg), false, false); l_reg = __uint_as_float(rr[0]) + __uint_as_float(rr[1]); }
  const int lane2 = tid_of(wave_) & 63, r32e = lane2 & 31, hie = lane2 >> 5;
  if (hie == 0) li_l[r32e] = l_reg; asm volatile("s_waitcnt lgkmcnt(0)" ::: "memory");
  float rli[16];
#pragma unroll
  for (int r = 0; r < 16; ++r) rli[r] = __builtin_amdgcn_rcpf(li_l[crow(r, hie)]);
  unsigned short* Ow = (unsigned short*)Ob + (long)(wid * QBLK) * LDO;
#pragma unroll
  for (int r = 0; r < 16; ++r) { int orow = crow(r, hie);
    for (int d0 = 0; d0 < 4; ++d0) Ow[(long)orow * LDO + d0 * 32 + r32e] = (unsigned short)f2bf(o[d0][r] * rli[r]); }
  __syncthreads();
#undef SLOAD
#undef SLOADP
#undef GLD16S
#undef SWRITE
#undef DSW0
#undef DSW1
#undef DSW2
#undef DSW3
#undef SLOADN
#undef KRD
#undef TRR
#undef WAITL
#undef PKV
#undef MM2
#undef EXPN
#undef SUM8
#undef MFMA_Z
#undef MFMA_A
#undef WMFMA_Z
#undef WMFMA_A
#undef WMM2
#undef TIE
#undef TIE3
}
#undef TILE_BODY

#define TILE_BODY(BUFK, BUFV, WB, WS, NXT) do { \
    KRD(kf0, 0, (0) * 8192 + BUFK); \
    KRD(kf1, 1, (0) * 8192 + BUFK); \
    KRD(kf2, 2, (0) * 8192 + BUFK); \
    KRD(kf3, 3, (0) * 8192 + BUFK); \
    KRD(kf4, 4, (0) * 8192 + BUFK); \
    KRD(kf5, 5, (0) * 8192 + BUFK); \
    WMFMA_Z_KR(4, p0, kf0, qr[0], kf0, 6, (0) * 8192 + BUFK); \
    MFMA_A_KR(p0, kf1, qr[1], kf1, 7, (0) * 8192 + BUFK); \
    DSWK0(WB, WS); \
    WMFMA_A_KR(5, p0, kf2, qr[2], kf2, 0, (1) * 8192 + BUFK); \
    DSWK1(WB, WS); \
    MFMA_A_KR(p0, kf3, qr[3], kf3, 1, (1) * 8192 + BUFK); \
    DSWV0(WB, WS); \
    WMFMA_A_KR(7, p0, kf4, qr[4], kf4, 2, (1) * 8192 + BUFK); \
    DSWV1(WB, WS); \
    MFMA_A_KR(p0, kf5, qr[5], kf5, 3, (1) * 8192 + BUFK); \
    DSWV2(WB, WS); \
    WMFMA_A_KR(9, p0, kf0, qr[6], kf0, 4, (1) * 8192 + BUFK); \
    DSWV3(WB, WS); \
    MFMA_A_KR(p0, kf1, qr[7], kf1, 5, (1) * 8192 + BUFK); \
    WMFMA_Z_KR(8, p1, kf2, qr[0], kf2, 6, (1) * 8192 + BUFK); \
    SLOADN(WS, NXT); \
    MFMA_A_KR(p1, kf3, qr[1], kf3, 7, (1) * 8192 + BUFK); \
    TIE(p0); \
    EXPN(p0, 0, 4); \
    WMFMA_A(6, p1, kf4, qr[2]); \
    TIE(p0); \
    EXPN(p0, 4, 4); \
    MFMA_A(p1, kf5, qr[3]); \
    TIE(p0); \
    SUM8(p0, 0); PACK8(p0, 0, pb0); \
    WMFMA_A(2, p1, kf0, qr[4]); \
    TIE3(p0, l2, pb0); \
    EXPN(p0, 8, 4); \
    VRD(ra0_, 0, (0) * 4096 + BUFV); \
    VRD(ra1_, 1, (0) * 4096 + BUFV); \
    MFMA_A(p1, kf1, qr[5]); \
    TIE(p0); \
    EXPN(p0, 12, 4); \
    VRD(rb0_, 0, (1) * 4096 + BUFV); \
    VRD(rb1_, 1, (1) * 4096 + BUFV); \
    WMFMA_A(4, p1, kf2, qr[6]); \
    TIE(p0); \
    SUM8(p0, 8); PACK8(p0, 8, pb1); \
    MFMA_A(p1, kf3, qr[7]); \
    TIE3(p0, l2, pb1); \
    WMM2T(2, ot[0], ra, pb0, pb1); \
    VRD(ra0_, 0, (2) * 4096 + BUFV); \
    VRD(ra1_, 1, (2) * 4096 + BUFV); \
    TIE(p1); \
    EXPN(p1, 0, 8); \
    WMM2T(2, ot[1], rb, pb0, pb1); \
    VRD(rb0_, 0, (3) * 4096 + BUFV); \
    VRD(rb1_, 1, (3) * 4096 + BUFV); \
    TIE(p1); \
    SUM8(p1, 0); PACK8(p1, 0, pb2); \
    WMM2T(2, ot[2], ra, pb0, pb1); \
    VRD(ra0_, 2, (0) * 4096 + BUFV); \
    VRD(ra1_, 3, (0) * 4096 + BUFV); \
    TIE3(p1, l2, pb2); \
    EXPN(p1, 8, 8); \
    WMM2T(2, ot[3], rb, pb0, pb1); \
    VRD(rb0_, 2, (1) * 4096 + BUFV); \
    VRD(rb1_, 3, (1) * 4096 + BUFV); \
    TIE(p1); \
    SUM8(p1, 8); PACK8(p1, 8, pb3); \
    TIE3(p1, l2, pb3); \
    WMM2T(2, ot[0], ra, pb2, pb3); \
    VRD(ra0_, 2, (2) * 4096 + BUFV); \
    VRD(ra1_, 3, (2) * 4096 + BUFV); \
    WMM2T(2, ot[1], rb, pb2, pb3); \
    VRD(rb0_, 2, (3) * 4096 + BUFV); \
    VRD(rb1_, 3, (3) * 4096 + BUFV); \
    WMM2T(2, ot[2], ra, pb2, pb3); \
    WMM2T(0, ot[3], rb, pb2, pb3); \
  } while (0)

__device__ __forceinline__ void attn_body_v4(const bf16* Qb, const bf16* __restrict__ Kh, const bf16* __restrict__ Vth, bf16* Ob, int seq, char* lds, int wave_, const float* qg, const float* rope, int tok0) {
  constexpr int VTLD = MR;
  const int tid = tid_of(wave_), wid = tid >> 6, lane = tid & 63, r32 = lane & 31, hi = lane >> 5;
  bf16* V_lds = (bf16*)lds; bf16* K_lds = (bf16*)(lds + 4 * SHM_V);
  f32x2 l2 = {0.f, 0.f}; f32x16 ot[4] = {}; bf16x8 qr[8];
  const int sr = tid >> 4, sc = (tid & 15) * 8;
  const int kbase_ = (int)(uintptr_t)K_lds + r32 * 256 + ((hi ^ (r32 & 1)) << 4), kt_ = (r32 & 15) >> 1;
  const int kaddr0 = kbase_ + ((0 ^ kt_) << 5), kaddr1 = kbase_ + ((1 ^ kt_) << 5), kaddr2 = kbase_ + ((2 ^ kt_) << 5), kaddr3 = kbase_ + ((3 ^ kt_) << 5),
            kaddr4 = kbase_ + ((4 ^ kt_) << 5), kaddr5 = kbase_ + ((5 ^ kt_) << 5), kaddr6 = kbase_ + ((6 ^ kt_) << 5), kaddr7 = kbase_ + ((7 ^ kt_) << 5);
  const int vbase_ = (int)(uintptr_t)V_lds + r32 * 128, vt_ = (r32 >> 1) & 7;
  const int vaddr0 = vbase_ + (((0 + hi) ^ vt_) << 4), vaddr1 = vbase_ + (((2 + hi) ^ vt_) << 4), vaddr2 = vbase_ + (((4 + hi) ^ vt_) << 4), vaddr3 = vbase_ + (((6 + hi) ^ vt_) << 4);
  const int kwa0 = (int)(uintptr_t)K_lds + KSWZ(sr, sc * 2), kwa1 = (int)(uintptr_t)K_lds + KSWZ(32 + sr, sc * 2);
  const unsigned goff0 = (unsigned)(sr * LDK + sc) * 2u, goff1 = goff0 + 32u * LDK * 2u;
  const int vd0_ = tid >> 3, vd1_ = 64 + (tid >> 3), vcs_ = tid & 7, vg_ = vcs_ >> 1, ve_ = vcs_ & 1;
  const unsigned goffv0 = (unsigned)(vd0_ * VTLD + vcs_ * 8) * 2u, goffv1 = (unsigned)(vd1_ * VTLD + vcs_ * 8) * 2u;
  const int vwl0 = (int)(uintptr_t)V_lds + vd0_ * 128 + (((2 * vg_) ^ ((vd0_ >> 1) & 7)) << 4) + 8 * ve_, vwh0 = (int)(uintptr_t)V_lds + vd0_ * 128 + (((2 * vg_ + 1) ^ ((vd0_ >> 1) & 7)) << 4) + 8 * ve_;
  const int vwl1 = (int)(uintptr_t)V_lds + vd1_ * 128 + (((2 * vg_) ^ ((vd1_ >> 1) & 7)) << 4) + 8 * ve_, vwh1 = (int)(uintptr_t)V_lds + vd1_ * 128 + (((2 * vg_ + 1) ^ ((vd1_ >> 1) & 7)) << 4) + 8 * ve_;
  struct { bf16x8 vs0, vs1, ks0, ks1; } sr_[2];
#define GLD16S(dst, voff, sbase) asm volatile("global_load_dwordx4 %0, %1, %2" : "=&v"(dst) : "v"(voff), "s"(sbase) : "memory")
#define SLOADP(i) do { GLD16S(sr_[i].vs0, goffv0, vnext_); GLD16S(sr_[i].vs1, goffv1, vnext_); GLD16S(sr_[i].ks0, goff0, knext_); GLD16S(sr_[i].ks1, goff1, knext_); \
    vnext_ += KVBLK * 2; knext_ += KVBLK * LDK * 2; } while (0)
#define SLOADN(WS, T) SLOADP(WS)
#define LO4(x) __builtin_shufflevector(x, x, 0, 1, 2, 3)
#define HI4(x) __builtin_shufflevector(x, x, 4, 5, 6, 7)
#define DSWK0(WB, WS) asm volatile("s_waitcnt vmcnt(4)\n\tds_write_b128 %0, %1 offset:%2" :: "v"(kwa0), "v"(sr_[WS].ks0), "i"(WB) : "memory")
#define DSWK1(WB, WS) asm volatile("ds_write_b128 %0, %1 offset:%2" :: "v"(kwa1), "v"(sr_[WS].ks1), "i"(WB) : "memory")
#define DSWV0(WB, WS) asm volatile("ds_write_b64 %0, %1 offset:%2" :: "v"(vwl0), "v"(LO4(sr_[WS].vs0)), "i"(WB) : "memory")
#define DSWV1(WB, WS) asm volatile("ds_write_b64 %0, %1 offset:%2" :: "v"(vwh0), "v"(HI4(sr_[WS].vs0)), "i"(WB) : "memory")
#define DSWV2(WB, WS) asm volatile("ds_write_b64 %0, %1 offset:%2" :: "v"(vwl1), "v"(LO4(sr_[WS].vs1)), "i"(WB) : "memory")
#define DSWV3(WB, WS) asm volatile("ds_write_b64 %0, %1 offset:%2" :: "v"(vwh1), "v"(HI4(sr_[WS].vs1)), "i"(WB) : "memory")
#define DSWALL(WB, WS) do { DSWK0(WB, WS); DSWK1(WB, WS); DSWV0(WB, WS); DSWV1(WB, WS); DSWV2(WB, WS); DSWV3(WB, WS); } while (0)
#define KRD(dst, bq, imm) asm volatile("ds_read_b128 %0, %1 offset:%2" : "=&v"(dst) : "v"(kaddr##bq), "i"(imm) : "memory")
#define VRD(dst, ks, imm) asm volatile("ds_read_b128 %0, %1 offset:%2" : "=&v"(dst) : "v"(vaddr##ks), "i"(imm) : "memory")
#define MFMA_A(acc, a, b) asm volatile("v_mfma_f32_32x32x16_bf16 %0, %1, %2, %0" : "+v"(acc) : "v"(a), "v"(b))
#define WMFMA_Z(n, acc, a, b) asm volatile("s_waitcnt lgkmcnt(" #n ")\n\tv_mfma_f32_32x32x16_bf16 %0, %1, %2, 0" : "=&v"(acc) : "v"(a), "v"(b) : "memory")
#define WMFMA_A(n, acc, a, b) asm volatile("s_waitcnt lgkmcnt(" #n ")\n\tv_mfma_f32_32x32x16_bf16 %0, %1, %2, %0" : "+v"(acc) : "v"(a), "v"(b) : "memory")
#define WMFMA_Z_KR(n, acc, a, b, kfn, bq, imm) asm volatile("s_waitcnt lgkmcnt(" #n ")\n\tv_mfma_f32_32x32x16_bf16 %0, %2, %3, 0\n\tds_read_b128 %1, %4 offset:%5" : "=&v"(acc), "=&v"(kfn) : "v"(a), "v"(b), "v"(kaddr##bq), "i"(imm) : "memory")
#define WMFMA_A_KR(n, acc, a, b, kfn, bq, imm) asm volatile("s_waitcnt lgkmcnt(" #n ")\n\tv_mfma_f32_32x32x16_bf16 %0, %2, %3, %0\n\tds_read_b128 %1, %4 offset:%5" : "+v"(acc), "=&v"(kfn) : "v"(a), "v"(b), "v"(kaddr##bq), "i"(imm) : "memory")
#define MFMA_A_KR(acc, a, b, kfn, bq, imm) asm volatile("v_mfma_f32_32x32x16_bf16 %0, %2, %3, %0\n\tds_read_b128 %1, %4 offset:%5" : "+v"(acc), "=&v"(kfn) : "v"(a), "v"(b), "v"(kaddr##bq), "i"(imm) : "memory")
#define WMM2T(n, od, x, pa, pb) asm volatile("s_waitcnt lgkmcnt(" #n ")\n\tv_mfma_f32_32x32x16_bf16 %0, %1, %2, %0\n\tv_mfma_f32_32x32x16_bf16 %0, %3, %4, %0" : "+v"(od) : "v"(x##0_), "v"(pa), "v"(x##1_), "v"(pb) : "memory")
#define TIE(p) asm volatile("" : "+v"(p))
#define TIE3(p, a, b) asm volatile("" : "+v"(p), "+v"(a), "+v"(b))
#define EXPN(p, lo, n) do { _Pragma("unroll") for (int r_ = (lo); r_ < (lo) + (n); ++r_) p[r_] = __builtin_amdgcn_exp2f(p[r_]); } while (0)
#define SUM8(p, lo) do { _Pragma("unroll") for (int r_ = (lo); r_ < (lo) + 8; r_ += 2) l2 += (f32x2){p[r_], p[r_ + 1]}; } while (0)
#define PACK8(P, BASE, OUT) do { u32x4 w_ = {cvtpk(P[(BASE) + 0], P[(BASE) + 1]), cvtpk(P[(BASE) + 2], P[(BASE) + 3]), cvtpk(P[(BASE) + 4], P[(BASE) + 5]), cvtpk(P[(BASE) + 6], P[(BASE) + 7])}; OUT = *reinterpret_cast<bf16x8*>(&w_); } while (0)
  const int NT = seq / KVBLK;
  f32x16 p0, p1; bf16x8 pb0, pb1, pb2, pb3, kf0, kf1, kf2, kf3, kf4, kf5, ra0_, ra1_, rb0_, rb1_;
  const char* vnext_ = (const char*)Vth; const char* knext_ = (const char*)Kh;
  SLOADP(0); SLOADP(1);
  const bf16* Qw = Qb + (long)(wid * QBLK + r32) * LDQ + hi * 8;
#pragma unroll
  for (int d0 = 0; d0 < 8; ++d0) qr[d0] = *reinterpret_cast<const bf16x8*>(Qw + d0 * 16);
  q_prologue(qr, qg, rope, tok0 < 0 ? -1 : tok0 + wid * QBLK + r32, hi);
  asm volatile("s_waitcnt vmcnt(0)" : "+v"(qr[0]), "+v"(qr[1]), "+v"(qr[2]), "+v"(qr[3]), "+v"(qr[4]), "+v"(qr[5]), "+v"(qr[6]), "+v"(qr[7]));
  asm volatile("s_waitcnt vmcnt(0)" ::: "memory"); DSWALL(0, 0); DSWALL(16384, 1);
  SLOADP(0); SLOADP(1);
  for (int j = 0; j < NT; j += 4) {
    asm volatile("s_waitcnt lgkmcnt(0)\n\ts_barrier" ::: "memory");
    TILE_BODY(0, 0, 32768, 0, j + 4);
    TILE_BODY(16384, 16384, 49152, 1, j + 5);
    asm volatile("s_waitcnt lgkmcnt(0)\n\ts_barrier" ::: "memory");
    TILE_BODY(32768, 32768, 0, 0, j + 6);
    TILE_BODY(49152, 49152, 16384, 1, j + 7);
  }
  asm volatile("s_waitcnt vmcnt(0)" : "+v"(sr_[0].vs0), "+v"(sr_[0].vs1), "+v"(sr_[0].ks0), "+v"(sr_[0].ks1), "+v"(sr_[1].vs0), "+v"(sr_[1].vs1), "+v"(sr_[1].ks0), "+v"(sr_[1].ks1));
  asm volatile("s_nop 15\n\ts_nop 15" : "+v"(ot[0]), "+v"(ot[1]), "+v"(ot[2]), "+v"(ot[3]));
  float l_reg = l2.x + l2.y;
  { auto rr = __builtin_amdgcn_permlane32_swap(__float_as_uint(l_reg), __float_as_uint(l_reg), false, false); l_reg = __uint_as_float(rr[0]) + __uint_as_float(rr[1]); }
  const float rl = __builtin_amdgcn_rcpf(l_reg);
  const int lane2 = tid_of(wave_) & 63, r32e = lane2 & 31, hie = lane2 >> 5;
  unsigned short* Ow = (unsigned short*)Ob + (long)(wid * QBLK + r32e) * LDO + 8 * hie;
#pragma unroll
  for (int D0 = 0; D0 < 4; ++D0)
#pragma unroll
    for (int g4 = 0; g4 < 4; g4 += 2) {
      u32x2 a, b; a.x = cvtpk(ot[D0][4 * g4 + 0] * rl, ot[D0][4 * g4 + 1] * rl); a.y = cvtpk(ot[D0][4 * g4 + 2] * rl, ot[D0][4 * g4 + 3] * rl);
      b.x = cvtpk(ot[D0][4 * g4 + 4] * rl, ot[D0][4 * g4 + 5] * rl); b.y = cvtpk(ot[D0][4 * g4 + 6] * rl, ot[D0][4 * g4 + 7] * rl);
      { auto r = __builtin_amdgcn_permlane32_swap(a.x, b.x, false, false); a.x = r[0]; b.x = r[1]; }
      { auto r = __builtin_amdgcn_permlane32_swap(a.y, b.y, false, false); a.y = r[0]; b.y = r[1]; }
      *(u32x4*)(Ow + D0 * 32 + 8 * g4) = (u32x4){a.x, a.y, b.x, b.y}; }
  __syncthreads();
#undef GLD16S
#undef SLOADP
#undef SLOADN
#undef LO4
#undef HI4
#undef DSWK0
#undef DSWK1
#undef DSWV0
#undef DSWV1
#undef DSWV2
#undef DSWV3
#undef DSWALL
#undef KRD
#undef VRD
#undef MFMA_A
#undef WMFMA_Z
#undef WMFMA_A
#undef WMFMA_Z_KR
#undef WMFMA_A_KR
#undef MFMA_A_KR
#undef WMM2T
#undef TIE
#undef TIE3
#undef EXPN
#undef SUM8
#undef PACK8
}
#undef TILE_BODY
}

#ifdef ATT_DMA
#define ATT_FAST attn_body_dma<true>
#define ATT_FAST_ARGS F.lds, (char*)lds,
#elif defined(ATT_FX1)
#define ATT_FAST attn_dense_body_fx
#define ATT_FAST_ARGS (char*)lds,
#elif defined(ATT_V2)
#define ATT_FAST attn_body_v2
#define ATT_FAST_ARGS (char*)lds,
#else
#define ATT_V3 1
#endif
struct Args { const float* in[23]; float* out; unsigned char* ws; int ph_lo, ph_hi; };

struct Frame {
    LAS unsigned char* lds; unsigned char* ldsg;
    gu32* ctl; unsigned char* ws;
    int tid, lane, wave, vcu, G, gw, NGW;
};
__device__ __forceinline__ Frame opaque(const Frame& F0) { Frame F = F0; const int t = tid_of(F0.wave); F.tid = t; F.lane = t & 63; return F; }

__device__ __forceinline__ void p0_transpose_item(const float* W, int N, bf16_t* WT, int ldt, int drow0, int k0, int n0, LAS float* scr, int lane) {
#pragma unroll 8
    for (int i = 0; i < 32; ++i) { const int kk = 2 * i + (lane >> 5); scr[kk * 33 + (lane & 31)] = __builtin_nontemporal_load(W + (size_t)(k0 + kk) * N + n0 + (lane & 31)); }
    LDS_WAIT(); asm volatile("" ::: "memory");
    const int c = lane & 7;
#pragma unroll
    for (int j = 0; j < 4; ++j) { const int n = (lane >> 3) + 8 * j; const LAS float* s = scr + (8 * c) * 33 + n;
        u32x4 o; o.x = pk2(s[0 * 33], s[1 * 33]); o.y = pk2(s[2 * 33], s[3 * 33]); o.z = pk2(s[4 * 33], s[5 * 33]); o.w = pk2(s[6 * 33], s[7 * 33]);
        *(GAS u32x4*)(WT + (size_t)(drow0 + n) * ldt + k0 + 8 * c) = o; }
    LDS_WAIT(); asm volatile("" ::: "memory");
}
__device__ __forceinline__ void p0_convert(Frame& F, const float* W, int K, int N, bf16_t* WT, int mode, int& rot) {
    LAS float* scr = (LAS float*)(F.lds + F.wave * 16384);
    const int nblk = N / 32, nitems = (K / 64) * nblk;
    int it0 = F.gw - rot; if (it0 < 0) it0 += F.NGW;
    rot = (rot + nitems) % F.NGW;
    for (int it = it0; it < nitems; it += F.NGW) { const int kb = it / nblk, nb = it % nblk, n0 = nb * 32;
        const int drow0 = mode == 0 ? n0 : ((n0 >> 7) * 256 + (n0 & 127) + (mode == 2 ? 128 : 0));
        p0_transpose_item(W, N, WT, K, drow0, kb * 64, n0, scr, F.lane); }
}
__device__ __forceinline__ float siluf_(float x) { return x / (1.0f + __expf(-x)); }

__device__ __forceinline__ void p0_prologue(const Frame& F0, const Args& A) {
    Frame F = opaque(F0);
    unsigned char* ws = F.ws;
    if (F.gw < 1536) {
        const int task = F.gw, l = task / 768, rem = task % 768, chunk = rem / 16, slab = rem % 16;
        const float* w = A.in[4] + (size_t)l * DM * 12288 + chunk * 256 + F.lane * 4;
        const float* cv = A.in[1]; const float* xv = A.in[3];
        f32x4 a0 = {0.f, 0.f, 0.f, 0.f}, a1 = {0.f, 0.f, 0.f, 0.f};
#pragma unroll 8
        for (int k = slab * 128; k < slab * 128 + 128; ++k) { const f32x4 wv = __builtin_nontemporal_load((const f32x4*)(w + (size_t)k * 12288)); const float s0 = siluf_(cv[k]), s1 = siluf_(xv[k]); a0 += wv * s0; a1 += wv * s1; }
        float* part = (float*)(ws + WS_PART);
        *(f32x4*)(part + ((size_t)((slab * 2 + l) * 2 + 0) * 12288 + chunk * 256 + F.lane * 4)) = a0;
        *(f32x4*)(part + ((size_t)((slab * 2 + l) * 2 + 1) * 12288 + chunk * 256 + F.lane * 4)) = a1;
    }
    const int gtid = F.gw * 64 + F.lane, gstride = F.NGW * 64;
    { bf16_t* DC = (bf16_t*)(ws + WS_TAB + TAB_DC);
      for (int idx = gtid; idx < 512 * 256; idx += gstride) { const int r = idx >> 8, c = idx & 255, reim = r >> 8, m = r & 255, ph = (m * c) & 255; float s, co; sincospif((float)ph * (2.0f / 256.0f), &s, &co);
          DC[idx] = (bf16_t)f2bf((reim ? -s : co) * 0.0625f); }
      bf16_t* DN = (bf16_t*)(ws + WS_TAB + TAB_DN);
      for (int idx = gtid; idx < 256 * 256; idx += gstride) { const int r = idx >> 8, cc = idx & 255, ro = r >> 7, k = r & 127, ci = cc >> 7, b = cc & 127, ph = (k * b) & 127; float s, co; sincospif((float)ph * (2.0f / 128.0f), &s, &co);
          const float v = (ro == ci) ? co : (ro == 0 ? s : -s); DN[idx] = (bf16_t)f2bf(v * 0.08838834764831845f); }
      bf16_t* D2 = (bf16_t*)(ws + WS_TAB + TAB_D256);
      for (int idx = gtid; idx < 256 * 512; idx += gstride) { const int k = idx >> 9, cc = idx & 511, ci = cc >> 8, n = cc & 255, ph = (k * n) & 255; float s, co; sincospif((float)ph * (2.0f / 256.0f), &s, &co);
          D2[idx] = (bf16_t)f2bf((ci ? s : co) * 0.0625f); }
      float* rope = (float*)(ws + WS_TAB + TAB_ROPE);
      for (int idx = gtid; idx < 320 * 32; idx += gstride) { const int p = idx >> 5, j = idx & 31; const float inv = powf(10000.0f, -(float)j / 32.0f);
          const float pos = (float)(p < 256 ? p : p - 256); const float ang = pos * inv; float s, co; sincosf(ang, &s, &co);
          if (p < 256) { rope[p * 32 + j] = co; rope[8192 + p * 32 + j] = s; } else { rope[16384 + (p - 256) * 32 + j] = co; rope[16384 + 2048 + (p - 256) * 32 + j] = s; } }
    }
    int rot = 0;
    for (int l = 0; l < 2; ++l) {
        p0_convert(F, A.in[8] + (size_t)l * DM * INC, DM, INC, (bf16_t*)(ws + WS_WIN) + (size_t)l * INC * DM, 0, rot);
        p0_convert(F, A.in[12] + (size_t)l * QW * DM, QW, DM, (bf16_t*)(ws + WS_WAP) + (size_t)l * DM * QW, 0, rot);
        p0_convert(F, A.in[13] + (size_t)l * FD * DM, FD, DM, (bf16_t*)(ws + WS_WFP) + (size_t)l * DM * FD, 0, rot);
        p0_convert(F, A.in[14] + (size_t)l * DM * DM, DM, DM, (bf16_t*)(ws + WS_WOUT) + (size_t)l * DM * DM, 0, rot);
    }
    p0_convert(F, A.in[15], DM, DFF, (bf16_t*)(ws + WS_WGU), 1, rot);
    p0_convert(F, A.in[16], DM, DFF, (bf16_t*)(ws + WS_WGU), 2, rot);
    p0_convert(F, A.in[17], DFF, DM, (bf16_t*)(ws + WS_WD), 0, rot);
    for (int e = 0; e < NE; ++e) {
        p0_convert(F, A.in[19] + (size_t)e * DM * DFE, DM, DFE, (bf16_t*)(ws + WS_MGU) + (size_t)e * 2 * DFE * DM, 1, rot);
        p0_convert(F, A.in[20] + (size_t)e * DM * DFE, DM, DFE, (bf16_t*)(ws + WS_MGU) + (size_t)e * 2 * DFE * DM, 2, rot);
        p0_convert(F, A.in[21] + (size_t)e * DFE * DM, DFE, DM, (bf16_t*)(ws + WS_MD) + (size_t)e * DM * DFE, 0, rot);
    }
}
__device__ __forceinline__ void p0b_mod(const Frame& F0, const Args& A) {
    Frame F = opaque(F0);
    const float* part = (const float*)(F.ws + WS_PART); float* mod = (float*)(F.ws + WS_MOD);
    for (int idx = F.gw * 64 + F.lane; idx < 2 * 2 * 12288; idx += F.NGW * 64) { const int l = idx / 24576, cond = (idx / 12288) & 1, col = idx % 12288;
        float s = A.in[5][l * 12288 + col];
#pragma unroll
        for (int slab = 0; slab < 16; ++slab) s += part[(size_t)((slab * 2 + l) * 2 + cond) * 12288 + col];
        mod[idx] = s; }
}

template <bool ROUTER>
__device__ __forceinline__ void norm_phase(const Frame& F0, const float* xl, const float* xc, int nrows, const float* gamma, const float* modL, const float* modC, int ksh, bf16_t* H,
                                           const float* router_w, i32x4* route, f32x2* rwt, const float* cparts = nullptr, int ncparts = 0, float* xc_out = nullptr, const bf16_t* xlb = nullptr) {
    Frame F = opaque(F0);
    LAS float* PA = (LAS float*)F.lds;
    LAS float* PB = PA + 2 * DM;
    LAS float* RW = PB + 2 * DM;
    {
        float g_[4], sl_[4], hl_[4], sc_[4], hc_[4];
#pragma unroll
        for (int q = 0; q < DM / 512; ++q) { const int i = F.tid + 512 * q; g_[q] = gamma[i]; sl_[q] = modL[(ksh + 1) * DM + i]; hl_[q] = modL[ksh * DM + i]; sc_[q] = modC[(ksh + 1) * DM + i]; hc_[q] = modC[ksh * DM + i]; }
        f32x4 w0[4], w1[4];
        if (ROUTER) {
#pragma unroll
            for (int q = 0; q < DM / 512; ++q) { const int c = F.tid + 512 * q; w0[q] = *(const f32x4*)(router_w + c * NE); w1[q] = *(const f32x4*)(router_w + c * NE + 4); } }
#pragma unroll
        for (int q = 0; q < DM / 512; ++q) { const int i = F.tid + 512 * q;
            PA[i] = g_[q] * (1.0f + sl_[q]); PB[i] = hl_[q]; PA[DM + i] = g_[q] * (1.0f + sc_[q]); PB[DM + i] = hc_[q]; }
        if (ROUTER) {
#pragma unroll
            for (int q = 0; q < DM / 512; ++q) { const int c = F.tid + 512 * q;
                RW[0 * DM + c] = w0[q].x; RW[1 * DM + c] = w0[q].y; RW[2 * DM + c] = w0[q].z; RW[3 * DM + c] = w0[q].w;
                RW[4 * DM + c] = w1[q].x; RW[5 * DM + c] = w1[q].y; RW[6 * DM + c] = w1[q].z; RW[7 * DM + c] = w1[q].w; } }
    }
    LAS unsigned* cntL = (LAS unsigned*)(RW + DM * NE); LAS unsigned* baseL = cntL + 8; LAS i32x4* RI = (LAS i32x4*)(cntL + 16); LAS f32x2* RT = (LAS f32x2*)(RI + NWAVES * 32);
    if (ROUTER && F.tid < 8) cntL[F.tid] = 0u;
    __syncthreads();
    int kslot = 0;
    auto load_main = [&](int row, f32x4 (&v)[8]) {
        const bool isc = row >= SEQ; const float* src = isc ? xc + (size_t)(row - SEQ) * DM : xl + (size_t)row * DM;
#pragma unroll
        for (int j = 0; j < 8; ++j) {
            if (!isc && xlb) { const u32x2 w = *(const u32x2*)(xlb + (size_t)row * DM + 4 * F.lane + 256 * j); v[j] = (f32x4){bflo(w.x), bfhi(w.x), bflo(w.y), bfhi(w.y)}; }
            else v[j] = *(const f32x4*)(src + 4 * F.lane + 256 * j); }
    };
    auto finish = [&](int row, f32x4 (&v)[8], bool live) {
        const bool isc = row >= SEQ;
        const LAS float* pa = PA + (isc ? DM : 0); const LAS float* pb = PB + (isc ? DM : 0);
        if (isc && ncparts > 0) {
            const float* cp = cparts + (size_t)(row - SEQ) * DM + 4 * F.lane; int s_ = 0;
            for (; s_ + 2 <= ncparts; s_ += 2) { f32x4 t0[8], t1[8];
#pragma unroll
                for (int j = 0; j < 8; ++j) { t0[j] = *(const f32x4*)(cp + (size_t)s_ * CTXL * DM + 256 * j); t1[j] = *(const f32x4*)(cp + (size_t)(s_ + 1) * CTXL * DM + 256 * j); }
#pragma unroll
                for (int j = 0; j < 8; ++j) { v[j] += t0[j]; v[j] += t1[j]; } }
            if (s_ < ncparts) { f32x4 t0[8];
#pragma unroll
                for (int j = 0; j < 8; ++j) t0[j] = *(const f32x4*)(cp + (size_t)s_ * CTXL * DM + 256 * j);
#pragma unroll
                for (int j = 0; j < 8; ++j) v[j] += t0[j]; }
            if (live) {
#pragma unroll
                for (int j = 0; j < 8; ++j) *(f32x4*)(xc_out + (size_t)(row - SEQ) * DM + 4 * F.lane + 256 * j) = v[j]; } }
        float ss = 0.f;
#pragma unroll
        for (int j = 0; j < 8; ++j) ss += (v[j].x * v[j].x + v[j].y * v[j].y) + (v[j].z * v[j].z + v[j].w * v[j].w);
        const float rstd = 1.0f / sqrtf(wave_sum(ss) * (1.0f / DM) + EPS);
        float lg[NE];
        if (ROUTER) {
#pragma unroll
            for (int e = 0; e < NE; ++e) lg[e] = 0.f; }
        bf16_t* orow = H + (size_t)row * DM;
#pragma unroll
        for (int j = 0; j < 8; ++j) { const int c0 = 4 * F.lane + 256 * j; const f32x4 a = *(const LAS f32x4*)(pa + c0), b = *(const LAS f32x4*)(pb + c0);
            const f32x4 h = v[j] * rstd * a + b;
            u32x2 o; o.x = pk2(h.x, h.y); o.y = pk2(h.z, h.w); if (live) *(u32x2*)(orow + c0) = o;
            if (ROUTER) {
#pragma unroll
                for (int e = 0; e < NE; ++e) { const f32x4 wv = *(const LAS f32x4*)(RW + e * DM + c0); lg[e] += (h.x * wv.x + h.y * wv.y) + (h.z * wv.z + h.w * wv.w); }
                asm volatile("" ::: "memory"); } }
        if (ROUTER) {
#pragma unroll
            for (int e = 0; e < NE; ++e) lg[e] = wave_sum(lg[e]);
            int i1 = 0; float v1 = lg[0];
#pragma unroll
            for (int e = 1; e < NE; ++e) if (lg[e] > v1) { v1 = lg[e]; i1 = e; }
            int i2 = -1; float v2 = -3.0e38f;
#pragma unroll
            for (int e = 0; e < NE; ++e) if (e != i1 && lg[e] > v2) { v2 = lg[e]; i2 = e; }
            const float w1 = 1.0f / (1.0f + __expf(v2 - v1)), w2 = 1.0f - w1;
            if (live && F.lane == 0) {
                if (kslot < 32) { const int r1 = (int)__hip_atomic_fetch_add(cntL + i1, 1u, __ATOMIC_RELAXED, __HIP_MEMORY_SCOPE_WORKGROUP), r2 = (int)__hip_atomic_fetch_add(cntL + i2, 1u, __ATOMIC_RELAXED, __HIP_MEMORY_SCOPE_WORKGROUP);
                    RI[F.wave * 32 + kslot] = (i32x4){i1, r1, i2, r2}; RT[F.wave * 32 + kslot] = (f32x2){w1, w2}; }
                else { const int s1 = (int)__hip_atomic_fetch_add(F.ctl + CW_CNT + 64 * i1, 1u, RLX_AGENT), s2 = (int)__hip_atomic_fetch_add(F.ctl + CW_CNT + 64 * i2, 1u, RLX_AGENT);
                    route[row] = (i32x4){i1, s1, i2, s2}; rwt[row] = (f32x2){w1, w2}; } }
        }
    };
    const int nlat = nrows < SEQ ? nrows : SEQ;
    if constexpr (!ROUTER) {
        LAS float* red = RW;
        for (int cr = F.vcu; cr < nrows - SEQ; cr += F.G) { const int c0 = F.tid * 4;
            f32x4 x = *(const f32x4*)(xc + (size_t)cr * DM + c0); f32x4 t[11];
#pragma unroll
            for (int s_ = 0; s_ < 11; ++s_) t[s_] = (s_ < ncparts) ? *(const f32x4*)(cparts + ((size_t)s_ * CTXL + cr) * DM + c0) : (f32x4){0.f, 0.f, 0.f, 0.f};
#pragma unroll
            for (int s_ = 0; s_ < 11; ++s_) if (s_ < ncparts) x += t[s_];
            if (ncparts > 0) *(f32x4*)(xc_out + (size_t)cr * DM + c0) = x;
            const float ssw = wave_sum((x.x * x.x + x.y * x.y) + (x.z * x.z + x.w * x.w));
            if (F.lane == 0) red[F.wave] = ssw;
            __syncthreads();
            float ss = 0.f;
#pragma unroll
            for (int w_ = 0; w_ < NWAVES; ++w_) ss += red[w_];
            __syncthreads();
            const float rstd = 1.0f / sqrtf(ss * (1.0f / DM) + EPS);
            const f32x4 a = *(const LAS f32x4*)(PA + DM + c0), b = *(const LAS f32x4*)(PB + DM + c0);
            const f32x4 h = x * rstd * a + b;
            u32x2 o; o.x = pk2(h.x, h.y); o.y = pk2(h.z, h.w); *(u32x2*)(H + (size_t)(SEQ + cr) * DM + c0) = o; }
    }
    auto load_raw = [&](int row, u32x2 (&r)[8]) {
#pragma unroll
        for (int j = 0; j < 8; ++j) r[j] = *(const u32x2*)(xlb + (size_t)row * DM + 4 * F.lane + 256 * j);
    };
    auto unpack_raw = [&](const u32x2 (&r)[8], f32x4 (&v)[8]) {
#pragma unroll
        for (int j = 0; j < 8; ++j) v[j] = (f32x4){bflo(r[j].x), bfhi(r[j].x), bflo(r[j].y), bfhi(r[j].y)};
    };
    if constexpr (!ROUTER) {
        if (xlb) {
            for (int row = F.gw; row < nlat; row += 4 * F.NGW) {
                int rr[4]; bool lv[4]; u32x2 ra[8], rb[8], rc[8], rd[8];
#pragma unroll
                for (int q = 0; q < 4; ++q) { const int r_ = row + q * F.NGW; lv[q] = r_ < nlat; rr[q] = lv[q] ? r_ : row; }
                load_raw(rr[0], ra); load_raw(rr[1], rb); load_raw(rr[2], rc); load_raw(rr[3], rd);
                f32x4 v[8];
                unpack_raw(ra, v); finish(rr[0], v, true);
                unpack_raw(rb, v); finish(rr[1], v, lv[1]);
                unpack_raw(rc, v); finish(rr[2], v, lv[2]);
                unpack_raw(rd, v); finish(rr[3], v, lv[3]); }
        } else {
            for (int row = F.gw; row < nlat; row += 2 * F.NGW) { const int row1 = row + F.NGW; const bool has1 = row1 < nlat; const int r1 = has1 ? row1 : row;
                f32x4 va[8], vb[8];
                load_main(row, va); load_main(r1, vb);
                finish(row, va, true); finish(r1, vb, has1);
            }
        }
    } else {
        if (xlb) {
            for (int row = F.gw; row < nlat; row += 4 * F.NGW) {
                int rr[4]; bool lv[4]; u32x2 ra[8], rb[8], rc[8], rd[8];
#pragma unroll
                for (int q = 0; q < 4; ++q) { const int r_ = row + q * F.NGW; lv[q] = r_ < nlat; rr[q] = lv[q] ? r_ : row; }
                load_raw(rr[0], ra); load_raw(rr[1], rb); load_raw(rr[2], rc); load_raw(rr[3], rd);
                f32x4 v[8];
                unpack_raw(ra, v); finish(rr[0], v, true); ++kslot;
                if (lv[1]) { unpack_raw(rb, v); finish(rr[1], v, true); ++kslot; }
                if (lv[2]) { unpack_raw(rc, v); finish(rr[2], v, true); ++kslot; }
                if (lv[3]) { unpack_raw(rd, v); finish(rr[3], v, true); ++kslot; } }
        } else {
            for (int row = F.gw; row < nlat; row += F.NGW) { f32x4 va[8]; load_main(row, va); finish(row, va, true); ++kslot; }
        }
        __syncthreads();
        if (F.tid < 8) baseL[F.tid] = __hip_atomic_fetch_add(F.ctl + CW_CNT + 64 * F.tid, cntL[F.tid], RLX_AGENT);
        __syncthreads();
        { const int nk = kslot < 32 ? kslot : 32;
          if (F.lane < nk) { const i32x4 ri = RI[F.wave * 32 + F.lane]; const int row = F.gw + F.lane * F.NGW;
              route[row] = (i32x4){ri.x, (int)baseL[ri.x] + ri.y, ri.z, (int)baseL[ri.z] + ri.w}; rwt[row] = RT[F.wave * 32 + F.lane]; } }
    }
    __syncthreads();
}

__device__ __forceinline__ void qknorm_rope_phase(const Frame& F0, bf16_t* Q, bf16_t* Kb, const float* qg, const float* kg, int nrows, bool ctx_q) {
    Frame F = opaque(F0);
    const float* rope = (const float*)(F.ws + WS_TAB + TAB_ROPE);
    const int L = F.lane, axis = L >> 5, half = (L & 31) >> 4, j0 = 2 * (L & 15);
    constexpr float QC = 0.088388347648318440f * 1.4426950408889634f;
    const f32x2 gq = *(const f32x2*)(qg + 2 * L) * QC, gk = *(const f32x2*)(kg + 2 * L);
    int gw = F.gw, ngw = F.NGW;
    if (ctx_q && F.G == 256) { if ((F.vcu & 31) == 0) gw = nrows; else { gw = (F.vcu - 1 - (F.vcu >> 5)) * NWAVES + F.wave; ngw = (F.G - 8) * NWAVES; } }
    for (int row = gw; row < nrows; row += ngw) {
        const bool isc = row >= SEQ;
        f32x2 cs = {1.f, 1.f}, sn = {0.f, 0.f};
        if (!isc) { const int p = axis ? (row & 63) : (row >> 6); const float* cb = rope + (axis ? 16384 : 0) + p * 32 + j0; const float* sb = cb + (axis ? 2048 : 8192);
            cs = *(const f32x2*)cb; sn = *(const f32x2*)sb; if (half == 0) { sn.x = -sn.x; sn.y = -sn.y; } }
        const int nq = 0;
        unsigned* qrow = (unsigned*)(Q + (size_t)row * QW) + L; unsigned* krow = (unsigned*)(Kb + (size_t)row * KVW) + L;
        unsigned w[NH + NKV];
#pragma unroll
        for (int h = 0; h < NH + NKV; ++h) { const unsigned* p = h < NH ? qrow + h * 64 : krow + (h - NH) * 64; w[h] = (h < NH && h >= nq) ? 0u : *p; }
#pragma unroll
        for (int h = 0; h < NH + NKV; ++h) { if (h < NH && h >= nq) continue;
            unsigned* p = h < NH ? qrow + h * 64 : krow + (h - NH) * 64; const f32x2 g = h < NH ? gq : gk;
            float x0 = bflo(w[h]), x1 = bfhi(w[h]);
            const float rs = 1.0f / sqrtf(wave_sum(x0 * x0 + x1 * x1) * (1.0f / HD) + EPS);
            x0 = x0 * rs * g.x; x1 = x1 * rs * g.y;
            const float y0 = xor16f(x0), y1 = xor16f(x1);
            *p = pk2(x0 * cs.x + y0 * sn.x, x1 * cs.y + y1 * sn.y); }
    }
}

__device__ __forceinline__ void moe_cum(Frame& F, int (&cum)[9], int (&rbase)[8]) {
    const int ln = tid_of(F.wave) & 63;
    unsigned cv = 0u; if (ln < NE) cv = __hip_atomic_load(F.ctl + CW_CNT + 64 * ln, RLX_AGENT);
    int t = 0;
#pragma unroll
    for (int e = 0; e < NE; ++e) { const unsigned c = (unsigned)__builtin_amdgcn_readlane((int)cv, e); cum[e] = t; rbase[e] = t * 256; t += (int)((c + 255u) >> 8); }
    cum[8] = t;
}
__device__ __forceinline__ void moe_gather_phase(const Frame& F0, const bf16_t* H, bf16_t* HG, const i32x4* route, i32x2* pairpos) {
    Frame F = opaque(F0);
    int cum[9], rbase[8]; moe_cum(F, cum, rbase);
    LAS int* RB = (LAS int*)F.lds;
    if (F.tid == 0) {
#pragma unroll
        for (int e = 0; e < NE; ++e) RB[e] = rbase[e]; }
    __syncthreads();
    for (int t = F.gw; t < SEQ; t += 2 * F.NGW) { const int t1 = t + F.NGW; const bool has1 = t1 < SEQ; const int tb = has1 ? t1 : t;
        const i32x4 ra = route[t], rb = route[tb]; const int pa1 = RB[ra.x] + ra.y, pa2 = RB[ra.z] + ra.w, pb1 = RB[rb.x] + rb.y, pb2 = RB[rb.z] + rb.w;
        const u32x4* sa = (const u32x4*)(H + (size_t)t * DM) + F.lane; const u32x4* sb = (const u32x4*)(H + (size_t)tb * DM) + F.lane;
        u32x4 va[4], vb[4];
#pragma unroll
        for (int j = 0; j < 4; ++j) { va[j] = sa[64 * j]; vb[j] = sb[64 * j]; }
        u32x4* da1 = (u32x4*)(HG + (size_t)pa1 * DM) + F.lane; u32x4* da2 = (u32x4*)(HG + (size_t)pa2 * DM) + F.lane;
        u32x4* db1 = (u32x4*)(HG + (size_t)pb1 * DM) + F.lane; u32x4* db2 = (u32x4*)(HG + (size_t)pb2 * DM) + F.lane;
#pragma unroll
        for (int j = 0; j < 4; ++j) { da1[64 * j] = va[j]; da2[64 * j] = va[j]; if (has1) { db1[64 * j] = vb[j]; db2[64 * j] = vb[j]; } }
        if (F.lane == 0) { pairpos[t] = (i32x2){pa1, pa2}; if (has1) pairpos[t1] = (i32x2){pb1, pb2}; } }
    __syncthreads();
}

__device__ __forceinline__ void final_phase(const Frame& F0, float* out, const bf16_t* XBp, const bf16_t* OP, const i32x2* pairpos, const f32x2* rwt, const float* ga2, const float* fg, bool poison) {
    Frame F = opaque(F0);
    for (int row = F.gw; row < SEQ; row += 2 * F.NGW) { const int row1 = row + F.NGW; const bool has1 = row1 < SEQ; const int r1 = has1 ? row1 : row;
        const i32x2 ppa = pairpos[row], ppb = pairpos[r1]; const f32x2 wa = rwt[row], wb = rwt[r1];
        u32x4 xa[4], xb[4], a1[4], a2[4], b1[4], b2[4];
#pragma unroll
        for (int j = 0; j < 4; ++j) { const int c0 = 8 * F.lane + 512 * j;
            xa[j] = __builtin_nontemporal_load((const u32x4*)(XBp + (size_t)row * DM + c0)); a1[j] = __builtin_nontemporal_load((const u32x4*)(OP + (size_t)ppa.x * DM + c0)); a2[j] = __builtin_nontemporal_load((const u32x4*)(OP + (size_t)ppa.y * DM + c0));
            xb[j] = __builtin_nontemporal_load((const u32x4*)(XBp + (size_t)r1 * DM + c0)); b1[j] = __builtin_nontemporal_load((const u32x4*)(OP + (size_t)ppb.x * DM + c0)); b2[j] = __builtin_nontemporal_load((const u32x4*)(OP + (size_t)ppb.y * DM + c0)); }
        f32x4 va[8], vb[8]; float sa = 0.f, sb = 0.f;
#pragma unroll
        for (int j = 0; j < 4; ++j)
#pragma unroll
            for (int h = 0; h < 2; ++h) { const int c0 = 8 * F.lane + 512 * j + 4 * h, e = 2 * j + h; const f32x4 g = *(const f32x4*)(ga2 + c0);
                { const unsigned x0 = h ? xa[j].z : xa[j].x, x1 = h ? xa[j].w : xa[j].y, p0 = h ? a1[j].z : a1[j].x, p1 = h ? a1[j].w : a1[j].y, q0 = h ? a2[j].z : a2[j].x, q1 = h ? a2[j].w : a2[j].y;
                  const f32x4 x = (f32x4){bflo(x0), bfhi(x0), bflo(x1), bfhi(x1)};
                  const f32x4 m = (f32x4){bflo(p0), bfhi(p0), bflo(p1), bfhi(p1)} * wa.x + (f32x4){bflo(q0), bfhi(q0), bflo(q1), bfhi(q1)} * wa.y;
                  va[e] = x + g * m; sa += (va[e].x * va[e].x + va[e].y * va[e].y) + (va[e].z * va[e].z + va[e].w * va[e].w); }
                { const unsigned x0 = h ? xb[j].z : xb[j].x, x1 = h ? xb[j].w : xb[j].y, p0 = h ? b1[j].z : b1[j].x, p1 = h ? b1[j].w : b1[j].y, q0 = h ? b2[j].z : b2[j].x, q1 = h ? b2[j].w : b2[j].y;
                  const f32x4 x = (f32x4){bflo(x0), bfhi(x0), bflo(x1), bfhi(x1)};
                  const f32x4 m = (f32x4){bflo(p0), bfhi(p0), bflo(p1), bfhi(p1)} * wb.x + (f32x4){bflo(q0), bfhi(q0), bflo(q1), bfhi(q1)} * wb.y;
                  vb[e] = x + g * m; sb += (vb[e].x * vb[e].x + vb[e].y * vb[e].y) + (vb[e].z * vb[e].z + vb[e].w * vb[e].w); } }
        const float ra = 1.0f / sqrtf(wave_sum(sa) * (1.0f / DM) + EPS), rb = 1.0f / sqrtf(wave_sum(sb) * (1.0f / DM) + EPS);
        float* xr = out + (size_t)row * DM; float* xr1 = out + (size_t)r1 * DM;
#pragma unroll
        for (int e = 0; e < 8; ++e) { const int c0 = 8 * F.lane + 512 * (e >> 1) + 4 * (e & 1); const f32x4 fgv = *(const f32x4*)(fg + c0); f32x4 oa = va[e] * ra * fgv, ob = vb[e] * rb * fgv;
            if (poison) { const float q = __builtin_nanf(""); oa = (f32x4){q, q, q, q}; ob = oa; }
            *(f32x4*)(xr + c0) = oa; if (has1) *(f32x4*)(xr1 + c0) = ob; } }
}

__device__ __forceinline__ void dctx_reduce_phase(const Frame& F0, const float* part, const bf16_t* Gb, bf16_t* Y) {
    Frame F = opaque(F0);
    for (int idx = F.gw * 64 + F.lane; idx < CTXL * DM / 4; idx += F.NGW * 64) { const int row = idx / (DM / 4), c0 = (idx % (DM / 4)) * 4;
        const float* p = part + (size_t)row * DM + c0;
        f32x4 t[12];
#pragma unroll
        for (int s_ = 0; s_ < 12; ++s_) t[s_] = *(const f32x4*)(p + (size_t)s_ * CTXL * DM);
        const u32x2 ga = *(const u32x2*)(Gb + (size_t)(SEQ + row) * GW2 + c0), gf = *(const u32x2*)(Gb + (size_t)(SEQ + row) * GW2 + DM + c0);
        f32x4 a = t[0]; a += t[1]; a += t[2]; a += t[3]; a += t[4]; a += t[5]; a += t[6]; a += t[7];
        f32x4 f = t[8]; f += t[9]; f += t[10]; f += t[11];
        const f32x4 y = (f32x4){bflo(ga.x), bfhi(ga.x), bflo(ga.y), bfhi(ga.y)} * a + (f32x4){bflo(gf.x), bfhi(gf.x), bflo(gf.y), bfhi(gf.y)} * f;
        u32x2 o; o.x = pk2(y.x, y.y); o.y = pk2(y.z, y.w); *(u32x2*)(Y + (size_t)(SEQ + row) * DM + c0) = o; }
}

constexpr int PH_P0 = 0, PH_P0B = 1, PH_L0 = 2, PH_PER_LAYER = 12, PH_END = PH_L0 + 2 * PH_PER_LAYER;

__global__ void __launch_bounds__(NWAVES * 64, 2) mk_fwd(Args args) {
    extern __shared__ __attribute__((aligned(16))) unsigned char lds[];
    Frame F;
    F.lds = (LAS unsigned char*)lds; F.ldsg = lds;
    volatile LAS unsigned* MISC = (volatile LAS unsigned*)(F.lds + MISC_OFF);
    F.tid = threadIdx.x; F.lane = F.tid & 63; F.wave = __builtin_amdgcn_readfirstlane(F.tid >> 6);
    F.G = gridDim.x; { const int bx = blockIdx.x; F.vcu = (F.G % 8 == 0) ? (bx % 8) * (F.G / 8) + bx / 8 : bx; }
    F.gw = F.vcu * NWAVES + F.wave; F.NGW = F.G * NWAVES;
    F.ws = args.ws; F.ctl = (gu32*)(args.ws + WS_CTL);
    for (int u = F.tid; u < (LDS_BYTES - LDSCTL_OFF) / 4; u += NWAVES * 64) ((LAS unsigned*)(F.lds + LDSCTL_OFF))[u] = 0u;
    __syncthreads();
    const int lo = args.ph_lo, hi = args.ph_hi;
    XcdBarrier bar; bar.bar = (unsigned*)(F.ctl + CW_BAR); bar.x = 0; bar.st = nullptr; bar.wave = 0;
    if (!MK_SPLIT) bar = xcd_barrier_post((unsigned*)(F.ctl + CW_BAR), MISC + 8);
    bar.wave = F.wave;
#ifndef PH_MASK
#define PH_MASK 0xFFFFFFFFu
#endif
#define PHT(k) ((k) < PH_L0 ? (k) : 2 + ((k) - PH_L0) % PH_PER_LAYER)
#define IN(k) (((PH_MASK >> PHT(k)) & 1u) && lo <= (k) && (k) < hi)
#ifdef PROF_MASK
    unsigned long long tacc = 0, tph = __builtin_amdgcn_s_memrealtime();
#define SEAM(k) do { if (!MK_SPLIT) xcd_barrier(bar); { const unsigned long long t_ = __builtin_amdgcn_s_memrealtime(); if ((PROF_MASK >> (k)) & 1ull) tacc += t_ - tph; tph = t_; } } while (0)
#else
#define SEAM(k) do { if (!MK_SPLIT) xcd_barrier(bar); } while (0)
#endif
    unsigned char* ws = args.ws;
    bf16_t* Hb = (bf16_t*)(ws + WS_H); bf16_t* Qb = (bf16_t*)(ws + WS_Q); bf16_t* Kb = (bf16_t*)(ws + WS_K); bf16_t* Vb = (bf16_t*)(ws + WS_V);
    bf16_t* Fb = (bf16_t*)(ws + WS_F); bf16_t* Gb = (bf16_t*)(ws + WS_G); bf16_t* ZA = (bf16_t*)(ws + WS_ZA); bf16_t* YB = (bf16_t*)(ws + WS_YB);
    bf16_t* FOUR = (bf16_t*)(ws + WS_FOUR); bf16_t* ZC = (bf16_t*)(ws + WS_ZC); float* XC = (float*)(ws + WS_XC); bf16_t* XB = (bf16_t*)(ws + WS_XB);
    bf16_t* Ub = (bf16_t*)(ws + WS_U); bf16_t* HG = (bf16_t*)(ws + WS_HG); bf16_t* UG = (bf16_t*)(ws + WS_UG);
    i32x4* route = (i32x4*)(ws + WS_ROUTE); f32x2* rwt = (f32x2*)(ws + WS_ROUTE + 256 * 1024); i32x2* pairpos = (i32x2*)(ws + WS_ROUTE + 512 * 1024);
    const bf16_t* DC = (const bf16_t*)(ws + WS_TAB + TAB_DC); const bf16_t* DN = (const bf16_t*)(ws + WS_TAB + TAB_DN); const bf16_t* D256 = (const bf16_t*)(ws + WS_TAB + TAB_D256);
    const float* MOD = (const float*)(ws + WS_MOD); float* PARTC = (float*)(ws + WS_PARTC);
    const int bx = (int)blockIdx.x;

    if (IN(PH_P0)) { p0_prologue(F, args); __syncthreads(); SEAM(PH_P0); }
    if (IN(PH_P0B)) { p0b_mod(F, args); SEAM(PH_P0B); }

#pragma unroll 1
    for (int l = 0; l < 2; ++l) {
        const int pb = PH_L0 + l * PH_PER_LAYER; const bool last = (l == 1);
        const float* modL = MOD + (size_t)(l * 2 + 0) * 12288; const float* modC = MOD + (size_t)(l * 2 + 1) * 12288;
        const float* xlat = args.in[0]; const float* xctx = (l == 0) ? args.in[2] : XC;
        if (IN(pb + 0)) {
            norm_phase<false>(F, xlat, xctx, MR, args.in[6] + l * DM, modL, modC, 0, Hb, nullptr, nullptr, nullptr, PARTC, l == 0 ? 0 : 11, XC, l == 0 ? nullptr : XB); SEAM(pb + 0); }
        if (IN(pb + 1)) {
            pg8::Gemm g = pg8::mk_gemm(Hb, DM, (const bf16_t*)(ws + WS_WIN) + (size_t)l * INC * DM, DM, DM);
            pg8::TileOrder S; S.init(last ? 64 : 65, 32, F.G, bx, (long)256 * DM * 2, (long)256 * DM * 2);
            if (last) { S.xpm = 64; S.xlo = 8; S.xn = 4; }
            { const bf16_t* Wl = (const bf16_t*)(ws + WS_WIN) + (size_t)l * INC * DM;
              S.sn = 2 * 65; S.sdiv = 65; S.sA0 = (long)((const char*)Wl - (const char*)Hb) + (long)(QW + KVW) * DM * 2; S.sB0 = (long)((const char*)Hb - (const char*)Wl); }
            pg8::EpiInProj E{Qb, Kb, Vb, Fb, Gb, args.in[9] + l * GW2, (bf16_t*)(ws + WS_VT)};
            pg8::gemm_phase(F.lds, g, S, E, F.wave);
            SEAM(pb + 1);
        }
        if (IN(pb + 2)) {
#ifndef NO_QKN
            qknorm_rope_phase(F, Qb, Kb, args.in[10] + l * HD, args.in[11] + l * HD, MR, !last);
#endif
#ifndef NO_F1
            { pg8::Gemm g = pg8::mk_gemm(DC, 256, Fb, FD, 256); g.rmulB = 128; g.hstepB = (long)FD * 2;
              pg8::F1Order S{F.G, bx}; pg8::EpiF1 E{ZA}; pg8::gemm_phase(F.lds, g, S, E, F.wave); }
#endif
#ifndef NO_F1C
            if (!last) { pg8::Gemm g = pg8::mk_gemm(DC, 256, Fb, FD, 256);
              pg8::F1cOrder S{F.G, bx}; pg8::EpiF1c E{ZC}; pg8::gemm_phase(F.lds, g, S, E, F.wave); }
#endif
            SEAM(pb + 2);
        }
        if (IN(pb + 3)) {
            pg8::Gemm g = pg8::mk_gemm(DN, 256, ZA, 256, 256);
            pg8::LinOrder S{F.G, bx, 512, (long)256 * 256 * 2}; pg8::EpiF2 E{YB}; pg8::gemm_phase(F.lds, g, S, E, F.wave);
            SEAM(pb + 3);
        }
        if (IN(pb + 4)) {
#ifndef NO_F3
            { pg8::Gemm g = pg8::mk_gemm(DN, 256, YB, 256, 256);
              pg8::LinOrder S{F.G, bx, 512, (long)256 * 256 * 2}; pg8::EpiF3 E{FOUR}; pg8::gemm_phase(F.lds, g, S, E, F.wave); }
#endif
#ifndef NO_F3C
            if (!last) { pg8::Gemm g = pg8::mk_gemm(D256, 512, ZC, 512, 512);
              pg8::LinOrder S{F.G, (bx + F.G - 1) % F.G, 4, (long)256 * 512 * 2}; pg8::EpiF3c E{FOUR};
              pg8::gemm_phase(F.lds, g, S, E, F.wave); }
#endif
            __syncthreads();
#ifndef NO_ATTN
            const int nctx = last ? 0 : NH;
            float gqm = 0.f, gkm = 0.f;
            { const float* gq = args.in[10] + l * HD; const float* gk = args.in[11] + l * HD;
              const int ln = tid_of(F.wave) & 63;
              gqm = fmaxf(fabsf(gq[ln]), fabsf(gq[ln + 64])); gkm = fmaxf(fabsf(gk[ln]), fabsf(gk[ln + 64]));
              gqm = wave_max(gqm); gkm = wave_max(gkm); }
            const float bnd = (11.313708499f * gqm * gkm * 1.03f + 0.25f) * 1.4426950408889634f;
            const bool fastsm = __builtin_amdgcn_readfirstlane(bnd <= 43.0f ? 1 : 0) != 0;
            const float negBC = 0.f;
            for (int i = 0;; ++i) {
                int qh, qb, isc;
                if (F.G == 256) { const int xcd = F.vcu >> 5, c = F.vcu & 31;
                    if (i < 4) { qh = (xcd >> 1) * 4 + (xcd & 1) * 2 + (i >> 1); qb = (i & 1) * 32 + c; isc = 0; }
                    else if (i == 4 && F.vcu < nctx) { qh = F.vcu; qb = 0; isc = 1; }
                    else break; }
                else { const int Lu = i * F.G + bx; if (Lu < 1024) { qh = Lu >> 6; qb = Lu & 63; isc = 0; } else if (Lu < 1024 + nctx) { qh = Lu - 1024; qb = 0; isc = 1; } else break; }
                const size_t row0 = isc ? (size_t)SEQ : (size_t)qb * 256;
                const at::bf16* Qp = (const at::bf16*)(Qb + row0 * QW + qh * HD);
                const size_t kro = isc ? (size_t)SEQ * KVW : 0;
                const at::bf16* Kp = (const at::bf16*)(Kb + kro + (qh >> 2) * HD); const at::bf16* Vp = (const at::bf16*)(Vb + kro + (qh >> 2) * HD);
#ifdef ATT_V3
                if (fastsm) at::attn_body_v4(Qp, Kp, (const at::bf16*)((const bf16_t*)(ws + WS_VT) + (size_t)(qh >> 2) * HD * MR + (isc ? SEQ : 0)), (at::bf16*)(Qb + row0 * QW + qh * HD), isc ? CTXL : MR, (char*)lds, F.wave, args.in[10] + l * HD, (const float*)(ws + WS_TAB + TAB_ROPE), isc ? -1 : qb * 256);
#else
                if (fastsm) at::ATT_FAST(Qp, Kp, Vp, (at::bf16*)(Qb + row0 * QW + qh * HD), isc ? CTXL : MR, ATT_FAST_ARGS negBC, F.wave);
#endif
#ifndef NO_SLOWATT
                else at::attn_dense_body(Qp, Kp, Vp, (at::bf16*)(Qb + row0 * QW + qh * HD), isc ? CTXL : MR, (char*)lds, F.wave, args.in[10] + l * HD, (const float*)(ws + WS_TAB + TAB_ROPE), isc ? -1 : qb * 256);
#endif
            }
#endif
            SEAM(pb + 4);
        }
        if (IN(pb + 5)) {
            { pg8::Gemm g = pg8::mk_gemm(Qb, QW, (const bf16_t*)(ws + WS_WAP) + (size_t)l * DM * QW, QW, QW);
              pg8::TileOrder S; S.init(64, 8, F.G, bx, (long)256 * QW * 2, (long)256 * QW * 2); pg8::EpiMerge<0> E{Hb, Gb}; pg8::gemm_phase(F.lds, g, S, E, F.wave);
              if (!last) { pg8::Gemm g2 = g; g2.K = 256;
                  pg8::SplitKOrder S2{F.G, bx, 8, 8, 64, (long)SEQ * QW * 2, (long)256 * QW * 2, (long)256 * 2};
                  pg8::EpiPartial E2{PARTC, nullptr}; pg8::gemm_phase(F.lds, g2, S2, E2, F.wave); } }
            { pg8::Gemm g = pg8::mk_gemm(FOUR, FD, (const bf16_t*)(ws + WS_WFP) + (size_t)l * DM * FD, FD, FD);
              pg8::TileOrder S; S.init(64, 8, F.G, bx, (long)256 * FD * 2, (long)256 * FD * 2); pg8::EpiMerge<1> E{Hb, Gb}; pg8::gemm_phase(F.lds, g, S, E, F.wave);
              if (!last) { pg8::Gemm g2 = g; g2.K = 256;
                  pg8::SplitKOrder S2{F.G, (bx + F.G - 64) % F.G, 8, 4, 64, (long)SEQ * FD * 2, (long)256 * FD * 2, (long)256 * 2};
                  pg8::EpiPartial E2{PARTC + (size_t)8 * CTXL * DM, nullptr}; pg8::gemm_phase(F.lds, g2, S2, E2, F.wave); } }
            SEAM(pb + 5);
        }
        if (!last && IN(pb + 10)) { dctx_reduce_phase(F, PARTC, Gb, Hb); SEAM(pb + 10); }
        if (IN(pb + 6)) {
            pg8::Gemm g = pg8::mk_gemm(Hb, DM, (const bf16_t*)(ws + WS_WOUT) + (size_t)l * DM * DM, DM, DM);
            pg8::TileOrder S; S.init(64, 8, F.G, bx, (long)256 * DM * 2, (long)256 * DM * 2);
            pg8::EpiRes E{xlat, l == 0 ? nullptr : XB, XB, modL + 2 * DM, xctx, XC, modC + 2 * DM};
            pg8::gemm_phase(F.lds, g, S, E, F.wave);
            if (!last) {
                pg8::Gemm g2 = g; g2.K = 256;
                pg8::SplitKOrder S2{F.G, bx, 8, 8, 64, (long)SEQ * DM * 2, (long)256 * DM * 2, (long)256 * 2};
                pg8::EpiPartial E2{PARTC, modC + 2 * DM}; pg8::gemm_phase(F.lds, g2, S2, E2, F.wave); }
            SEAM(pb + 6);
        }
        if (IN(pb + 7)) {
            if (!last) norm_phase<false>(F, xlat, xctx, MR, args.in[7] + l * DM, modL, modC, 3, Hb, nullptr, nullptr, nullptr, PARTC, 8, XC, XB);
            else norm_phase<true>(F, xlat, XC, SEQ, args.in[7] + l * DM, modL, modC, 3, Hb, args.in[18], route, rwt, nullptr, 0, nullptr, XB);
            SEAM(pb + 7);
        }
        if (!last) {
            if (IN(pb + 8)) {
                pg8::Gemm g = pg8::mk_gemm(Hb, DM, (const bf16_t*)(ws + WS_WGU), DM, DM);
                pg8::TileOrder S; S.init(65, 44, F.G, bx, (long)256 * DM * 2, (long)256 * DM * 2);
                pg8::EpiSwiglu E{Ub, DFF}; pg8::gemm_phase(F.lds, g, S, E, F.wave);
                SEAM(pb + 8);
            }
            if (IN(pb + 9)) {
                pg8::Gemm g = pg8::mk_gemm(Ub, DFF, (const bf16_t*)(ws + WS_WD), DFF, DFF);
                pg8::TileOrder S; S.init(64, 8, F.G, bx, (long)256 * DFF * 2, (long)256 * DFF * 2);
                pg8::EpiRes E{nullptr, XB, XB, modL + 5 * DM, XC, XC, modC + 5 * DM};
                pg8::gemm_phase(F.lds, g, S, E, F.wave);
                { pg8::Gemm g2 = g; g2.K = 512;
                  pg8::SplitKOrder S2{F.G, bx, 8, 11, 64, (long)SEQ * DFF * 2, (long)256 * DFF * 2, (long)512 * 2};
                  pg8::EpiPartial E2{PARTC, modC + 5 * DM}; pg8::gemm_phase(F.lds, g2, S2, E2, F.wave); }
                SEAM(pb + 9);
            }
        } else {
            if (IN(pb + 8)) { moe_gather_phase(F, Hb, HG, route, pairpos); SEAM(pb + 8); }
            if (IN(pb + 9)) {
                int rbase[8]; pg8::MoeOrder S; S.G = F.G; S.c = bx; S.nN = 22; moe_cum(F, S.cum, rbase); S.tA = (long)256 * DM * 2; S.tB = (long)256 * DM * 2; S.eB = (long)2 * DFE * DM * 2;
                pg8::Gemm g = pg8::mk_gemm(HG, DM, (const bf16_t*)(ws + WS_MGU), DM, DM);
                pg8::EpiSwiglu E{UG, DFE}; pg8::gemm_phase(F.lds, g, S, E, F.wave);
                SEAM(pb + 9);
            }
            if (IN(pb + 10)) {
                int rbase[8]; pg8::MoeOrder S; S.G = F.G; S.c = bx; S.nN = 8; moe_cum(F, S.cum, rbase); S.tA = (long)256 * DFE * 2; S.tB = (long)256 * DFE * 2; S.eB = (long)DM * DFE * 2;
                pg8::Gemm g = pg8::mk_gemm(UG, DFE, (const bf16_t*)(ws + WS_MD), DFE, DFE);
                pg8::EpiPlain E{HG, DM}; pg8::gemm_phase(F.lds, g, S, E, F.wave);
                SEAM(pb + 10);
            }
            if (IN(pb + 11)) {
                bool poison = false;
                if (!MK_SPLIT) poison = __hip_atomic_load((gu32*)((unsigned*)(F.ctl + CW_BAR) + XB_TMO), RLX_AGENT) != 0u;
                final_phase(F, args.out, XB, HG, pairpos, rwt, modL + 5 * DM, args.in[22], poison);
#ifdef PROF_MASK
                { const unsigned long long t_ = __builtin_amdgcn_s_memrealtime(); if ((PROF_MASK >> (pb + 11)) & 1ull) tacc += t_ - tph; tph = t_;
                  if (blockIdx.x == 0) { while (__builtin_amdgcn_s_memrealtime() - tph < PROF_MULT * tacc) __builtin_amdgcn_s_sleep(8); } }
#endif
            }
        }
    }
#undef IN
#undef SEAM
}

extern "C" void kernel_launch(void* const* d_in, const int* in_sizes, int n_in, void* d_out, int out_size, void* d_ws, size_t ws_size, hipStream_t stream) {
    static int grid = 0;
    if (grid == 0) {
        if (n_in != 23 || out_size != SEQ * DM || ws_size < WS_END) { fprintf(stderr, "kernel_launch: unexpected shapes (n_in %d out %d ws %zu)\n", n_in, out_size, ws_size); grid = -1; return; }
        int dev = 0, cus = 0, per_cu = 0;
        if (hipGetDevice(&dev) != hipSuccess || hipDeviceGetAttribute(&cus, hipDeviceAttributeMultiprocessorCount, dev) != hipSuccess) { grid = -1; return; }
        if (hipFuncSetAttribute((const void*)mk_fwd, hipFuncAttributeMaxDynamicSharedMemorySize, LDS_BYTES) != hipSuccess) { grid = -1; return; }
        if (hipOccupancyMaxActiveBlocksPerMultiprocessor(&per_cu, (const void*)mk_fwd, NWAVES * 64, LDS_BYTES) != hipSuccess || per_cu < 1) fprintf(stderr, "kernel_launch: occupancy query says %d\n", per_cu);
        (void)hipGetLastError();
        grid = cus;
    }
    if (grid < 0) return;
    (void)hipMemsetAsync((char*)d_ws + WS_CTL, 0, CTL_ZERO_BYTES, stream);
    Args a{};
    for (int i = 0; i < 23; ++i) a.in[i] = (const float*)d_in[i];
    a.out = (float*)d_out; a.ws = (unsigned char*)d_ws;
#if MK_SPLIT
    for (int p = 0; p < PH_END; ++p) { a.ph_lo = p; a.ph_hi = p + 1; hipLaunchKernelGGL(mk_fwd, dim3(grid), dim3(NWAVES * 64), LDS_BYTES, stream, a); }
#else
    a.ph_lo = 0; a.ph_hi = PH_END;
    hipLaunchKernelGGL(mk_fwd, dim3(grid), dim3(NWAVES * 64), LDS_BYTES, stream, a);
#endif
}
```
